# Optimizing an MI355X kernel written in HIP

```python
import math
import jax, jax.numpy as jnp
from jax import lax
import numpy as np

D_MODEL = 1024
BATCH = 8
SEQ = 4096
DEPTH = 2

A_CH = 512
CONV_W = 31
B_HEADS = 8
B_HEAD_DIM = 64
B_CH = B_HEADS * B_HEAD_DIM
SGU_CHUNK = 128
MIX_IN = 2 * A_CH + 2 * B_CH
MIX_OUT = A_CH + B_CH
MOBA_HEADS = 16
MOBA_HEAD_DIM = 64
MOBA_BLOCK = 256
MOBA_TOPK = 3
MOBA_Q_BLOCK = 128
REL_BUCKETS = 32
REL_MAX_DIST = 2048
PEER_HEADS = 8
PEER_NKEYS = 128
PEER_N_EXPERTS = PEER_NKEYS * PEER_NKEYS
PEER_DKEY = 256
PEER_TOPK = 16
PEER_TOKEN_BLOCK = 128
EPS = 1e-6
NEG = -1e30

kernel_name = "hybrid_conv_sgu_moba_peer"


def rms_norm(x, g):
    xf = x.astype(jnp.float32)
    y = xf * lax.rsqrt(jnp.mean(xf * xf, axis=-1, keepdims=True) + EPS)
    return (y * g.astype(jnp.float32)).astype(x.dtype)


def layer_norm(x, g, b):
    xf = x.astype(jnp.float32)
    mu = jnp.mean(xf, axis=-1, keepdims=True)
    var = jnp.mean(jnp.square(xf - mu), axis=-1, keepdims=True)
    y = (xf - mu) * lax.rsqrt(var + EPS)
    return (y * g.astype(jnp.float32) + b.astype(jnp.float32)).astype(x.dtype)


def t5_bucket(dist):
    n = jnp.maximum(dist, 0)
    max_exact = REL_BUCKETS // 2
    nf = jnp.maximum(n, 1).astype(jnp.float32)
    log_b = max_exact + (jnp.log(nf / max_exact) / math.log(REL_MAX_DIST / max_exact)
                         * (REL_BUCKETS - max_exact)).astype(jnp.int32)
    return jnp.where(n < max_exact, n, jnp.minimum(log_b, REL_BUCKETS - 1))


def conv_sgu_mixer(h, w_in, conv_w, conv_b, conv_ln_g, conv_ln_b,
                   sgu_ln_g, sgu_ln_b, sgu_w, sgu_b, w_out):
    B, S, _ = h.shape
    z = h @ w_in
    a_val, a_gate, b_u, b_v = jnp.split(z, [A_CH, 2 * A_CH, 2 * A_CH + B_CH], axis=-1)
    a = a_val * jax.nn.sigmoid(a_gate)
    a = lax.conv_general_dilated(
        a, conv_w.reshape(CONV_W, 1, A_CH), window_strides=(1,),
        padding=[(CONV_W - 1, 0)], dimension_numbers=('NWC', 'WIO', 'NWC'),
        feature_group_count=A_CH) + conv_b
    a = jax.nn.silu(layer_norm(a, conv_ln_g, conv_ln_b))
    u = jax.nn.gelu(b_u)
    v = layer_norm(jax.nn.gelu(b_v), sgu_ln_g, sgu_ln_b)
    n_chunk = S // SGU_CHUNK
    v = v.reshape(B, n_chunk, SGU_CHUNK, B_HEADS, B_HEAD_DIM)
    mask = jnp.tril(jnp.ones((SGU_CHUNK, SGU_CHUNK), dtype=sgu_w.dtype))
    s = jnp.einsum('hts,bnshc->bnthc', sgu_w * mask, v) + sgu_b.T[None, None, :, :, None]
    bo = u * s.reshape(B, S, B_CH)
    return jnp.concatenate([a, bo], axis=-1) @ w_out


def moba_attention(q, k, v, rel_bias):
    B, S, H, hd = q.shape
    n_blk = -(-S // MOBA_BLOCK)
    s_pad = n_blk * MOBA_BLOCK
    pad = ((0, 0), (0, s_pad - S), (0, 0), (0, 0))
    kb = jnp.pad(k, pad).reshape(B, n_blk, MOBA_BLOCK, H, hd).transpose(0, 3, 1, 2, 4)
    vb = jnp.pad(v, pad).reshape(B, n_blk, MOBA_BLOCK, H, hd).transpose(0, 3, 1, 2, 4)
    k_mean = jnp.mean(kb.astype(jnp.float32), axis=3)
    gate = jnp.einsum('bshd,bhnd->bshn', q.astype(jnp.float32), k_mean)
    own_blk = jnp.arange(S) // MOBA_BLOCK
    past = jnp.arange(n_blk)[None, :] < own_blk[:, None]
    gate = jnp.where(past[None, :, None, :], gate, -jnp.inf)
    k_sel = min(MOBA_TOPK, n_blk)
    _, sel = lax.top_k(gate, k_sel)
    nqc = S // MOBA_Q_BLOCK
    qc_all = q.reshape(B * nqc, MOBA_Q_BLOCK, H, hd)
    sel_all = sel.reshape(B * nqc, MOBA_Q_BLOCK, H, k_sel)
    idx = jnp.arange(B * nqc)
    b_all = idx // nqc
    c_all = idx % nqc
    h_idx = jnp.arange(H)[None, :, None]
    offs = jnp.arange(MOBA_BLOCK)
    scale = hd ** -0.5
    n_past = k_sel * MOBA_BLOCK

    def step(args):
        qc, selc, b, c = args
        t = c * MOBA_Q_BLOCK + jnp.arange(MOBA_Q_BLOCK)
        own = (c * MOBA_Q_BLOCK) // MOBA_BLOCK
        kp = kb[b, h_idx, selc]
        vp = vb[b, h_idx, selc]
        ko = kb[b, :, own]
        vo = vb[b, :, own]
        dist_p = t[:, None, None, None] - (selc[..., None] * MOBA_BLOCK + offs)
        bias_p = rel_bias[t5_bucket(dist_p), h_idx[..., None]].astype(jnp.float32)
        lp = jnp.einsum('qhd,qhjkd->qhjk', qc, kp).astype(jnp.float32) * scale + bias_p
        lp = jnp.where((selc < own)[..., None], lp, NEG)
        dist_o = t[:, None] - (own * MOBA_BLOCK + offs)
        bias_o = rel_bias[t5_bucket(dist_o)].transpose(0, 2, 1).astype(jnp.float32)
        lo = jnp.einsum('qhd,hkd->qhk', qc, ko).astype(jnp.float32) * scale + bias_o
        lo = jnp.where((dist_o >= 0)[:, None, :], lo, NEG)
        logits = jnp.concatenate([lp.reshape(MOBA_Q_BLOCK, H, n_past), lo], axis=-1)
        p = jax.nn.softmax(logits, axis=-1).astype(vb.dtype)
        pp = p[..., :n_past].reshape(MOBA_Q_BLOCK, H, k_sel, MOBA_BLOCK)
        po = p[..., n_past:]
        return (jnp.einsum('qhjk,qhjkd->qhd', pp, vp)
                + jnp.einsum('qhk,hkd->qhd', po, vo))

    out = lax.map(step, (qc_all, sel_all, b_all, c_all))
    return out.reshape(B, S, H * hd)


def moba_mixer(h, w_qkv, w_o, rel_bias):
    B, S, _ = h.shape
    qkv = (h @ w_qkv).reshape(B, S, 3, MOBA_HEADS, MOBA_HEAD_DIM)
    o = moba_attention(qkv[:, :, 0], qkv[:, :, 1], qkv[:, :, 2], rel_bias)
    return o @ w_o


def peer(h, w_q, subkeys, u_tab, v_tab):
    B, S, D = h.shape
    T = B * S
    xt = h.reshape(T, D)
    q = (xt @ w_q).reshape(T, PEER_HEADS, 2, PEER_DKEY // 2)
    s = jnp.einsum('thpd,hpkd->thpk', q, subkeys).astype(jnp.float32)
    s1, i1 = lax.top_k(s[:, :, 0], PEER_TOPK)
    s2, i2 = lax.top_k(s[:, :, 1], PEER_TOPK)
    cand = (s1[..., :, None] + s2[..., None, :]).reshape(T, PEER_HEADS, PEER_TOPK * PEER_TOPK)
    sc, ci = lax.top_k(cand, PEER_TOPK)
    ei = jnp.take_along_axis(i1, ci // PEER_TOPK, axis=-1)
    ej = jnp.take_along_axis(i2, ci % PEER_TOPK, axis=-1)
    expert = ei * PEER_NKEYS + ej
    g = jax.nn.softmax(sc, axis=-1).astype(h.dtype)
    nc = T // PEER_TOKEN_BLOCK

    def step(args):
        xc, ec, gc = args
        uc = u_tab[ec]
        vc = v_tab[ec]
        act = jax.nn.gelu(jnp.einsum('td,thkd->thk', xc, uc))
        return jnp.einsum('thk,thkd->td', gc * act, vc)

    y = lax.map(step, (xt.reshape(nc, PEER_TOKEN_BLOCK, D),
                       expert.reshape(nc, PEER_TOKEN_BLOCK, PEER_HEADS, PEER_TOPK),
                       g.reshape(nc, PEER_TOKEN_BLOCK, PEER_HEADS, PEER_TOPK)))
    return y.reshape(B, S, D)


def setup_inputs(seed: int = 0) -> dict:
    key = jax.random.key(seed)
    ks = jax.random.split(key, 24)
    n_even = (DEPTH + 1) // 2
    n_odd = DEPTH // 2
    f32 = jnp.float32

    def nrm(k, shape, scale):
        return jax.random.normal(k, shape, f32) * scale

    attn_w = MOBA_HEADS * MOBA_HEAD_DIM
    return {
        "x": nrm(ks[0], (BATCH, SEQ, D_MODEL), 1.0),
        "ev_w_in": nrm(ks[1], (n_even, D_MODEL, MIX_IN), D_MODEL ** -0.5),
        "ev_conv_w": nrm(ks[2], (n_even, CONV_W, A_CH), CONV_W ** -0.5),
        "ev_conv_b": nrm(ks[3], (n_even, A_CH), 0.02),
        "ev_conv_ln_g": 1.0 + nrm(ks[4], (n_even, A_CH), 0.02),
        "ev_conv_ln_b": nrm(ks[5], (n_even, A_CH), 0.02),
        "ev_sgu_ln_g": 1.0 + nrm(ks[6], (n_even, B_CH), 0.02),
        "ev_sgu_ln_b": nrm(ks[7], (n_even, B_CH), 0.02),
        "ev_sgu_w": nrm(ks[8], (n_even, B_HEADS, SGU_CHUNK, SGU_CHUNK), SGU_CHUNK ** -0.5),
        "ev_sgu_b": 1.0 + nrm(ks[9], (n_even, B_HEADS, SGU_CHUNK), 0.02),
        "ev_w_out": nrm(ks[10], (n_even, MIX_OUT, D_MODEL), MIX_OUT ** -0.5),
        "od_w_qkv": nrm(ks[11], (n_odd, D_MODEL, 3 * attn_w), D_MODEL ** -0.5),
        "od_w_o": nrm(ks[12], (n_odd, attn_w, D_MODEL), attn_w ** -0.5),
        "rel_bias": nrm(ks[13], (REL_BUCKETS, MOBA_HEADS), 0.5),
        "peer_w_q": nrm(ks[14], (DEPTH, D_MODEL, PEER_HEADS * PEER_DKEY), D_MODEL ** -0.5),
        "peer_subkeys": nrm(ks[15], (DEPTH, PEER_HEADS, 2, PEER_NKEYS, PEER_DKEY // 2),
                            (PEER_DKEY // 2) ** -0.5),
        "peer_u": nrm(ks[16], (DEPTH, PEER_N_EXPERTS, D_MODEL), D_MODEL ** -0.5),
        "peer_v": nrm(ks[17], (DEPTH, PEER_N_EXPERTS, D_MODEL), PEER_HEADS ** -0.5),
        "norm_mix_g": 1.0 + nrm(ks[18], (DEPTH, D_MODEL), 0.02),
        "norm_ffn_g": 1.0 + nrm(ks[19], (DEPTH, D_MODEL), 0.02),
        "norm_final_g": 1.0 + nrm(ks[20], (D_MODEL,), 0.02),
    }


def reference(x, ev_w_in, ev_conv_w, ev_conv_b, ev_conv_ln_g, ev_conv_ln_b,
              ev_sgu_ln_g, ev_sgu_ln_b, ev_sgu_w, ev_sgu_b, ev_w_out,
              od_w_qkv, od_w_o, rel_bias, peer_w_q, peer_subkeys, peer_u, peer_v,
              norm_mix_g, norm_ffn_g, norm_final_g):
    for l in range(DEPTH):
        h = rms_norm(x, norm_mix_g[l])
        i = l // 2
        if l % 2 == 0:
            mix = conv_sgu_mixer(h, ev_w_in[i], ev_conv_w[i], ev_conv_b[i],
                                 ev_conv_ln_g[i], ev_conv_ln_b[i], ev_sgu_ln_g[i],
                                 ev_sgu_ln_b[i], ev_sgu_w[i], ev_sgu_b[i], ev_w_out[i])
        else:
            mix = moba_mixer(h, od_w_qkv[i], od_w_o[i], rel_bias)
        x = x + mix
        h = rms_norm(x, norm_ffn_g[l])
        x = x + peer(h, peer_w_q[l], peer_subkeys[l], peer_u[l], peer_v[l])
    return rms_norm(x, norm_final_g)
```

```cpp
#include <hip/hip_runtime.h>
#include <cstdio>
#include <cstdint>
namespace pg8 {
#define PG8_LAS __attribute__((address_space(3)))
typedef unsigned short bf16_t;
typedef short bf16x8 __attribute__((ext_vector_type(8)));
typedef float f32x4 __attribute__((ext_vector_type(4)));
typedef unsigned u32x4 __attribute__((ext_vector_type(4)));
constexpr int BM = 256, BK = 64, HALF = 128, HTB = HALF * BK * 2  , STAGE_BYTES = 8 * HTB, NXCD = 8, WGM = 8;

__host__ __device__ __forceinline__ int lds_byte(int r, int c) { const int st = (r >> 4) * 2 + (c >> 5), rr = r & 15, cc = c & 31, ob = rr * 64 + cc * 2; return st * 1024 + (ob ^ (((ob >> 9) & 1) << 5)); }
__host__ __device__ __forceinline__ void stage_rc(int b, int& R, int& C) { const int st = b / 1024, sb = b % 1024, swz = sb ^ (((sb >> 9) & 1) << 5); R = (st >> 1) * 16 + swz / 64; C = (st & 1) * 32 + (swz % 64) / 2; }
__host__ __device__ __forceinline__ int perm32(int rho) { const int n = rho >> 4, i = rho & 15; return 8 * (i >> 2) + 4 * n + (i & 3); }

struct Unit { int pm, pn; };
struct Gemm { const bf16_t* A; const bf16_t* Bt; int M, N, K; };

struct StaticOrder {
    int nM, nN, nwg, G, c;
    __host__ __device__ void init(int M, int N, int G_, int c_) { nM = M / BM; nN = N / BM; nwg = nM * nN; G = G_; c = c_; }
    __host__ __device__ bool next(int i, Unit& u) const {
        const long L = (long)i * G + c; if (L >= nwg) return false;
        int wgid = (int)L; { const int q = nwg / NXCD, r = nwg % NXCD, xcd = wgid % NXCD, off = wgid / NXCD; wgid = (xcd < r ? xcd * (q + 1) : r * (q + 1) + (xcd - r) * q) + off; }
        const int nig = WGM * nN, gid = wgid / nig, fm = gid * WGM, gsz = (nM - fm) < WGM ? (nM - fm) : WGM;
        u.pm = fm + ((wgid % nig) % gsz); u.pn = (wgid % nig) / gsz; return true;
    }
    __device__ __forceinline__ void a_ready(const Unit&) const {}
    __device__ __forceinline__ void done(const Unit&) const {}
};

__device__ __forceinline__ unsigned cvt_pk_bf16(float lo, float hi) { unsigned r; asm volatile("v_cvt_pk_bf16_f32 %0, %1, %2" : "=v"(r) : "v"(lo), "v"(hi)); return r; }
typedef float f32x2 __attribute__((ext_vector_type(2)));
__device__ __forceinline__ f32x2 gelu_pk(f32x2 v) {
    const f32x2 av = __builtin_elementwise_abs(v), d = av * 0.2316418882f + 1.0f;
    f32x2 t; t.x = __builtin_amdgcn_rcpf(d.x); t.y = __builtin_amdgcn_rcpf(d.y);
    f32x2 q = t * 0.5307027145f + (-0.7265760135f); q = q * t + 0.7107068705f; q = q * t + (-0.142248368f); q = q * t + 0.127414796f; q = q * t;
    const f32x2 s = (v * v) * (-0.72134752044f);
    f32x2 e; e.x = __builtin_amdgcn_exp2f(s.x); e.y = __builtin_amdgcn_exp2f(s.y);
    const f32x2 m = v * (q * e), r = v - m;
    f32x2 o; o.x = v.x < 0.f ? m.x : r.x; o.y = v.y < 0.f ? m.y : r.y; return o;
}

template <int ACT  > struct EpiBf16 {
    static constexpr bool PERM = true, AFTER_DRAIN = false; static_assert(ACT == 0 || ACT == 1, "EpiBf16: ACT is 0 (none) or 1 (gelu_pk)");
    bf16_t* O; int ldc; const float* bias; int split_cols; size_t split_stride; float scale0;
    __device__ __forceinline__ void operator()(const f32x4 (&acc)[2][2][4][2], const Unit& u, int wr, int wc, int fr, int fq) const {
        const int row0 = u.pm * BM + wr * 64 + fr; int colt = u.pn * BM; bf16_t* base = O;
        float sc = 1.f; if (split_cols) { const int t = colt / split_cols; base += (size_t)t * split_stride; colt -= t * split_cols; if (t == 0) sc = scale0; }
        const int col0 = colt + wc * 32 + 8 * fq, bcol0 = u.pn * BM + wc * 32 + 8 * fq;
        f32x4 bv[2][2];
#pragma unroll
        for (int bj = 0; bj < 2; ++bj)
#pragma unroll
            for (int n = 0; n < 2; ++n) bv[bj][n] = bias ? *(const f32x4*)(bias + bcol0 + bj * HALF + 4 * n) : (f32x4){0.f, 0.f, 0.f, 0.f};
#pragma unroll
        for (int ai = 0; ai < 2; ++ai)
#pragma unroll
            for (int m = 0; m < 4; ++m) { bf16_t* rowp = base + (size_t)(row0 + ai * HALF + m * 16) * ldc + col0;
#pragma unroll
                for (int bj = 0; bj < 2; ++bj) { f32x4 v0 = acc[ai][bj][m][0] + bv[bj][0], v1 = acc[ai][bj][m][1] + bv[bj][1];
                    if (ACT == 1) { f32x2 a = gelu_pk((f32x2){v0[0], v0[1]}), b = gelu_pk((f32x2){v0[2], v0[3]}), c = gelu_pk((f32x2){v1[0], v1[1]}), d = gelu_pk((f32x2){v1[2], v1[3]});
                        v0 = (f32x4){a.x, a.y, b.x, b.y}; v1 = (f32x4){c.x, c.y, d.x, d.y}; }
                    v0 = v0 * sc; v1 = v1 * sc; u32x4 w; w.x = cvt_pk_bf16(v0[0], v0[1]); w.y = cvt_pk_bf16(v0[2], v0[3]); w.z = cvt_pk_bf16(v1[0], v1[1]); w.w = cvt_pk_bf16(v1[2], v1[3]);
                    *(u32x4*)(rowp + bj * HALF) = w; } }
    }
};
typedef int i32x4 __attribute__((ext_vector_type(4)));
__device__ __forceinline__ float sigmoid_f(float x) { return __builtin_amdgcn_rcpf(1.0f + __expf(-x)); }
__device__ __forceinline__ float gelu_tanh_f(float x) { const float t = 1.5957691216057308f * (x + 0.044715f * x * x * x); return x * sigmoid_f(t); }
struct EpiMixIn {
    static constexpr bool PERM = true, AFTER_DRAIN = false;
    bf16_t* aglu; bf16_t* ug; bf16_t* vg;
    __device__ __forceinline__ void operator()(const f32x4 (&acc)[2][2][4][2], const Unit& u, int wr, int wc, int fr, int fq) const {
        const int row0 = u.pm * BM + wr * 64 + fr;
        if (u.pn < 4) {
            const int col0 = u.pn * 128 + wc * 32 + 8 * fq;
#pragma unroll
            for (int ai = 0; ai < 2; ++ai)
#pragma unroll
                for (int m = 0; m < 4; ++m) {
                    const f32x4 v0 = acc[ai][0][m][0], v1 = acc[ai][0][m][1], g0 = acc[ai][1][m][0], g1 = acc[ai][1][m][1];
                    u32x4 w;
                    w.x = cvt_pk_bf16(v0[0] * sigmoid_f(g0[0]), v0[1] * sigmoid_f(g0[1])); w.y = cvt_pk_bf16(v0[2] * sigmoid_f(g0[2]), v0[3] * sigmoid_f(g0[3]));
                    w.z = cvt_pk_bf16(v1[0] * sigmoid_f(g1[0]), v1[1] * sigmoid_f(g1[1])); w.w = cvt_pk_bf16(v1[2] * sigmoid_f(g1[2]), v1[3] * sigmoid_f(g1[3]));
                    *(u32x4*)(aglu + (size_t)(row0 + ai * HALF + m * 16) * 512 + col0) = w;
                }
        } else {
            bf16_t* dst = (u.pn < 6) ? ug : vg; const int col0 = (u.pn & 1) * 256 + wc * 32 + 8 * fq;
#pragma unroll
            for (int ai = 0; ai < 2; ++ai)
#pragma unroll
                for (int m = 0; m < 4; ++m)
#pragma unroll
                    for (int bj = 0; bj < 2; ++bj) {
                        const f32x4 v0 = acc[ai][bj][m][0], v1 = acc[ai][bj][m][1];
                        u32x4 w;
                        w.x = cvt_pk_bf16(gelu_tanh_f(v0[0]), gelu_tanh_f(v0[1])); w.y = cvt_pk_bf16(gelu_tanh_f(v0[2]), gelu_tanh_f(v0[3]));
                        w.z = cvt_pk_bf16(gelu_tanh_f(v1[0]), gelu_tanh_f(v1[1])); w.w = cvt_pk_bf16(gelu_tanh_f(v1[2]), gelu_tanh_f(v1[3]));
                        *(u32x4*)(dst + (size_t)(row0 + ai * HALF + m * 16) * 512 + col0 + bj * HALF) = w;
                    }
        }
    }
};
struct EpiRes {
    static constexpr bool PERM = false, AFTER_DRAIN = false;
    const float* base; float* out; int ldc;
    __device__ __forceinline__ void operator()(const f32x4 (&acc)[2][2][4][2], const Unit& u, int wr, int wc, int fr, int fq) const {
        const int col0 = u.pn * BM + wc * 32 + 4 * fq;
#pragma unroll
        for (int ai = 0; ai < 2; ++ai)
#pragma unroll
            for (int m = 0; m < 4; ++m) { const size_t off = (size_t)(u.pm * BM + ai * HALF + wr * 64 + m * 16 + fr) * ldc + col0;
#pragma unroll
                for (int bj = 0; bj < 2; ++bj)
#pragma unroll
                    for (int n = 0; n < 2; ++n) { const f32x4 bs = *(const f32x4*)(base + off + bj * HALF + n * 16); *(f32x4*)(out + off + bj * HALF + n * 16) = bs + acc[ai][bj][m][n]; } }
    }
};

struct EpiQKV {
    static constexpr bool PERM = true, AFTER_DRAIN = false;
    bf16_t* Q; size_t split_stride; const float* ssq; float* kmf; float qscale, eps;
    __device__ __forceinline__ void operator()(const f32x4 (&acc)[2][2][4][2], const Unit& u, int wr, int wc, int fr, int fq) const {
        const int row0 = u.pm * BM + wr * 64 + fr; const int tsel = u.pn >> 2, colt = (u.pn & 3) * 256;
        bf16_t* base = Q + (size_t)tsel * split_stride; const int col0 = colt + wc * 32 + 8 * fq;
        const float sc = tsel == 0 ? qscale : 1.f;
        f32x4 cs[2][2];
#pragma unroll
        for (int bj = 0; bj < 2; ++bj) { cs[bj][0] = (f32x4){0.f, 0.f, 0.f, 0.f}; cs[bj][1] = (f32x4){0.f, 0.f, 0.f, 0.f}; }
#pragma unroll
        for (int ai = 0; ai < 2; ++ai)
#pragma unroll
            for (int m = 0; m < 4; ++m) { const int row = row0 + ai * HALF + m * 16; const float rs = rsqrtf(ssq[row] * (1.0f / 1024.0f) + eps) * sc;
#pragma unroll
                for (int bj = 0; bj < 2; ++bj) { const f32x4 v0 = acc[ai][bj][m][0] * rs, v1 = acc[ai][bj][m][1] * rs; cs[bj][0] += v0; cs[bj][1] += v1;
                    u32x4 w; w.x = cvt_pk_bf16(v0[0], v0[1]); w.y = cvt_pk_bf16(v0[2], v0[3]); w.z = cvt_pk_bf16(v1[0], v1[1]); w.w = cvt_pk_bf16(v1[2], v1[3]);
                    *(u32x4*)(base + (size_t)row * 1024 + col0 + bj * HALF) = w; } }
        if (tsel == 1) {
#pragma unroll
            for (int bj = 0; bj < 2; ++bj)
#pragma unroll
                for (int n = 0; n < 2; ++n)
#pragma unroll
                    for (int e = 0; e < 4; ++e) { float v = cs[bj][n][e];
                        v += __builtin_bit_cast(float, __builtin_amdgcn_update_dpp(0, __builtin_bit_cast(int, v), 0xB1, 0xf, 0xf, true)); v += __builtin_bit_cast(float, __builtin_amdgcn_update_dpp(0, __builtin_bit_cast(int, v), 0x4E, 0xf, 0xf, true));
                        v += __builtin_bit_cast(float, __builtin_amdgcn_update_dpp(0, __builtin_bit_cast(int, v), 0x141, 0xf, 0xf, true)); v += __builtin_bit_cast(float, __builtin_amdgcn_update_dpp(0, __builtin_bit_cast(int, v), 0x128, 0xf, 0xf, true));
                        if (fr == 0) atomicAdd(kmf + (size_t)u.pm * 1024 + col0 + bj * HALF + 4 * n + e, v * (1.0f / 256.0f)); }
        }
    }
};

template <class Inner> struct EpiI8 {
    static constexpr bool PERM = true, AFTER_DRAIN = false; static_assert(Inner::PERM, "EpiI8 wraps PERM epilogues");
    Inner E; const float* sa; const float* sb;
    __device__ __forceinline__ void operator()(const f32x4 (&acc)[2][2][4][2], const Unit& u, int wr, int wc, int fr, int fq) const {
        const int cb0 = u.pn * BM + wc * 32 + 8 * fq, row0 = u.pm * BM + wr * 64 + fr;
        f32x4 sbv[2][2];
#pragma unroll
        for (int bj = 0; bj < 2; ++bj)
#pragma unroll
            for (int n = 0; n < 2; ++n) sbv[bj][n] = *(const f32x4*)(sb + cb0 + bj * HALF + 4 * n);
        f32x4 cv[2][2][4][2];
#pragma unroll
        for (int ai = 0; ai < 2; ++ai)
#pragma unroll
            for (int m = 0; m < 4; ++m) { const float ra = sa[row0 + ai * HALF + m * 16];
#pragma unroll
                for (int bj = 0; bj < 2; ++bj)
#pragma unroll
                    for (int n = 0; n < 2; ++n) { const i32x4 iv = __builtin_bit_cast(i32x4, acc[ai][bj][m][n]);
                        cv[ai][bj][m][n] = (f32x4){(float)iv[0], (float)iv[1], (float)iv[2], (float)iv[3]} * ra * sbv[bj][n]; } }
        E(cv, u, wr, wc, fr, fq);
    }
};

template <bool BF> struct EpiResB {
    static constexpr bool PERM = false, AFTER_DRAIN = false;
    const float* basef; const bf16_t* baseb; bf16_t* outb; int ldc;
    __device__ __forceinline__ void operator()(const f32x4 (&acc)[2][2][4][2], const Unit& u, int wr, int wc, int fr, int fq) const {
        typedef unsigned u32x2 __attribute__((ext_vector_type(2)));
        const int col0 = u.pn * BM + wc * 32 + 4 * fq;
#pragma unroll
        for (int ai = 0; ai < 2; ++ai)
#pragma unroll
            for (int m = 0; m < 4; ++m) { const size_t off = (size_t)(u.pm * BM + ai * HALF + wr * 64 + m * 16 + fr) * ldc + col0;
#pragma unroll
                for (int bj = 0; bj < 2; ++bj)
#pragma unroll
                    for (int n = 0; n < 2; ++n) { const size_t o = off + bj * HALF + n * 16; f32x4 bs;
                        if (BF) { const u32x2 w = *(const u32x2*)(baseb + o); bs = (f32x4){__builtin_bit_cast(float, w.x << 16), __builtin_bit_cast(float, w.x & 0xffff0000u), __builtin_bit_cast(float, w.y << 16), __builtin_bit_cast(float, w.y & 0xffff0000u)}; }
                        else bs = *(const f32x4*)(basef + o);
                        const f32x4 v = bs + acc[ai][bj][m][n]; u32x2 wv; wv.x = cvt_pk_bf16(v[0], v[1]); wv.y = cvt_pk_bf16(v[2], v[3]); *(u32x2*)(outb + o) = wv; } }
    }
};

struct EpiQKVM {
    static constexpr bool PERM = true, AFTER_DRAIN = false;
    EpiBf16<0> B; float* kmp; int ntm;
    __device__ __forceinline__ void operator()(const f32x4 (&acc)[2][2][4][2], const Unit& u, int wr, int wc, int fr, int fq) const {
        B(acc, u, wr, wc, fr, fq);
        if (u.pn >= 4 && u.pn < 8) {
            float* dst = kmp + ((size_t)wr * ntm + u.pm) * 1024 + (u.pn - 4) * BM + wc * 32 + 8 * fq;
#pragma unroll
            for (int bj = 0; bj < 2; ++bj)
#pragma unroll
                for (int n = 0; n < 2; ++n) { f32x4 cs = (acc[0][bj][0][n] + acc[0][bj][1][n]) + (acc[0][bj][2][n] + acc[0][bj][3][n]) + ((acc[1][bj][0][n] + acc[1][bj][1][n]) + (acc[1][bj][2][n] + acc[1][bj][3][n]));
#pragma unroll
                    for (int e = 0; e < 4; ++e) { float v = cs[e];
                        v += __builtin_bit_cast(float, __builtin_amdgcn_update_dpp(0, __builtin_bit_cast(int, v), 0xB1, 0xf, 0xf, true)); v += __builtin_bit_cast(float, __builtin_amdgcn_update_dpp(0, __builtin_bit_cast(int, v), 0x4E, 0xf, 0xf, true));
                        v += __builtin_bit_cast(float, __builtin_amdgcn_update_dpp(0, __builtin_bit_cast(int, v), 0x141, 0xf, 0xf, true)); v += __builtin_bit_cast(float, __builtin_amdgcn_update_dpp(0, __builtin_bit_cast(int, v), 0x128, 0xf, 0xf, true));
                        cs[e] = v * (1.0f / 256.0f); }
                    if (fr == 0) *(f32x4*)(dst + bj * HALF + 4 * n) = cs; }
        }
    }
};

template <bool KM> struct EpiI8Bf16 {
    static constexpr bool PERM = true, AFTER_DRAIN = false;
    bf16_t* O; int ldc; int split_cols; size_t split_stride; float scale0; const float* sa; const float* sb; float* kmp; int ntm;
    __device__ __forceinline__ void operator()(const f32x4 (&acc)[2][2][4][2], const Unit& u, int wr, int wc, int fr, int fq) const {
        const int row0 = u.pm * BM + wr * 64 + fr; int colt = u.pn * BM, tsel = 0; bf16_t* base = O; float sc = 1.f;
        if (split_cols) { tsel = colt / split_cols; base += (size_t)tsel * split_stride; colt -= tsel * split_cols; if (tsel == 0) sc = scale0; }
        const int col0 = colt + wc * 32 + 8 * fq, cb0 = u.pn * BM + wc * 32 + 8 * fq;
        f32x4 sbv[2][2], cs[2][2];
#pragma unroll
        for (int bj = 0; bj < 2; ++bj)
#pragma unroll
            for (int n = 0; n < 2; ++n) { sbv[bj][n] = *(const f32x4*)(sb + cb0 + bj * HALF + 4 * n) * sc; cs[bj][n] = (f32x4){0.f, 0.f, 0.f, 0.f}; }
#pragma unroll
        for (int ai = 0; ai < 2; ++ai)
#pragma unroll
            for (int m = 0; m < 4; ++m) { const int row = row0 + ai * HALF + m * 16; const float ra = sa[row]; bf16_t* rowp = base + (size_t)row * ldc + col0;
#pragma unroll
                for (int bj = 0; bj < 2; ++bj) { const i32x4 i0 = __builtin_bit_cast(i32x4, acc[ai][bj][m][0]), i1 = __builtin_bit_cast(i32x4, acc[ai][bj][m][1]);
                    const f32x4 v0 = (f32x4){(float)i0[0], (float)i0[1], (float)i0[2], (float)i0[3]} * ra * sbv[bj][0], v1 = (f32x4){(float)i1[0], (float)i1[1], (float)i1[2], (float)i1[3]} * ra * sbv[bj][1];
                    if (KM) { cs[bj][0] += v0; cs[bj][1] += v1; }
                    u32x4 w; w.x = cvt_pk_bf16(v0[0], v0[1]); w.y = cvt_pk_bf16(v0[2], v0[3]); w.z = cvt_pk_bf16(v1[0], v1[1]); w.w = cvt_pk_bf16(v1[2], v1[3]);
                    *(u32x4*)(rowp + bj * HALF) = w; } }
        if (KM && tsel == 1) {
            float* dst = kmp + ((size_t)wr * ntm + u.pm) * 1024 + colt + wc * 32 + 8 * fq;
#pragma unroll
            for (int bj = 0; bj < 2; ++bj)
#pragma unroll
                for (int n = 0; n < 2; ++n) { f32x4 c = cs[bj][n];
#pragma unroll
                    for (int e = 0; e < 4; ++e) { float v = c[e];
                        v += __builtin_bit_cast(float, __builtin_amdgcn_update_dpp(0, __builtin_bit_cast(int, v), 0xB1, 0xf, 0xf, true)); v += __builtin_bit_cast(float, __builtin_amdgcn_update_dpp(0, __builtin_bit_cast(int, v), 0x4E, 0xf, 0xf, true));
                        v += __builtin_bit_cast(float, __builtin_amdgcn_update_dpp(0, __builtin_bit_cast(int, v), 0x141, 0xf, 0xf, true)); v += __builtin_bit_cast(float, __builtin_amdgcn_update_dpp(0, __builtin_bit_cast(int, v), 0x128, 0xf, 0xf, true));
                        c[e] = v * (1.0f / 256.0f); }
                    if (fr == 0) *(f32x4*)(dst + bj * HALF + 4 * n) = c; }
        }
    }
};
template <bool I8> __device__ __forceinline__ f32x4 mma_step(const bf16x8& b, const bf16x8& a, const f32x4& c) {
    if constexpr (I8) return __builtin_bit_cast(f32x4, __builtin_amdgcn_mfma_i32_16x16x64_i8(__builtin_bit_cast(i32x4, b), __builtin_bit_cast(i32x4, a), __builtin_bit_cast(i32x4, c), 0, 0, 0));
    else return __builtin_amdgcn_mfma_f32_16x16x32_bf16(b, a, c, 0, 0, 0);
}
template <class Epi, class Sched, bool ALIGN_EPI = false, bool SP2 = false, bool I8 = false>
__device__ __forceinline__ void gemm_phase(PG8_LAS unsigned char* lds, const Gemm g, const Sched& S, const Epi& E) {
    const int tid = threadIdx.x, wid = __builtin_amdgcn_readfirstlane(tid >> 6), lane = tid & 63, wr = wid >> 2, wc = wid & 3, fr = lane & 15, fq = lane >> 4;
    const int K = g.K, nt = K / BK;
    unsigned voffA[2], voffB[2];
#pragma unroll
    for (int i = 0; i < 2; ++i) { int R, C; stage_rc(tid * 16 + i * 8192, R, C); const int Rb = Epi::PERM ? ((R & ~31) + perm32(R & 31)) : R;
        voffA[i] = (unsigned)(R * K + C) * 2u; voffB[i] = (unsigned)(Rb * K + C) * 2u; }
    const size_t kstep = (size_t)(BK * 2);
    const size_t hstep = (size_t)HALF * K * 2;
    const size_t tstep = 2 * hstep;
    const unsigned ldsw = (unsigned)wid * 1024u;
    const int aoff = lds_byte(wr * 64 + fr, fq * 8), boff = lds_byte(wc * 32 + fr, fq * 8);
#define PG8_SA(b, h) (((b) * 2 + (h)) * HTB)
#define PG8_SB(b, h) ((4 + (b) * 2 + (h)) * HTB)
#define PG8_STAGE(bufoff, gbase, voff) do { _Pragma("unroll") for (int _i = 0; _i < 2; ++_i) \
        __builtin_amdgcn_global_load_lds((const unsigned*)((const char*)(gbase) + (voff)[_i]), (PG8_LAS unsigned*)(lds + (bufoff) + ldsw + _i * 8192), 16, 0, 0); } while (0)
#define PG8_LDA(dst, b, h) do { _Pragma("unroll") for (int m = 0; m < 4; ++m) _Pragma("unroll") for (int k = 0; k < 2; ++k) dst[m][k] = *(const PG8_LAS bf16x8*)(lds + PG8_SA(b, h) + aoff + m * 2048 + k * 1024); } while (0)
#define PG8_LDB(dst, b, h) do { _Pragma("unroll") for (int n = 0; n < 2; ++n) _Pragma("unroll") for (int k = 0; k < 2; ++k) dst[n][k] = *(const PG8_LAS bf16x8*)(lds + PG8_SB(b, h) + boff + n * 2048 + k * 1024); } while (0)
#define PG8_MMA(ai, bj, At, Bt) do { __builtin_amdgcn_s_setprio(1); _Pragma("unroll") for (int m = 0; m < 4; ++m) _Pragma("unroll") for (int n = 0; n < 2; ++n) _Pragma("unroll") for (int k = 0; k < 2; ++k) \
        acc[ai][bj][m][n] = mma_step<I8>(Bt[n][k], At[m][k], acc[ai][bj][m][n]); __builtin_amdgcn_s_setprio(0); } while (0)
#define PG8_WAIT_V(n) asm volatile("s_waitcnt vmcnt(" #n ")" ::: "memory")
#define PG8_WAIT_L(n) asm volatile("s_waitcnt lgkmcnt(" #n ")" ::: "memory")
#define PG8_BAR __builtin_amdgcn_s_barrier()
#define PG8_SCHED __builtin_amdgcn_sched_barrier(0)
    Unit cur, nxt; int ui = 0;
    if (!S.next(0, cur)) return;
    f32x4 acc[2][2][4][2];
#pragma unroll
    for (int a = 0; a < 2; ++a)
#pragma unroll
        for (int b = 0; b < 2; ++b)
#pragma unroll
            for (int m = 0; m < 4; ++m)
#pragma unroll
                for (int n = 0; n < 2; ++n) acc[a][b][m][n] = (f32x4){0.f, 0.f, 0.f, 0.f};
    bf16x8 At[4][2], B0[2][2], B1[2][2];
    const char* cA = (const char*)g.A + (size_t)cur.pm * tstep; const char* cB = (const char*)g.Bt + (size_t)cur.pn * tstep;
    S.a_ready(cur);
    if constexpr (SP2) {
        PG8_STAGE(PG8_SB(0, 0), cB, voffB); PG8_STAGE(PG8_SB(0, 1), cB + hstep, voffB); PG8_STAGE(PG8_SA(0, 0), cA, voffA); PG8_STAGE(PG8_SA(0, 1), cA + hstep, voffA);
        if (wr == 1) PG8_BAR;
        PG8_WAIT_V(2); PG8_BAR;
        PG8_STAGE(PG8_SB(1, 0), cB + kstep, voffB); PG8_STAGE(PG8_SA(1, 0), cA + kstep, voffA); PG8_STAGE(PG8_SB(1, 1), cB + hstep + kstep, voffB);
        PG8_WAIT_V(6); PG8_BAR;
    } else {
        PG8_STAGE(PG8_SB(0, 0), cB, voffB); PG8_STAGE(PG8_SA(0, 0), cA, voffA); PG8_STAGE(PG8_SB(0, 1), cB + hstep, voffB); PG8_STAGE(PG8_SA(0, 1), cA + hstep, voffA);
        if (wr == 1) PG8_BAR;
        PG8_WAIT_V(4); PG8_BAR;
        PG8_STAGE(PG8_SB(1, 0), cB + kstep, voffB); PG8_STAGE(PG8_SA(1, 0), cA + kstep, voffA); PG8_STAGE(PG8_SB(1, 1), cB + hstep + kstep, voffB);
        PG8_WAIT_V(6); PG8_BAR;
    }
    for (;;) {
        const bool has_next = S.next(ui + 1, nxt);
        const char* nA = has_next ? (const char*)g.A + (size_t)nxt.pm * tstep : cA; const char* nB = has_next ? (const char*)g.Bt + (size_t)nxt.pn * tstep : cB;
        for (int t = 0; t < nt; t += 2) {
            const bool last = (t == nt - 2);
            const char* a1 = cA + (size_t)(t + 1) * kstep;
            const char* a2 = last ? nA : cA + (size_t)(t + 2) * kstep; const char* b2 = last ? nB : cB + (size_t)(t + 2) * kstep;
            const char* a3 = a2 + kstep; const char* b3 = b2 + kstep;
            if (last && has_next) S.a_ready(nxt);
            if constexpr (SP2) {
            PG8_LDB(B0, 0, 0); PG8_LDB(B1, 0, 1); PG8_SCHED; PG8_LDA(At, 0, 0); PG8_STAGE(PG8_SA(1, 1), a1 + hstep, voffA);
            PG8_WAIT_V(8); PG8_WAIT_L(0); PG8_BAR; PG8_MMA(0, 0, At, B0); PG8_MMA(0, 1, At, B1); PG8_BAR; PG8_SCHED;
            PG8_LDA(At, 0, 1); PG8_STAGE(PG8_SB(0, 0), b2, voffB); PG8_STAGE(PG8_SB(0, 1), b2 + hstep, voffB); PG8_STAGE(PG8_SA(0, 0), a2, voffA);
            PG8_WAIT_V(8); PG8_WAIT_L(0); PG8_BAR; PG8_MMA(1, 0, At, B0); PG8_MMA(1, 1, At, B1); PG8_BAR; PG8_SCHED;
            PG8_LDB(B0, 1, 0); PG8_LDB(B1, 1, 1); PG8_SCHED; PG8_LDA(At, 1, 0); PG8_STAGE(PG8_SA(0, 1), a2 + hstep, voffA);
            PG8_WAIT_V(8); PG8_WAIT_L(0); PG8_BAR; PG8_MMA(0, 0, At, B0); PG8_MMA(0, 1, At, B1); PG8_BAR; PG8_SCHED;
            PG8_LDA(At, 1, 1); PG8_STAGE(PG8_SB(1, 0), b3, voffB); PG8_STAGE(PG8_SB(1, 1), b3 + hstep, voffB); PG8_STAGE(PG8_SA(1, 0), a3, voffA);
            PG8_WAIT_V(8); PG8_WAIT_L(0); PG8_BAR; PG8_MMA(1, 0, At, B0); PG8_MMA(1, 1, At, B1); PG8_BAR; PG8_SCHED;
            } else {
            PG8_LDB(B0, 0, 0); PG8_SCHED; PG8_LDA(At, 0, 0); PG8_STAGE(PG8_SA(1, 1), a1 + hstep, voffA);
            PG8_WAIT_L(8); PG8_BAR; PG8_WAIT_L(0); PG8_MMA(0, 0, At, B0); PG8_BAR; PG8_SCHED;
            PG8_LDB(B1, 0, 1); PG8_STAGE(PG8_SB(0, 0), b2, voffB);
            PG8_BAR; PG8_WAIT_L(0); PG8_MMA(0, 1, At, B1); PG8_BAR;
            PG8_LDA(At, 0, 1); PG8_STAGE(PG8_SA(0, 0), a2, voffA);
            PG8_BAR; PG8_WAIT_L(0); PG8_MMA(1, 0, At, B0); PG8_BAR; PG8_SCHED;
            PG8_STAGE(PG8_SB(0, 1), b2 + hstep, voffB);
            PG8_WAIT_V(6); PG8_BAR; PG8_MMA(1, 1, At, B1); PG8_BAR;
            PG8_LDB(B0, 1, 0); PG8_SCHED; PG8_LDA(At, 1, 0); PG8_STAGE(PG8_SA(0, 1), a2 + hstep, voffA);
            PG8_WAIT_L(8); PG8_BAR; PG8_WAIT_L(0); PG8_MMA(0, 0, At, B0); PG8_BAR; PG8_SCHED;
            PG8_LDB(B1, 1, 1); PG8_STAGE(PG8_SB(1, 0), b3, voffB);
            PG8_BAR; PG8_WAIT_L(0); PG8_MMA(0, 1, At, B1); PG8_BAR;
            PG8_LDA(At, 1, 1); PG8_STAGE(PG8_SA(1, 0), a3, voffA);
            PG8_BAR; PG8_WAIT_L(0); PG8_MMA(1, 0, At, B0); PG8_BAR; PG8_SCHED;
            PG8_STAGE(PG8_SB(1, 1), b3 + hstep, voffB);
            PG8_WAIT_V(6); PG8_BAR; PG8_MMA(1, 1, At, B1); PG8_BAR;
            }
        }
        if constexpr (ALIGN_EPI) { if (wr == 0) PG8_BAR; }
        if constexpr (!Epi::AFTER_DRAIN) { E(acc, cur, wr, wc, fr, fq); S.done(cur); }
        if (!has_next) break;
#pragma unroll
        for (int a = 0; a < 2; ++a)
#pragma unroll
            for (int b = 0; b < 2; ++b)
#pragma unroll
                for (int m = 0; m < 4; ++m)
#pragma unroll
                    for (int n = 0; n < 2; ++n) acc[a][b][m][n] = (f32x4){0.f, 0.f, 0.f, 0.f};
        cur = nxt; cA = nA; cB = nB; ++ui;
        if constexpr (ALIGN_EPI) { if (wr == 1) PG8_BAR; }
    }
    PG8_WAIT_V(0);
    if constexpr (!ALIGN_EPI) { if (wr == 0) PG8_BAR; }
    PG8_BAR;
    if constexpr (Epi::AFTER_DRAIN) { E.fused(acc, cur, wr, wc, fr, fq, lds, wid, lane); S.done(cur); }
#undef PG8_SA
#undef PG8_SB
#undef PG8_STAGE
#undef PG8_LDA
#undef PG8_LDB
#undef PG8_MMA
#undef PG8_WAIT_V
#undef PG8_WAIT_L
#undef PG8_BAR
#undef PG8_SCHED
}
}
#include <hip/hip_bf16.h>
#include <cmath>
namespace attn_body {
using bf16=__hip_bfloat16;
using bf16x8=__attribute__((ext_vector_type(8)))short;
using s16x4=__attribute__((ext_vector_type(4)))short;
using f32x16=__attribute__((ext_vector_type(16)))float;
using u32x4=__attribute__((ext_vector_type(4)))unsigned;
using f32x4_t=__attribute__((ext_vector_type(4)))float;
constexpr int BATCH=8,NHEAD=16,SEQ=4096,D=64,DM=NHEAD*D;
constexpr int NW=8,QBLK=32,QB=QBLK*NW,KVBLK=64,NQB=SEQ/QB;
constexpr int ATTN_PITCH=DM, ATTN_UNIT_ROWS=QB;
__device__ __forceinline__ int crow(int r,int hi){return (r&3)+8*(r>>2)+4*hi;}
#define SBAR() __builtin_amdgcn_sched_barrier(0)
__device__ __forceinline__ void cmask(f32x16&p0,f32x16&p1,int jb,int qrel,int hi){
  const float NEG=-INFINITY; int kb=64*jb+4*hi;
  #pragma unroll
  for(int r=0;r<16;++r){int kv=kb+(r&3)+8*(r>>2); if(kv>qrel)p0[r]=NEG; if(kv+32>qrel)p1[r]=NEG;}
}

constexpr int NSLOT=3, SLOTB=8192;
constexpr int LDS_K=0, LDS_V=NSLOT*SLOTB, LDS_WS=2*NSLOT*SLOTB, LDS_OST=LDS_WS+NW*64*4, LDS_LUTB=LDS_OST+NW*4096, LUTL_OFF=256, LUTL_N=SEQ+LUTL_OFF, LDS_BYTES=LDS_LUTB+LUTL_N*4;
constexpr float C2=0.125f*1.4426950408889634f; constexpr int GLUT_OFF=256, GLUT_N=SEQ+GLUT_OFF;
__device__ __forceinline__ void glds16(const void*gsrc,unsigned lds_dst){unsigned keep;
  asm volatile("s_mov_b32 %0, m0\n\ts_mov_b32 m0, %2\n\ts_nop 0\n\tglobal_load_lds_dwordx4 %1, off\n\ts_mov_b32 m0, %0":"=&s"(keep):"v"(gsrc),"s"(lds_dst):"memory");}
__device__ __forceinline__ float max3f(float a,float b,float c){float r;asm("v_max3_f32 %0, %1, %2, %3":"=v"(r):"v"(a),"v"(b),"v"(c));return r;}
__device__ __forceinline__ float max2f(float a,float b){float r;asm("v_max_f32_e32 %0, %1, %2":"=v"(r):"v"(a),"v"(b));return r;}
__device__ __forceinline__ float fadd_s(float a,float b){float r;asm("v_add_f32_e32 %0, %1, %2":"=v"(r):"v"(a),"v"(b));return r;}
__device__ __forceinline__ float fsub_s(float a,float b){float r;asm("v_sub_f32_e32 %0, %1, %2":"=v"(r):"v"(a),"v"(b));return r;}
typedef float f32x2_t __attribute__((ext_vector_type(2))); typedef __bf16 bf16x2_t __attribute__((ext_vector_type(2)));
__device__ __forceinline__ unsigned cvtpk_s(float lo,float hi){f32x2_t v={lo,hi};bf16x2_t b=__builtin_convertvector(v,bf16x2_t);return __builtin_bit_cast(unsigned,b);}
#define WAIT_BAR(N) asm volatile("s_waitcnt vmcnt(" #N ") lgkmcnt(0)\n\ts_barrier":::"memory")

__device__ __forceinline__ void qkt(f32x16&p0,f32x16&p1,const char*Kslot,const bf16x8*qr,int r32,int hi){
  const char*kb=Kslot+hi*1024+r32*16;
  #pragma unroll
  for(int d0=0;d0<4;++d0){
    const bf16x8 b0=*reinterpret_cast<const bf16x8*>(kb+d0*2048);
    const bf16x8 b1=*reinterpret_cast<const bf16x8*>(kb+d0*2048+512);
    {p0=__builtin_amdgcn_mfma_f32_32x32x16_bf16(b0,qr[d0],p0,0,0,0);p1=__builtin_amdgcn_mfma_f32_32x32x16_bf16(b1,qr[d0],p1,0,0,0);}}
}
typedef __attribute__((address_space(3))) const char* lds_cptr; typedef __attribute__((address_space(3))) float* lds_fptr;
typedef short v4i16_t __attribute__((ext_vector_type(4)));
__device__ __forceinline__ void kload8(bf16x8*kf,lds_cptr kp){
  kf[0]=*(const __attribute__((address_space(3))) bf16x8*)(kp);      kf[1]=*(const __attribute__((address_space(3))) bf16x8*)(kp+512);
  kf[2]=*(const __attribute__((address_space(3))) bf16x8*)(kp+2048); kf[3]=*(const __attribute__((address_space(3))) bf16x8*)(kp+2560);
  kf[4]=*(const __attribute__((address_space(3))) bf16x8*)(kp+4096); kf[5]=*(const __attribute__((address_space(3))) bf16x8*)(kp+4608);
  kf[6]=*(const __attribute__((address_space(3))) bf16x8*)(kp+6144); kf[7]=*(const __attribute__((address_space(3))) bf16x8*)(kp+6656);
}
__device__ __forceinline__ void kload2(bf16x8*kf,lds_cptr kp,int j){ kf[2*j]=*(const __attribute__((address_space(3))) bf16x8*)(kp+j*2048); kf[2*j+1]=*(const __attribute__((address_space(3))) bf16x8*)(kp+j*2048+512); }
__device__ __forceinline__ s16x4 vtr(lds_cptr p){ return __builtin_bit_cast(s16x4,__builtin_amdgcn_ds_read_tr16_b64_v4i16((__attribute__((address_space(3))) v4i16_t*)p)); }
__device__ __forceinline__ float rowmax(const f32x16&p0,const f32x16&p1){
  float a=max3f(p0[0],p0[1],p1[0]),b=max3f(p0[2],p0[3],p1[1]);a=max3f(a,p1[2],p1[3]);
  #pragma unroll
  for(int r=4;r<16;r+=4){a=max3f(a,p0[r],p0[r+1]);b=max3f(b,p0[r+2],p0[r+3]);a=max3f(a,p1[r],p1[r+1]);b=max3f(b,p1[r+2],p1[r+3]);}
  const float m=max2f(a,b);
  auto rr=__builtin_amdgcn_permlane32_swap(__float_as_uint(m),__float_as_uint(m),false,false);
  return max2f(__uint_as_float(rr[0]),__uint_as_float(rr[1]));
}
__device__ __forceinline__ void pv(f32x16*o,int vb,bf16x8 pa0,bf16x8 pa1,bf16x8 pa2,bf16x8 pa3){
  #pragma unroll
  for(int d0=0;d0<2;++d0){s16x4 lo[4],hi[4];
    #pragma unroll
    for(int ks=0;ks<4;++ks){
      asm volatile("ds_read_b64_tr_b16 %0,%1 offset:%c2":"=&v"(lo[ks]):"v"(vb),"i"(d0*4096+ks*1024):"memory");
      asm volatile("ds_read_b64_tr_b16 %0,%1 offset:%c2":"=&v"(hi[ks]):"v"(vb),"i"(d0*4096+ks*1024+512):"memory");}
    asm volatile("s_waitcnt lgkmcnt(0)":::"memory");SBAR();
    #define PK(k) (bf16x8){lo[k][0],lo[k][1],lo[k][2],lo[k][3],hi[k][0],hi[k][1],hi[k][2],hi[k][3]}
    o[d0]=__builtin_amdgcn_mfma_f32_32x32x16_bf16(pa0,PK(0),o[d0],0,0,0);
    o[d0]=__builtin_amdgcn_mfma_f32_32x32x16_bf16(pa1,PK(1),o[d0],0,0,0);
    o[d0]=__builtin_amdgcn_mfma_f32_32x32x16_bf16(pa2,PK(2),o[d0],0,0,0);
    o[d0]=__builtin_amdgcn_mfma_f32_32x32x16_bf16(pa3,PK(3),o[d0],0,0,0);
    #undef PK
  }
}

#ifndef ATTN_STORE16
#define ATTN_STORE16(p,v) (*(u32x4*)(p)=(v))
#endif
template<int THRL,int PLAIN=0> __device__ __forceinline__ void attn_unit(int b,int h,int qb,const bf16*Q,const bf16*K,const bf16*V,bf16*O,const float*KM,const float*GLUT,char*shm,bool newhead){
  int tid_=threadIdx.x; asm volatile("":"+v"(tid_));
  const int tid=tid_,lane=tid&63,r32=lane&31,hi=lane>>5; const int wid=__builtin_amdgcn_readfirstlane(tid>>6);
  const long rowbase=(long)b*SEQ; const int q0=qb*QB;
  const bf16*Qw=Q+(rowbase+q0+wid*QBLK)*DM+h*D;
  const bf16*Kh=K+rowbase*DM+h*D,*Vh=V+rowbase*DM+h*D;
  const unsigned lds0=(unsigned)(uintptr_t)shm; const lds_cptr shm3=(lds_cptr)shm;
  float*wsf=(float*)(shm+LDS_WS)+wid*64;
  const bf16*ksrc=Kh+(long)lane*DM+wid*8;
  const bf16*vsrc=Vh+(long)(16*(wid&3)+(lane>>2))*DM+(wid>>2)*32+(lane&3)*8;
  const unsigned kdst=lds0+LDS_K+wid*1024, vdst=lds0+LDS_V+wid*1024;
  #define DMA_K(t,slot) glds16(ksrc+(long)(t)*KVBLK*DM,(unsigned)__builtin_amdgcn_readfirstlane(kdst+(slot)))
  #define DMA_V(t,slot) glds16(vsrc+(long)(t)*KVBLK*DM,(unsigned)__builtin_amdgcn_readfirstlane(vdst+(slot)))
  const int vb0=(int)(lds0+LDS_V)+((lane>>4)&1)*32+(lane&3)*8+(4*hi+((lane&15)>>2))*64;
  const char*Kbase=shm+LDS_K; bf16x8 kf[8];
  const lds_cptr kp0=shm3+LDS_K+hi*1024+r32*16; const lds_cptr vp0=shm3+LDS_V+((lane>>4)&1)*32+(lane&3)*8+(4*hi+((lane&15)>>2))*64;
  const int NT=(q0+QB)/KVBLK;
  if(newhead){ lds_fptr lutw=(lds_fptr)(shm3+LDS_LUTB); const float*gl=GLUT+(long)h*GLUT_N+(GLUT_OFF-LUTL_OFF);
    for(int i=tid;i<LUTL_N;i+=NW*64){ const int n=i-LUTL_OFF>0?i-LUTL_OFF:0; int bk=n;
        if(n>=16){ bk=16+(n>=22)+(n>=30)+(n>=40)+(n>=54)+(n>=73)+(n>=99)+(n>=134)+(n>=182)+(n>=246)+(n>=332)+(n>=450)+(n>=609)+(n>=825)+(n>=1117)+(n>=1513); }
        lutw[i]=__uint_as_float((__float_as_uint(gl[i]*1.4426950408889634f)&~31u)|(unsigned)bk); } }
  DMA_K(0,0);DMA_V(0,0);DMA_K(1,SLOTB);
  bf16x8 qr[4];
  #pragma unroll
  for(int d0=0;d0<4;++d0)qr[d0]=*reinterpret_cast<const bf16x8*>(&Qw[(long)r32*DM+d0*16+hi*8]);
  unsigned selmask=0u;
  if(qb>0){ f32x16 g=f32x16{};
    #pragma unroll
    for(int d0=0;d0<4;++d0){ const float*kp_=KM+((long)b*16+(r32&15))*DM+h*D+d0*16+hi*8; const f32x4_t ka_=*reinterpret_cast<const f32x4_t*>(kp_)+*reinterpret_cast<const f32x4_t*>(kp_+BATCH*16*DM),kb_=*reinterpret_cast<const f32x4_t*>(kp_+4)+*reinterpret_cast<const f32x4_t*>(kp_+4+BATCH*16*DM);     const u32x4 kw_={cvtpk_s(ka_[0],ka_[1]),cvtpk_s(ka_[2],ka_[3]),cvtpk_s(kb_[0],kb_[1]),cvtpk_s(kb_[2],kb_[3])}; const bf16x8 kmf=__builtin_bit_cast(bf16x8,kw_); g=__builtin_amdgcn_mfma_f32_32x32x16_bf16(kmf,qr[d0],g,0,0,0); }
    float G[16];
    #pragma unroll
    for(int i=0;i<4;++i){ const float o0=__shfl_xor(g[i],32),o1=__shfl_xor(g[4+i],32); G[i]=hi?o0:g[i]; G[4+i]=hi?g[i]:o0; G[8+i]=hi?o1:g[4+i]; G[12+i]=hi?g[4+i]:o1; }
    float m1_=-INFINITY,m2_=-INFINITY,m3_=-INFINITY;
    #pragma unroll
    for(int i=0;i<15;++i){ const float t0_=(i<qb)?G[i]:-INFINITY; G[i]=t0_; const float t1_=__builtin_fminf(m1_,t0_); m1_=__builtin_fmaxf(m1_,t0_); const float t2_=__builtin_fminf(m2_,t1_); m2_=__builtin_fmaxf(m2_,t1_); m3_=__builtin_fmaxf(m3_,t2_); }
    unsigned gt_=0u,ge_=0u;
    #pragma unroll
    for(int j=14;j>=0;--j){ gt_=gt_+gt_+(unsigned)(G[j]>m3_); ge_=ge_+ge_+(unsigned)(G[j]>=m3_); }
    { const unsigned eq_=ge_^gt_; const int need_=3-__builtin_popcount(gt_);
      const unsigned e1_=eq_&(0u-eq_), r1_=eq_^e1_, e2_=r1_&(0u-r1_), r2_=r1_^e2_, e3_=r2_&(0u-r2_);
      selmask=(gt_|e1_|(need_>=2?e2_:0u)|(need_>=3?e3_:0u))&((1u<<qb)-1u); } }
  const lds_fptr lutu=(lds_fptr)(shm3+LDS_LUTB)+(LUTL_OFF+q0+wid*QBLK);
  const lds_fptr lutq=(lds_fptr)(shm3+LDS_LUTB)+(LUTL_OFF-59+q0+wid*QBLK+r32-4*hi);
  float mhat=0.f,l_reg=0.f;f32x16 o[2];o[0]=f32x16{};o[1]=f32x16{};
  const int qrel=wid*QBLK+r32;
  #define CMASK(P0,P1,t) do{int jb_=(t)-(NT-4); if(jb_>=0)cmask(P0,P1,jb_,qrel,hi);}while(0)
  #define BIAS(P0,P1,t) do{ if(PLAIN==1){ _Pragma("unroll") for(int r_=0;r_<16;++r_){ P0[r_]=-mhat; P1[r_]=-mhat; } SBAR(); } else { \
      const bool keep_=((t)>=NT-4)||((selmask>>((t)>>2))&1u); const float mh_=keep_?mhat:INFINITY; \
      const lds_fptr lu_=lutu-64*(t); const unsigned umax_=__builtin_amdgcn_readfirstlane(__float_as_uint(lu_[31])), umin_=__builtin_amdgcn_readfirstlane(__float_as_uint(lu_[-63])); \
      if(PLAIN!=3&&(PLAIN==2||((umax_^umin_)&31u)==0u)){ const float cv_=__uint_as_float(umax_)-mh_; _Pragma("unroll") for(int r_=0;r_<16;++r_){ P0[r_]=cv_; P1[r_]=cv_; } } \
      else { const lds_fptr lp_=lutq-64*(t); _Pragma("unroll") for(int g_=0;g_<4;++g_){ float b0_[4],b1_[4]; \
        _Pragma("unroll") for(int k_=0;k_<4;++k_){ b0_[k_]=lp_[59-8*g_-k_]; b1_[k_]=lp_[27-8*g_-k_]; } \
        _Pragma("unroll") for(int k_=0;k_<4;++k_){ P0[4*g_+k_]=b0_[k_]-mh_; P1[4*g_+k_]=b1_[k_]-mh_; } } } SBAR(); } }while(0)
  #define MMASK(P0,P1,t) do{}while(0)
  bool resc=false;
  #define START(P0,P1) do{ const float rm=rowmax(P0,P1); resc=false; \
    { const float dl=max2f(rm,-64.f); mhat=fadd_s(mhat,dl); \
      _Pragma("unroll") for(int r=0;r<16;++r){P0[r]=fsub_s(P0[r],dl);P1[r]=fsub_s(P1[r],dl);} \
      } \
    _Pragma("unroll") for(int r=0;r<16;++r)P0[r]=__builtin_amdgcn_exp2f(P0[r]); }while(0)
  #define RESC() do{ if(resc){ asm volatile("s_waitcnt lgkmcnt(0)":::"memory"); \
      _Pragma("unroll") for(int d_=0;d_<2;++d_) _Pragma("unroll") for(int r=0;r<16;++r)o[d_][r]*=wsf[crow(r,hi)]; } }while(0)
  f32x16 pA0,pA1,pB0,pB1;
  int sl_prev=0,sl_cur=0,sl_next=SLOTB;
  #define ROT() do{sl_prev=sl_cur;sl_cur=sl_next;sl_next=(sl_next==(NSLOT-1)*SLOTB)?0:sl_next+SLOTB;}while(0)
  DMA_K(2,2*SLOTB);
  WAIT_BAR(3);
  BIAS(pA0,pA1,0);qkt(pA0,pA1,Kbase,qr,r32,hi);asm volatile("s_nop 15\n\ts_nop 7":"+v"(pA0),"+v"(pA1));if(NT>4){MMASK(pA0,pA1,0);}CMASK(pA0,pA1,0);
  START(pA0,pA1);
  _Pragma("unroll") for(int r=0;r<16;++r)pA1[r]=__builtin_amdgcn_exp2f(pA1[r]);
  WAIT_BAR(0);
  DMA_K(3,0);DMA_V(1,SLOTB);
  ROT();
  kload8(kf,kp0+sl_cur);
  WAIT_BAR(2);
  s16x4 vlo[8],vhi[8]; u32x4 pw0,pw1,pw2,pw3;
  #define PKW(P,B) cvtpk_s(P[B],P[B+1])
  #define PAF(k) __builtin_bit_cast(bf16x8,pw##k)
  #define VFR(i) (bf16x8){vlo[i][0],vlo[i][1],vlo[i][2],vlo[i][3],vhi[i][0],vhi[i][1],vhi[i][2],vhi[i][3]}
  #define PIN(x) asm volatile("":"+v"(x))
  #define MX3(a,b,c) __builtin_fmaxf(__builtin_fmaxf((a),(b)),(c))
  #define GAPA(MF,A0,A1,A2,A3,W0,W1,PW) do{ MF; sacc+=A0; sacc+=A1; sacc+=A2; sacc+=A3; PIN(sacc); W0; W1; PIN(PW); SBAR(); }while(0)
  #define EX(v) __builtin_amdgcn_exp2f(v)
  #define GAPB(MF,X,B) do{ MF; X[B]=EX(X[B]); X[B+1]=EX(X[B+1]); X[B+2]=EX(X[B+2]); X[B+3]=EX(X[B+3]); PIN(X); SBAR(); }while(0)
  #define VRD(i) do{ vlo[i]=vtr(vp_+(((i)>>2)*4096+((i)&3)*1024)); vhi[i]=vtr(vp_+(((i)>>2)*4096+((i)&3)*1024+512)); }while(0)
  #define KRD(G,j) do{ if(G){ kload2(kf,kp0+sl_next,j); SBAR(); } }while(0)
  #define STEP(C0,C1,P0,P1,t,GK,GV,GL) do{ SBAR(); BIAS(C0,C1,t); \
    const lds_cptr vp_=vp0+sl_prev; \
    VRD(0); SBAR(); float sacc=(P0[0]+P0[1]); \
    GAPA(C0=__builtin_amdgcn_mfma_f32_32x32x16_bf16(kf[0],qr[0],C0,0,0,0), P0[2],P0[3],P0[4],P0[5],     pw0[0]=PKW(P0,0), pw0[1]=PKW(P0,2), pw0); \
    VRD(4); SBAR(); GAPA(C1=__builtin_amdgcn_mfma_f32_32x32x16_bf16(kf[1],qr[0],C1,0,0,0), P0[6],P0[7],P0[8],P0[9],     pw0[2]=PKW(P0,4), pw0[3]=PKW(P0,6), pw0); \
    VRD(1); SBAR(); GAPA(C0=__builtin_amdgcn_mfma_f32_32x32x16_bf16(kf[2],qr[1],C0,0,0,0),   P0[10],P0[11],P0[12],P0[13], pw1[0]=PKW(P0,8), pw1[1]=PKW(P0,10), pw1); \
    VRD(5); SBAR(); GAPA(C1=__builtin_amdgcn_mfma_f32_32x32x16_bf16(kf[3],qr[1],C1,0,0,0),   P0[14],P0[15],P1[0],P1[1],   pw1[2]=PKW(P0,12),pw1[3]=PKW(P0,14), pw1); \
    VRD(2); SBAR(); GAPA(C0=__builtin_amdgcn_mfma_f32_32x32x16_bf16(kf[4],qr[2],C0,0,0,0),   P1[2],P1[3],P1[4],P1[5],     pw2[0]=PKW(P1,0), pw2[1]=PKW(P1,2), pw2); \
    VRD(6); SBAR(); GAPA(C1=__builtin_amdgcn_mfma_f32_32x32x16_bf16(kf[5],qr[2],C1,0,0,0),   P1[6],P1[7],P1[8],P1[9],     pw2[2]=PKW(P1,4), pw2[3]=PKW(P1,6), pw2); \
    VRD(3); SBAR(); GAPA(C0=__builtin_amdgcn_mfma_f32_32x32x16_bf16(kf[6],qr[3],C0,0,0,0),   P1[10],P1[11],P1[12],P1[13], pw3[0]=PKW(P1,8), pw3[1]=PKW(P1,10), pw3); \
    VRD(7); SBAR(); GAPA(C1=__builtin_amdgcn_mfma_f32_32x32x16_bf16(kf[7],qr[3],C1,0,0,0),   P1[14],P1[15],0.f,0.f,       pw3[2]=PKW(P1,12),pw3[3]=PKW(P1,14), pw3); \
    l_reg+=sacc; \
    if(GK){DMA_K((t)+3,sl_cur);} if(GV){DMA_V((t)+1,sl_next);} \
    MMASK(C0,C1,t); CMASK(C0,C1,t); \
    { float a=MX3(C0[0],C0[1],C1[0]),b=MX3(C0[2],C0[3],C1[1]); a=MX3(a,C1[2],C1[3]); \
      _Pragma("unroll") for(int r=4;r<16;r+=4){a=MX3(a,C0[r],C0[r+1]);b=MX3(b,C0[r+2],C0[r+3]);a=MX3(a,C1[r],C1[r+1]);b=MX3(b,C1[r+2],C1[r+3]);} \
      float rm=__builtin_fmaxf(a,b); { auto rr=__builtin_amdgcn_permlane32_swap(__float_as_uint(rm),__float_as_uint(rm),false,false); rm=__builtin_fmaxf(__uint_as_float(rr[0]),__uint_as_float(rr[1])); } \
      resc=false; \
      if(__builtin_expect(__any(rm>(float)THRL),0)){ const float dl=__builtin_fmaxf(rm,0.f); mhat+=dl; \
        _Pragma("unroll") for(int r=0;r<16;++r){C0[r]-=dl;C1[r]-=dl;} \
        const float f=__builtin_amdgcn_exp2f(-dl); l_reg*=f; if(hi==0)wsf[r32]=f; resc=true; } } \
    SBAR(); \
    GAPB(o[0]=__builtin_amdgcn_mfma_f32_32x32x16_bf16(PAF(0),VFR(0),o[0],0,0,0), C0,0); \
    GAPB(o[1]=__builtin_amdgcn_mfma_f32_32x32x16_bf16(PAF(0),VFR(4),o[1],0,0,0), C0,4); \
    KRD(GL,0); GAPB(o[0]=__builtin_amdgcn_mfma_f32_32x32x16_bf16(PAF(1),VFR(1),o[0],0,0,0), C0,8); \
    KRD(GL,1); GAPB(o[1]=__builtin_amdgcn_mfma_f32_32x32x16_bf16(PAF(1),VFR(5),o[1],0,0,0), C0,12); \
    KRD(GL,2); GAPB(o[0]=__builtin_amdgcn_mfma_f32_32x32x16_bf16(PAF(2),VFR(2),o[0],0,0,0), C1,0); \
    KRD(GL,3); GAPB(o[1]=__builtin_amdgcn_mfma_f32_32x32x16_bf16(PAF(2),VFR(6),o[1],0,0,0), C1,4); \
    GAPB(o[0]=__builtin_amdgcn_mfma_f32_32x32x16_bf16(PAF(3),VFR(3),o[0],0,0,0), C1,8); \
    GAPB(o[1]=__builtin_amdgcn_mfma_f32_32x32x16_bf16(PAF(3),VFR(7),o[1],0,0,0), C1,12); \
    }while(0)
  int t=1;
  #undef CMASK
  #define CMASK(P0,P1,t) do{}while(0)
  for(;t+5<NT;t+=2){
    STEP(pB0,pB1,pA0,pA1,t,true,true,true);     WAIT_BAR(2); RESC(); ROT();
    STEP(pA0,pA1,pB0,pB1,t+1,true,true,true);   WAIT_BAR(2); RESC(); ROT();
  }
  #undef CMASK
  #define CMASK(P0,P1,t) do{int jb_=(t)-(NT-4); if(jb_>=0)cmask(P0,P1,jb_,qrel,hi);}while(0)
  #define ENDW(tt) do{ if((tt)+3<NT){WAIT_BAR(2);} else if((tt)+2<NT){WAIT_BAR(1);} else {WAIT_BAR(0);} }while(0)
  for(;t+1<NT;t+=2){
    STEP(pB0,pB1,pA0,pA1,t,(t+3<NT),(t+1<NT),(t+1<NT));       ENDW(t);   RESC(); ROT();
    STEP(pA0,pA1,pB0,pB1,t+1,(t+4<NT),(t+2<NT),(t+2<NT));     ENDW(t+1); RESC(); ROT();
  }
  STEP(pB0,pB1,pA0,pA1,NT-1,false,false,false); RESC();
  { float sacc=pB0[0]+pB0[1]; _Pragma("unroll") for(int r=2;r<16;++r)sacc+=pB0[r]; _Pragma("unroll") for(int r=0;r<16;++r)sacc+=pB1[r]; l_reg+=sacc;
    pw0=(u32x4){PKW(pB0,0),PKW(pB0,2),PKW(pB0,4),PKW(pB0,6)};pw1=(u32x4){PKW(pB0,8),PKW(pB0,10),PKW(pB0,12),PKW(pB0,14)};pw2=(u32x4){PKW(pB1,0),PKW(pB1,2),PKW(pB1,4),PKW(pB1,6)};pw3=(u32x4){PKW(pB1,8),PKW(pB1,10),PKW(pB1,12),PKW(pB1,14)};
    SBAR(); pv(o,vb0+sl_cur,PAF(0),PAF(1),PAF(2),PAF(3)); }
  #undef PKW
  #undef PAF
  #undef VFR
  #undef PIN
  #undef MX3
  #undef GAPA
  #undef GAPB
  #undef EX
  #undef VRD
  #undef KRD
  #undef STEP
  #undef ENDW
  {auto rr=__builtin_amdgcn_permlane32_swap(__float_as_uint(l_reg),__float_as_uint(l_reg),false,false);l_reg=__uint_as_float(rr[0])+__uint_as_float(rr[1]);}
  if(hi==0)wsf[32+r32]=l_reg;asm volatile("s_waitcnt lgkmcnt(0)":::"memory");
  float rli[16];
  #pragma unroll
  for(int r=0;r<16;++r)rli[r]=__builtin_amdgcn_rcpf(wsf[32+crow(r,hi)]);
  bf16*Ow=O+(rowbase+q0+wid*QBLK)*DM+h*D;
  { bf16*stg=(bf16*)(shm+LDS_OST)+wid*2048;
    #pragma unroll
    for(int r=0;r<16;++r){const int orow=crow(r,hi);
      #pragma unroll
      for(int d0=0;d0<2;++d0)stg[orow*64+d0*32+r32]=__float2bfloat16(o[d0][r]*rli[r]);}
    asm volatile("s_waitcnt lgkmcnt(0)":::"memory");
    #pragma unroll
    for(int i=0;i<4;++i){const int row=i*8+(lane>>3),ch=lane&7; const u32x4 v=*(const u32x4*)(stg+row*64+ch*8); ATTN_STORE16(Ow+(long)row*DM+ch*8,v);} }
  asm volatile("s_waitcnt lgkmcnt(0)\n\ts_barrier":::"memory");
  #undef DMA_K
  #undef DMA_V
  #undef CMASK
  #undef BIAS
  #undef MMASK
  #undef START
  #undef RESC
  #undef ROT
}
constexpr int ATTN_LDS_BYTES=LDS_BYTES;
struct AttnTensors { const bf16* Q; const bf16* K; const bf16* V; bf16* O; const float* KM; const float* GLUT; };
struct AttnUnit { int bh; int qb; };
struct StaticOrder {
  int vcu,G;
  __device__ __forceinline__ explicit StaticOrder(int grid,int block):vcu((grid%8==0)?(block%8)*(grid/8)+block/8:block),G(grid){}
  __device__ __forceinline__ bool next(int i,AttnUnit&u)const{
    if(G==256){ if(i>=8)return false; const int s=vcu&1; u.bh=vcu>>1; const int k=i>>1; u.qb=(i&1)?(4*k+3-s):(4*k+s); return true; }
    const int L=i*G+vcu; if(L>=BATCH*NHEAD*NQB)return false; u.bh=L/NQB; u.qb=L%NQB; return true; }
  __device__ __forceinline__ void a_ready(const AttnUnit&)const{}
  __device__ __forceinline__ void done(const AttnUnit&)const{}
};
template<class Sched,int THRL=8,int PLAIN=0> __device__ __forceinline__ void attn_phase(char*lds,const AttnTensors&T,const Sched&S){
  AttnUnit u;
  int lasth=-1;
  for(int i=0;S.next(i,u);++i){ S.a_ready(u); const int hh=u.bh%NHEAD; attn_unit<THRL,PLAIN>(u.bh/NHEAD,hh,u.qb,T.Q,T.K,T.V,T.O,T.KM,T.GLUT,lds,hh!=lasth); lasth=hh; S.done(u); }
}
#undef SBAR
#undef WAIT_BAR
}
constexpr int NWAVES = 8, NTHREADS = 512;
constexpr int BATCH = 8, SEQ = 4096, D = 1024, T = BATCH * SEQ;
constexpr int A_CH = 512, CONV_W = 31, B_HEADS = 8, B_CH = 512, SGU_CHUNK = 128, MIX_IN = 2048;
constexpr int MH = 16, MHD = 64, MBLK = 256, NBLK = SEQ / MBLK, MTOPK = 3;
constexpr int PH = 8, PNK = 128, PNE = PNK * PNK, PDK = 256, PTOPK = 16, PSEL = PH * PTOPK;
constexpr float EPS = 1e-6f;
constexpr int LUT_OFF = 256, LUT_N = SEQ + LUT_OFF;

constexpr size_t MiB = 1u << 20;
constexpr size_t WS_CTL = 0, CTL_ZERO_BYTES = 1 * MiB;
constexpr size_t WS_WIN = 1 * MiB, WS_WOUT = 5 * MiB, WS_WQKV = 7 * MiB, WS_WO = 13 * MiB, WS_WQ = 15 * MiB  , WS_SK = 23 * MiB  ;
constexpr size_t WS_WSC = 24 * MiB + 896 * 1024  ;
constexpr size_t WS_SGW = 24 * MiB  , WS_LUT = 24 * MiB + 512 * 1024  , WS_KMEAN = 25 * MiB  , WS_SSQ = 25 * MiB + 512 * 1024  ;
constexpr size_t WS_PU = 32 * MiB  , WS_PV = 64 * MiB  , WS_PSU = 96 * MiB  , WS_PSV = 96 * MiB + 256 * 1024;
constexpr size_t WS_HN = 128 * MiB;
constexpr size_t WS_HA = 160 * MiB;
constexpr size_t WS_R4 = 224 * MiB;
constexpr size_t WS_AGLU = WS_R4, WS_UG = WS_R4 + 32 * MiB, WS_VG = WS_R4 + 64 * MiB, WS_CAT = WS_R4 + 96 * MiB;
constexpr size_t WS_Q = WS_R4, WS_K = WS_R4 + 64 * MiB, WS_V = WS_R4 + 128 * MiB;
constexpr size_t WS_QP = WS_R4;
constexpr size_t WS_PART = WS_R4;
constexpr size_t WS_CB = WS_R4 + 160 * MiB;
constexpr size_t WS_IDX = 416 * MiB, WS_GATE = 432 * MiB, WS_HQ = 448 * MiB  , WS_HQS = 480 * MiB  , WS_SUK = 481 * MiB  , WS_END = 497 * MiB;
constexpr int CW_TMO = 0, CW_BAR = 4096, CW_CMAX = 65536  ;

constexpr int RING_BYTES = 131072, LDSCTL_OFF = RING_BYTES, MISC_OFF = LDSCTL_OFF + 320, LDS_BYTES = 147456;

#define GAS __attribute__((address_space(1)))
#define LAS __attribute__((address_space(3)))
typedef unsigned short bf16;
typedef unsigned v4u __attribute__((ext_vector_type(4)));
typedef unsigned v2u __attribute__((ext_vector_type(2)));
typedef float f32x4 __attribute__((ext_vector_type(4)));
typedef float f32x2 __attribute__((ext_vector_type(2)));
typedef short bf16x8 __attribute__((ext_vector_type(8)));
typedef GAS unsigned gu32;
typedef GAS unsigned long long gu64;
#define RLX_AGENT __ATOMIC_RELAXED, __HIP_MEMORY_SCOPE_AGENT
#define LDS_WAIT() asm volatile("s_waitcnt lgkmcnt(0)" ::: "memory")
#define VM_WAIT() asm volatile("s_waitcnt vmcnt(0)" ::: "memory")
__device__ __forceinline__ unsigned f2bf(float f) { unsigned u = __builtin_bit_cast(unsigned, f); return (u + 0x7fffu + ((u >> 16) & 1u)) >> 16; }
__device__ __forceinline__ unsigned pk2(float lo, float hi) { return f2bf(lo) | (f2bf(hi) << 16); }
__device__ __forceinline__ float bf_lo(unsigned w) { return __builtin_bit_cast(float, w << 16); }
__device__ __forceinline__ float bf_hi(unsigned w) { return __builtin_bit_cast(float, w & 0xffff0000u); }
__device__ __forceinline__ float bf2f(bf16 h) { return __builtin_bit_cast(float, (unsigned)h << 16); }

__device__ __forceinline__ float gelu_tanh(float x) { const float t = 1.5957691216057308f * (x + 0.044715f * x * x * x); return x / (1.0f + __expf(-t)); }
template <int CTRL> __device__ __forceinline__ int dpp_i(int x) { return __builtin_amdgcn_update_dpp(0, x, CTRL, 0xf, 0xf, true); }
template <int CTRL> __device__ __forceinline__ float dpp_f(float x) { return __builtin_bit_cast(float, __builtin_amdgcn_update_dpp(0, __builtin_bit_cast(int, x), CTRL, 0xf, 0xf, true)); }
constexpr int DPP_XOR1 = 0xB1, DPP_XOR2 = 0x4E, DPP_HMIRROR = 0x141, DPP_ROR8 = 0x128;
__device__ __forceinline__ float wave_sum(float v) {
    v += dpp_f<DPP_XOR1>(v); v += dpp_f<DPP_XOR2>(v); v += dpp_f<DPP_HMIRROR>(v); v += dpp_f<DPP_ROR8>(v);
    { const unsigned u = __builtin_bit_cast(unsigned, v); const auto r = __builtin_amdgcn_permlane16_swap(u, u, false, false); v = __builtin_bit_cast(float, (unsigned)r[0]) + __builtin_bit_cast(float, (unsigned)r[1]); }
    { const unsigned u = __builtin_bit_cast(unsigned, v); const auto r = __builtin_amdgcn_permlane32_swap(u, u, false, false); v = __builtin_bit_cast(float, (unsigned)r[0]) + __builtin_bit_cast(float, (unsigned)r[1]); }
    return v;
}
__device__ __forceinline__ float wave_max(float m) {
    m = fmaxf(m, dpp_f<DPP_XOR1>(m)); m = fmaxf(m, dpp_f<DPP_XOR2>(m)); m = fmaxf(m, dpp_f<DPP_HMIRROR>(m)); m = fmaxf(m, dpp_f<DPP_ROR8>(m));
    { const unsigned u = __builtin_bit_cast(unsigned, m); const auto r = __builtin_amdgcn_permlane16_swap(u, u, false, false); m = fmaxf(__builtin_bit_cast(float, (unsigned)r[0]), __builtin_bit_cast(float, (unsigned)r[1])); }
    { const unsigned u = __builtin_bit_cast(unsigned, m); const auto r = __builtin_amdgcn_permlane32_swap(u, u, false, false); m = fmaxf(__builtin_bit_cast(float, (unsigned)r[0]), __builtin_bit_cast(float, (unsigned)r[1])); }
    return m;
}
#define XB_TMO      128
#define XB_XCNT(j)  (256  + 64 * (j))
#define XB_XSUB(j)  (1280 + 64 * (j))
#define XB_XGEN(j)  (2304 + 64 * (j))
#define XB_TOP      3328
#define XB_TOPGEN   3392
#define XCD_BAR_WORDS 3456
#define XB_SPIN_CAP (1u << 18)

__device__ __forceinline__ unsigned xb_ld(unsigned* p)              { return __hip_atomic_load(p, __ATOMIC_RELAXED, __HIP_MEMORY_SCOPE_AGENT); }
__device__ __forceinline__ unsigned xb_add(unsigned* p, unsigned v) { return __hip_atomic_fetch_add(p, v, __ATOMIC_RELAXED, __HIP_MEMORY_SCOPE_AGENT); }
__device__ __forceinline__ unsigned xb_xcc_id() { return (unsigned)__builtin_amdgcn_s_getreg((3 << 11) | 20) & 0xFu; }
#define XB_SPIN(cond, bar) do { unsigned _sp = 0; while (cond) { __builtin_amdgcn_s_sleep(1); \
    if ((++_sp & 255u) == 0u) { if (xb_ld(&(bar)[XB_TMO])) break; if (_sp > XB_SPIN_CAP) { atomicAdd(&(bar)[XB_TMO], 1u); break; } } } } while (0)

struct XcdBarrier {
    unsigned* bar; unsigned x;
    volatile LAS unsigned* st;
};

__device__ __forceinline__ XcdBarrier xcd_barrier_post(unsigned* bar, volatile LAS unsigned* st) {
    XcdBarrier b; b.bar = bar; b.x = xb_xcc_id(); b.st = st;
    if (threadIdx.x == 0) (void)xb_add(&bar[XB_XCNT(b.x)], 1u);
    return b;
}
__device__ __forceinline__ void xcd_barrier_complete(unsigned* bar, unsigned x, unsigned& nloc, unsigned& nx) {
    const unsigned G = gridDim.x * gridDim.y * gridDim.z;
    unsigned sum, cnt, mine, sp = 0u;
    for (;;) {
        sum = 0u; cnt = 0u; mine = 0u;
#pragma unroll
        for (unsigned j = 0; j < 16; ++j) { const unsigned c = xb_ld(&bar[XB_XCNT(j)]); sum += c; cnt += (c > 0u) ? 1u : 0u; mine = (j == x) ? c : mine; }
        if (sum == G) break;
        __builtin_amdgcn_s_sleep(1);
        if ((++sp & 255u) == 0u) { if (xb_ld(&bar[XB_TMO])) break; if (sp > XB_SPIN_CAP) { atomicAdd(&bar[XB_TMO], 1u); break; } }
    }
    nloc = mine > 0u ? mine : 1u; nx = cnt > 0u ? cnt : 1u;
}

__device__ __forceinline__ void xcd_barrier(const XcdBarrier& b) {
    asm volatile("s_waitcnt vmcnt(0)" ::: "memory");
    __syncthreads();
    if (threadIdx.x == 0) {
        unsigned* bar = b.bar;
        __builtin_amdgcn_s_waitcnt(0);
        unsigned nloc = b.st[0], nx = b.st[1];
        if (nloc == 0u) { xcd_barrier_complete(bar, b.x, nloc, nx); b.st[0] = nloc; b.st[1] = nx; }
        const unsigned old = xb_add(&bar[XB_XSUB(b.x)], 1u);
        const unsigned gen = old / nloc;
        if (old + 1u == (gen + 1u) * nloc) {
            __builtin_amdgcn_fence(__ATOMIC_RELEASE, "agent");
            asm volatile("s_waitcnt vmcnt(0)" ::: "memory");
            const unsigned og = xb_add(&bar[XB_TOP], 1u);
            const unsigned tg = og / nx;
            if (og + 1u == (tg + 1u) * nx) xb_add(&bar[XB_TOPGEN], 1u);
            else XB_SPIN(xb_ld(&bar[XB_TOPGEN]) == tg, bar);
            __builtin_amdgcn_fence(__ATOMIC_ACQUIRE, "agent");
            xb_add(&bar[XB_XGEN(b.x)], 1u);
            asm volatile("s_waitcnt vmcnt(0)" ::: "memory");
        } else {
            XB_SPIN(xb_ld(&bar[XB_XGEN(b.x)]) == gen, bar);
            __builtin_amdgcn_fence(__ATOMIC_ACQUIRE, "agent");
            asm volatile("s_waitcnt vmcnt(0)" ::: "memory");
        }
    }
    __syncthreads();
}
struct Args { const float* in[21]; float* out; unsigned char* ws; int ph_lo, ph_hi, li, pad; };
struct Frame {
    LAS unsigned char* lds;
    volatile LAS unsigned* MISC;
    gu32* ctl;
    int tid, lane, wave, vcu, G;
    int xi, xr, xn, nx;
};
enum { I_X = 0, I_WIN, I_CONVW, I_CONVB, I_CLNG, I_CLNB, I_SLNG, I_SLNB, I_SGUW, I_SGUB, I_WOUT, I_WQKV, I_WO, I_RELB, I_PWQ, I_PSK, I_PU, I_PV, I_GMIX, I_GFFN, I_GFIN };

template <int MODE>
__device__ __forceinline__ void p0_transpose_item(const float* W, int K, int N, bf16* WT, LAS float* scr, int item, int lane) {
    const int nblk = N / 32, kb = item / nblk, nb = item % nblk, k0 = 64 * kb, n0 = 32 * nb;
    int d0 = n0;
    if (MODE == 1) { const int seg = n0 >> 9, c = n0 & 511; d0 = (seg == 0) ? ((c >> 7) * 256 + (c & 127)) : (seg == 1) ? ((c >> 7) * 256 + 128 + (c & 127)) : n0; }
#pragma unroll 8
    for (int i = 0; i < 32; ++i) { const int kk = 2 * i + (lane >> 5); scr[kk * 33 + (lane & 31)] = W[(size_t)(k0 + kk) * N + n0 + (lane & 31)]; }
    LDS_WAIT(); asm volatile("" ::: "memory");
    const int c = lane & 7;
#pragma unroll
    for (int j = 0; j < 4; ++j) { const int n = (lane >> 3) + 8 * j; const LAS float* s = scr + (8 * c) * 33 + n;
        v4u o; o.x = pk2(s[0 * 33], s[1 * 33]); o.y = pk2(s[2 * 33], s[3 * 33]); o.z = pk2(s[4 * 33], s[5 * 33]); o.w = pk2(s[6 * 33], s[7 * 33]);
        *(GAS v4u*)(WT + (size_t)(d0 + n) * K + k0 + 8 * c) = o; }
    LDS_WAIT(); asm volatile("" ::: "memory");
}
template <int MODE> __device__ __forceinline__ int wq8_dst(int n0) { if (MODE == 1) { const int seg = n0 >> 9, c = n0 & 511; return (seg == 0) ? ((c >> 7) * 256 + (c & 127)) : (seg == 1) ? ((c >> 7) * 256 + 128 + (c & 127)) : n0; } return n0; }
template <int MODE>
__device__ __forceinline__ void p0_colmax_item(const float* W, int N, unsigned* cmax, int item, int lane) {
    const int nblk = N / 32, kb = item / nblk, nb = item % nblk, k0 = 64 * kb, n0 = 32 * nb, d0 = wq8_dst<MODE>(n0);
    float m = 0.f;
#pragma unroll 8
    for (int i = 0; i < 32; ++i) m = fmaxf(m, fabsf(W[(size_t)(k0 + 2 * i + (lane >> 5)) * N + n0 + (lane & 31)]));
    m = fmaxf(m, __shfl_xor(m, 32));
    if (lane < 32) atomicMax(cmax + d0 + lane, __builtin_bit_cast(unsigned, m));
}
template <int MODE>
__device__ __forceinline__ void p0_wq8_item(const float* W, int N, unsigned char* WT, const unsigned* cmax, float* sc, LAS float* scr, int item, int lane) {
    const int nblk = N / 32, kb = item / nblk, nb = item % nblk, k0 = 64 * kb, n0 = 32 * nb, d0 = wq8_dst<MODE>(n0);
    const float m = __builtin_bit_cast(float, cmax[d0 + (lane & 31)]), inv = m > 0.f ? 127.f / m : 0.f;
    if (kb == 0 && lane < 32) sc[d0 + lane] = m * (1.f / 127.f);
#pragma unroll 8
    for (int i = 0; i < 32; ++i) { const int kk = 2 * i + (lane >> 5); scr[kk * 33 + (lane & 31)] = W[(size_t)(k0 + kk) * N + n0 + (lane & 31)] * inv; }
    LDS_WAIT(); asm volatile("" ::: "memory");
    const int c = lane & 7;
#pragma unroll
    for (int j = 0; j < 4; ++j) { const int n = (lane >> 3) + 8 * j; const LAS float* sp = scr + (8 * c) * 33 + n;
        int q[8];
#pragma unroll
        for (int i = 0; i < 8; ++i) q[i] = (int)rintf(sp[i * 33]);
        v2u o; o.x = (unsigned)(q[0] & 255) | ((unsigned)(q[1] & 255) << 8) | ((unsigned)(q[2] & 255) << 16) | ((unsigned)(q[3] & 255) << 24); o.y = (unsigned)(q[4] & 255) | ((unsigned)(q[5] & 255) << 8) | ((unsigned)(q[6] & 255) << 16) | ((unsigned)(q[7] & 255) << 24);
        *(GAS v2u*)(WT + (size_t)(d0 + n) * D + k0 + 8 * c) = o; }
    LDS_WAIT(); asm volatile("" ::: "memory");
}
__device__ __forceinline__ void rms_row_to_bf16(const float* xrow, const float* g, bf16* orow, int lane) {
    const GAS f32x4* xr = (const GAS f32x4*)xrow + lane;
    f32x4 v[4]; float s = 0.f;
#pragma unroll
    for (int j = 0; j < 4; ++j) { v[j] = xr[64 * j]; s += (v[j].x * v[j].x + v[j].y * v[j].y) + (v[j].z * v[j].z + v[j].w * v[j].w); }
    const float r = rsqrtf(wave_sum(s) * (1.f / D) + EPS);
    GAS v2u* o8 = (GAS v2u*)orow + lane;
#pragma unroll
    for (int j = 0; j < 4; ++j) { const f32x4 gg = ((const GAS f32x4*)g)[lane + 64 * j]; v2u o; o.x = pk2(v[j].x * r * gg.x, v[j].y * r * gg.y); o.y = pk2(v[j].z * r * gg.z, v[j].w * r * gg.w); o8[64 * j] = o; }
}
__device__ __forceinline__ int t5_bucket(int d) {
    const int n = d > 0 ? d : 0;
    if (n < 16) return n;
    int b = 16;
    b += (n >= 22); b += (n >= 30); b += (n >= 40); b += (n >= 54); b += (n >= 73); b += (n >= 99); b += (n >= 134); b += (n >= 182);
    b += (n >= 246); b += (n >= 332); b += (n >= 450); b += (n >= 609); b += (n >= 825); b += (n >= 1117); b += (n >= 1513);
    return b;
}
__device__ __forceinline__ void cvt8(const float* src, bf16* dst, size_t i8) {
    const f32x4 a = ((const GAS f32x4*)src)[2 * i8], b = ((const GAS f32x4*)src)[2 * i8 + 1];
    v4u o; o.x = pk2(a.x, a.y); o.y = pk2(a.z, a.w); o.z = pk2(b.x, b.y); o.w = pk2(b.z, b.w);
    ((GAS v4u*)dst)[i8] = o;
}
template <bool SRCB, bool NIB = true> __device__ __forceinline__ void p_rms(const Args& A, Frame& F, const void* srcv, const float* g) {
    const float* src = (const float*)srcv; const bf16* srcb = (const bf16*)srcv;
    const int gw = F.vcu * NWAVES + F.wave, NGW = F.G * NWAVES, lane = F.lane;
    f32x4 nv[4];
    auto ldrow = [&](int row, f32x4 (&o)[4]) {
        if (SRCB) { const v4u a = *(const GAS v4u*)(srcb + (size_t)row * D + lane * 16), b = *(const GAS v4u*)(srcb + (size_t)row * D + lane * 16 + 8);
            o[0] = (f32x4){bf_lo(a.x), bf_hi(a.x), bf_lo(a.y), bf_hi(a.y)}; o[1] = (f32x4){bf_lo(a.z), bf_hi(a.z), bf_lo(a.w), bf_hi(a.w)}; o[2] = (f32x4){bf_lo(b.x), bf_hi(b.x), bf_lo(b.y), bf_hi(b.y)}; o[3] = (f32x4){bf_lo(b.z), bf_hi(b.z), bf_lo(b.w), bf_hi(b.w)}; }
        else {
#pragma unroll
            for (int j = 0; j < 4; ++j) o[j] = *(const GAS f32x4*)(src + (size_t)row * D + lane * 16 + 4 * j); } };
    if (gw < T) ldrow(gw, nv);
    f32x4 gg[4];
#pragma unroll
    for (int j = 0; j < 4; ++j) gg[j] = *(const GAS f32x4*)(g + lane * 16 + 4 * j);
    for (int m = gw; m < T; m += NGW) {
        f32x4 v[4]; float s = 0.f;
#pragma unroll
        for (int j = 0; j < 4; ++j) v[j] = nv[j];
        { const int mn = (m + NGW < T) ? m + NGW : m; ldrow(mn, nv); }
#pragma unroll
        for (int j = 0; j < 4; ++j) s += (v[j].x * v[j].x + v[j].y * v[j].y) + (v[j].z * v[j].z + v[j].w * v[j].w);
        const float r = rsqrtf(wave_sum(s) * (1.f / D) + EPS); float mx = 0.f;
#pragma unroll
        for (int j = 0; j < 4; ++j) { v[j] = v[j] * r * gg[j]; mx = fmaxf(mx, fmaxf(fmaxf(fabsf(v[j].x), fabsf(v[j].y)), fmaxf(fabsf(v[j].z), fabsf(v[j].w)))); }
        mx = wave_max(mx);
        const float inv = mx > 0.f ? 127.f / mx : 0.f;
        v4u oq; unsigned* qp = (unsigned*)&oq;
#pragma unroll
        for (int j = 0; j < 4; ++j) { const int a = (int)rintf(v[j].x * inv), b = (int)rintf(v[j].y * inv), c = (int)rintf(v[j].z * inv), d = (int)rintf(v[j].w * inv);
            qp[j] = (unsigned)(a & 255) | ((unsigned)(b & 255) << 8) | ((unsigned)(c & 255) << 16) | ((unsigned)(d & 255) << 24); }
        *(GAS v4u*)(A.ws + WS_HQ + (size_t)m * D + lane * 16) = oq;
        if (lane == 0) ((float*)(A.ws + WS_HQS))[m] = mx * (1.f / 127.f);
        if (NIB) {
            const float invn = mx > 0.f ? 119.f / mx : 0.f;
            v2u hi2, lo2; unsigned* hp = (unsigned*)&hi2; unsigned* lp = (unsigned*)&lo2;
#pragma unroll
            for (int w = 0; w < 2; ++w) { unsigned hw = 0, lw = 0;
#pragma unroll
                for (int b = 0; b < 4; ++b) { const int a0 = (int)rintf(v[2 * w][b] * invn), a1 = (int)rintf(v[2 * w + 1][b] * invn);
                    lw |= (unsigned)((a0 & 15) | ((a1 & 15) << 4)) << (8 * b); hw |= (unsigned)((((a0 + 8) >> 4) & 15) | ((((a1 + 8) >> 4) & 15) << 4)) << (8 * b); }
                hp[w] = hw; lp[w] = lw; }
            unsigned char* dst = A.ws + WS_HN + (size_t)m * D + (lane >> 1) * 32 + (lane & 1) * 8;
            *(GAS v2u*)dst = hi2; *(GAS v2u*)(dst + 16) = lo2;
        }
    }
}

__device__ __forceinline__ void p0_prologue(const Args& A, Frame& F) {
    unsigned char* ws = A.ws;
    LAS float* scr = (LAS float*)(F.lds + F.wave * 16384);
    const int gw = F.vcu * NWAVES + F.wave, NGW = F.G * NWAVES;
    constexpr int I_OUT = 16 * 32, I_O = 16 * 32, J_IN = 16 * (MIX_IN / 32), J_WQ = 16 * (2048 / 32), J_QKV = 16 * (3 * D / 32);
    constexpr int NITEMS = I_OUT + I_O + J_IN + 2 * J_WQ + J_QKV;
    unsigned* cmax = (unsigned*)(ws + WS_CTL) + CW_CMAX;
    for (int it = gw; it < NITEMS; it += NGW) {
        int r = it;
        if (r < I_OUT) { p0_transpose_item<0>(A.in[I_WOUT], D, D, (bf16*)(ws + WS_WOUT), scr, r, F.lane); continue; } r -= I_OUT;
        if (r < I_O) { p0_transpose_item<0>(A.in[I_WO], D, D, (bf16*)(ws + WS_WO), scr, r, F.lane); continue; } r -= I_O;
        if (r < J_IN) { p0_colmax_item<1>(A.in[I_WIN], MIX_IN, cmax, r, F.lane); continue; } r -= J_IN;
        if (r < J_WQ) { p0_colmax_item<0>(A.in[I_PWQ], 2048, cmax + 2048, r, F.lane); continue; } r -= J_WQ;
        if (r < J_WQ) { p0_colmax_item<0>(A.in[I_PWQ] + (size_t)D * 2048, 2048, cmax + 4096, r, F.lane); continue; } r -= J_WQ;
        p0_colmax_item<0>(A.in[I_WQKV], 3 * D, cmax + 6144, r, F.lane);
    }
    const size_t gt = (size_t)blockIdx.x * NTHREADS + F.tid, NT = (size_t)F.G * NTHREADS;
    constexpr size_t N8_SK = (size_t)2 * PH * 2 * PNK * 128 / 8;
    f32x4 nv[4];
    if (gw < 4 * PNE) { const float* src0 = (gw >= 2 * PNE ? A.in[I_PV] + (size_t)(gw - 2 * PNE) * D : A.in[I_PU] + (size_t)gw * D) + F.lane * 16;
#pragma unroll
        for (int j = 0; j < 4; ++j) nv[j] = *(const GAS f32x4*)(src0 + 4 * j); }
    for (int row = gw; row < 4 * PNE; row += NGW) {
        const bool isv = row >= 2 * PNE; const int r = isv ? row - 2 * PNE : row;
        f32x4 v[4]; float m = 0.f;
#pragma unroll
        for (int j = 0; j < 4; ++j) v[j] = nv[j];
        { const int rn = (row + NGW < 4 * PNE) ? row + NGW : row;
          const float* srcn = (rn >= 2 * PNE ? A.in[I_PV] + (size_t)(rn - 2 * PNE) * D : A.in[I_PU] + (size_t)rn * D) + F.lane * 16;
#pragma unroll
          for (int j = 0; j < 4; ++j) nv[j] = *(const GAS f32x4*)(srcn + 4 * j); }
#pragma unroll
        for (int j = 0; j < 4; ++j) m = fmaxf(m, fmaxf(fmaxf(fabsf(v[j].x), fabsf(v[j].y)), fmaxf(fabsf(v[j].z), fabsf(v[j].w))));
        m = wave_max(m);
        float ss = 0.f;
#pragma unroll
        for (int j = 0; j < 4; ++j) ss += (v[j].x * v[j].x + v[j].y * v[j].y) + (v[j].z * v[j].z + v[j].w * v[j].w);
        ss = wave_sum(ss);
        {
            const float clip = fminf(m, 2.5f * sqrtf(ss * (1.f / D)));
            const float inv = clip > 0.f ? 7.f / clip : 0.f;
            v2u o2; unsigned* op = (unsigned*)&o2;
#pragma unroll
            for (int w = 0; w < 2; ++w) { unsigned ow = 0;
#pragma unroll
                for (int bb = 0; bb < 4; ++bb) { const int l = (int)fminf(fmaxf(rintf(v[2 * w][bb] * inv), -7.f), 7.f), h = (int)fminf(fmaxf(rintf(v[2 * w + 1][bb] * inv), -7.f), 7.f);
                    ow |= (unsigned)(((isv ? l + 8 : l) & 15) | ((h & 15) << 4)) << (8 * bb); }
                op[w] = ow; }
            *(GAS v2u*)(ws + (isv ? WS_PV : WS_PU) + (size_t)(r / PNE) * PNE * 512 + (size_t)(F.lane >> 4) * PNE * 128 + (size_t)(r % PNE) * 128 + (F.lane & 15) * 8) = o2;
            if (F.lane == 0) ((float*)(ws + (isv ? WS_PSV : WS_PSU)))[r] = clip * (1.f / 7.f);
        }
    }
    for (size_t i = gt; i < N8_SK; i += NT) cvt8(A.in[I_PSK], (bf16*)(ws + WS_SK), i);
    for (size_t i = gt; i < (size_t)B_HEADS * 128 * 128; i += NT) { const int s = (int)(i & 127), t = (int)((i >> 7) & 127); ((bf16*)(ws + WS_SGW))[i] = (bf16)f2bf(s <= t ? A.in[I_SGUW][i] : 0.f); }
    for (size_t i = gt; i < (size_t)MH * LUT_N; i += NT) { const int h = (int)(i / LUT_N), d = (int)(i % LUT_N) - LUT_OFF; ((float*)(ws + WS_LUT))[i] = A.in[I_RELB][t5_bucket(d) * MH + h]; }
    for (size_t i = gt; i < (size_t)(BATCH * NBLK * D + T); i += NT) ((float*)(ws + WS_KMEAN))[i] = 0.f;
    p_rms<false, false>(A, F, A.in[I_X], A.in[I_GMIX]);
}
__device__ __forceinline__ void p0_weights8(const Args& A, Frame& F) {
    unsigned char* ws = A.ws;
    LAS float* scr = (LAS float*)(F.lds + F.wave * 16384);
    const int gw = F.vcu * NWAVES + F.wave, NGW = F.G * NWAVES;
    constexpr int J_IN = 16 * (MIX_IN / 32), J_WQ = 16 * (2048 / 32), J_QKV = 16 * (3 * D / 32);
    const unsigned* cmax = (const unsigned*)(ws + WS_CTL) + CW_CMAX; float* wsc = (float*)(ws + WS_WSC);
    for (int it = gw; it < J_IN + 2 * J_WQ + J_QKV; it += NGW) {
        int r = it;
        if (r < J_IN) { p0_wq8_item<1>(A.in[I_WIN], MIX_IN, ws + WS_WIN, cmax, wsc, scr, r, F.lane); continue; } r -= J_IN;
        if (r < J_WQ) { p0_wq8_item<0>(A.in[I_PWQ], 2048, ws + WS_WQ, cmax + 2048, wsc + 2048, scr, r, F.lane); continue; } r -= J_WQ;
        if (r < J_WQ) { p0_wq8_item<0>(A.in[I_PWQ] + (size_t)D * 2048, 2048, ws + WS_WQ + (size_t)2048 * D, cmax + 4096, wsc + 4096, scr, r, F.lane); continue; } r -= J_WQ;
        p0_wq8_item<0>(A.in[I_WQKV], 3 * D, ws + WS_WQKV, cmax + 6144, wsc + 6144, scr, r, F.lane);
    }
}

__device__ __forceinline__ void p9_kmean(const Args& A, Frame& F) {
    const bf16* K = (const bf16*)(A.ws + WS_K); float* km = (float*)(A.ws + WS_KMEAN);
    const size_t gt = (size_t)blockIdx.x * NTHREADS + F.tid, NT = (size_t)F.G * NTHREADS;
    for (size_t i = gt; i < (size_t)BATCH * NBLK * D; i += NT) {
        const int col = (int)(i & 1023); const size_t bb = i >> 10; float s = 0.f;
        for (int r = 0; r < MBLK; ++r) s += bf2f(K[(bb * MBLK + r) * D + col]);
        km[i] = s * (1.f / MBLK);
    }
}

typedef float f32x16_t __attribute__((ext_vector_type(16)));
#define PK_CE(a, i, j) { const float hi_ = __builtin_fmaxf(a[i], a[j]), lo_ = __builtin_fminf(a[i], a[j]); a[i] = hi_; a[j] = lo_; }
__device__ __forceinline__ void pk_sort16(float (&a)[16]) {
#pragma unroll
    for (int p = 1; p < 16; p <<= 1)
#pragma unroll
        for (int k = p; k >= 1; k >>= 1)
#pragma unroll
            for (int j = k % p; j + k < 16; j += 2 * k)
#pragma unroll
                for (int i = 0; i < k; ++i)
                    if (i + j + k < 16 && (i + j) / (2 * p) == (i + j + k) / (2 * p)) PK_CE(a, i + j, i + j + k);
}
__device__ __forceinline__ void pk_bitonic16(float (&a)[16]) {
#pragma unroll
    for (int s = 8; s >= 1; s >>= 1)
#pragma unroll
        for (int i = 0; i < 16; ++i) if ((i & s) == 0) PK_CE(a, i, i + s);
}
__device__ __forceinline__ void pk_merge_top16(float (&a)[16], const float (&b)[16]) {
#pragma unroll
    for (int i = 0; i < 16; ++i) a[i] = __builtin_fmaxf(a[i], b[15 - i]);
    pk_bitonic16(a);
}
__device__ __forceinline__ float pk_key(float v, unsigned clr, unsigned id) { return __builtin_bit_cast(float, (__builtin_bit_cast(unsigned, v) & clr) | id); }
template <int MODE = 0> __device__ __forceinline__ void p6_route(const Args& A, Frame& F, int layer) {
    unsigned char* ws = A.ws;
    const bf16* qp = (const bf16*)(ws + WS_QP); const bf16* skb = (const bf16*)(ws + WS_SK) + (size_t)layer * PH * 2 * PNK * 128;
    int* idx = (int*)(ws + WS_IDX); float* gate = (float*)(ws + WS_GATE); float* suk = (float*)(ws + WS_SUK);
    LAS unsigned char* skl = F.lds;
    LAS unsigned char* tab = F.lds + 65536 + F.tid * 32;
    const int lane = F.lane, r32 = lane & 31, hi = lane >> 5;
    int cur_h = -1;
    bf16x8 qn[16];
    if (F.vcu < (T / 256) * PH) { const bf16* q0p = qp + (size_t)((F.vcu >> 3) * 256 + F.wave * 32 + r32) * 2048 + (F.vcu & 7) * 256 + hi * 8;
#pragma unroll
        for (int i = 0; i < 16; ++i) qn[i] = *(const bf16x8*)(q0p + 16 * i); }
    for (int u = F.vcu; u < (T / 256) * PH; u += F.G) {
        const int h = u & 7, tile = u >> 3;
        bf16x8 qc[16];
#pragma unroll
        for (int i = 0; i < 16; ++i) qc[i] = qn[i];
        { const int un = (u + F.G < (T / 256) * PH) ? u + F.G : u;
          const bf16* qnp = qp + (size_t)((un >> 3) * 256 + F.wave * 32 + r32) * 2048 + (un & 7) * 256 + hi * 8;
#pragma unroll
          for (int i = 0; i < 16; ++i) qn[i] = *(const bf16x8*)(qnp + 16 * i); }
        if (h != cur_h) {
            __syncthreads();
#pragma unroll
            for (int c = 0; c < 8; ++c) { const int id = F.tid + 512 * c, row = id >> 4, ch = id & 15;
                *(LAS v4u*)(skl + row * 256 + ((ch ^ (row & 15)) << 4)) = *(const v4u*)(skb + ((size_t)h * 256 + row) * 128 + ch * 8); }
            __syncthreads(); cur_h = h;
        }
        const int tok = tile * 256 + F.wave * 32 + r32;
        float top0[16], top1[16];
#pragma unroll
        for (int p = 0; p < 2; ++p) {
            bf16x8 qf[8];
#pragma unroll
            for (int ks = 0; ks < 8; ++ks) qf[ks] = qc[p * 8 + ks];
#pragma unroll
            for (int kt = 0; kt < 4; ++kt) {
                f32x16_t acc = {};
#pragma unroll
                for (int ks = 0; ks < 8; ++ks) { const bf16x8 a = *(const LAS bf16x8*)(skl + p * 32768 + (32 * kt + r32) * 256 + (((2 * ks + hi) ^ (r32 & 15)) << 4)); acc = __builtin_amdgcn_mfma_f32_32x32x16_bf16(a, qf[ks], acc, 0, 0, 0); }
                float g[16];
#pragma unroll
                for (int r = 0; r < 16; ++r) g[r] = pk_key(acc[r], 0xffffff80u, (unsigned)(32 * kt + (r & 3) + 8 * (r >> 2)));
                if (MODE != 1) pk_sort16(g);
                if (p == 0) { if (kt == 0) {
#pragma unroll
                        for (int i = 0; i < 16; ++i) top0[i] = g[i]; } else if (MODE != 1) pk_merge_top16(top0, g); else top0[kt] += g[kt]; }
                else { if (kt == 0) {
#pragma unroll
                        for (int i = 0; i < 16; ++i) top1[i] = g[i]; } else if (MODE != 1) pk_merge_top16(top1, g); else top1[kt] += g[kt]; }
            }
        }
        float mine[16], oth[16];
#pragma unroll
        for (int i = 0; i < 16; ++i) {
            const unsigned a0 = __builtin_bit_cast(unsigned, top0[i]) | ((unsigned)hi << 2), a1 = __builtin_bit_cast(unsigned, top1[i]) | ((unsigned)hi << 2);
            const auto rr = __builtin_amdgcn_permlane32_swap(a0, a1, false, false);
            mine[i] = __builtin_bit_cast(float, (unsigned)rr[0]); oth[i] = __builtin_bit_cast(float, (unsigned)rr[1]);
        }
        pk_merge_top16(mine, oth);
        float s1[16], s2[16];
#pragma unroll
        for (int i = 0; i < 16; ++i) { const unsigned m = __builtin_bit_cast(unsigned, mine[i]); const auto rr = __builtin_amdgcn_permlane32_swap(m, m, false, false);
            s1[i] = __builtin_bit_cast(float, (unsigned)rr[0]); s2[i] = __builtin_bit_cast(float, (unsigned)rr[1]); }
#pragma unroll
        for (int q4 = 0; q4 < 4; ++q4) {
            unsigned w1 = 0, w2 = 0;
#pragma unroll
            for (int k = 0; k < 4; ++k) { w1 |= (__builtin_bit_cast(unsigned, s1[4 * q4 + k]) & 127u) << (8 * k); w2 |= (__builtin_bit_cast(unsigned, s2[4 * q4 + k]) & 127u) << (8 * k); }
            *(LAS unsigned*)(tab + 4 * q4) = w1; *(LAS unsigned*)(tab + 16 + 4 * q4) = w2;
        }
#define PK_CAND(a, b) pk_key(s1[a] + s2[b], 0xffffff00u, (unsigned)((15 - (a)) * 16 + (15 - (b))))
        float G1[16], G2[16], G3[16];
#pragma unroll
        for (int b = 0; b < 16; ++b) G1[b] = PK_CAND(0, b);
#pragma unroll
        for (int b = 0; b < 8; ++b) { G2[b] = PK_CAND(1, b); G2[8 + b] = PK_CAND(15 - b, 0); }
        pk_bitonic16(G2);
        pk_merge_top16(G1, G2);
        G3[0] = PK_CAND(2, 0); G3[1] = PK_CAND(2, 1); G3[2] = PK_CAND(2, 2); G3[3] = PK_CAND(2, 3); G3[4] = PK_CAND(2, 4);
        G3[5] = PK_CAND(3, 0); G3[6] = PK_CAND(3, 1); G3[7] = PK_CAND(3, 2); G3[8] = PK_CAND(3, 3);
        G3[9] = PK_CAND(4, 0); G3[10] = PK_CAND(4, 1); G3[11] = PK_CAND(4, 2);
        G3[12] = PK_CAND(5, 0); G3[13] = PK_CAND(5, 1); G3[14] = PK_CAND(6, 0); G3[15] = PK_CAND(6, 1);
        pk_sort16(G3);
        G3[15] = __builtin_fmaxf(G3[15], PK_CAND(7, 0)); G3[14] = __builtin_fmaxf(G3[14], PK_CAND(7, 1));
        pk_bitonic16(G3);
        pk_merge_top16(G1, G3);
#undef PK_CAND
        LDS_WAIT();
        int e[16]; float pr[16]; float den = 0.f;
#pragma unroll
        for (int k = 0; k < 16; ++k) {
            const unsigned id = __builtin_bit_cast(unsigned, G1[k]) & 255u; const int a = 15 - (int)(id >> 4), b = 15 - (int)(id & 15u);
            const int i1 = *(const LAS unsigned char*)(tab + a), i2 = *(const LAS unsigned char*)(tab + 16 + b);
            e[k] = i1 * PNK + i2;
            pr[k] = __builtin_amdgcn_exp2f((G1[k] - G1[0]) * 1.4426950408889634f); den += pr[k];
        }
        const float inv = 1.f / den;
        const float* sc = (const float*)(ws + (hi == 0 ? WS_PSU : WS_PSV)) + layer * PNE;
        float scv[16];
#pragma unroll
        for (int k = 0; k < 16; ++k) scv[k] = sc[e[k]];
        if (hi == 0) {
#pragma unroll
            for (int k = 0; k < 4; ++k) { *(v4u*)(idx + (size_t)tok * PSEL + h * PTOPK + 4 * k) = (v4u){(unsigned)e[4 * k], (unsigned)e[4 * k + 1], (unsigned)e[4 * k + 2], (unsigned)e[4 * k + 3]};
                *(f32x4*)(suk + (size_t)tok * PSEL + h * PTOPK + 4 * k) = (f32x4){scv[4 * k], scv[4 * k + 1], scv[4 * k + 2], scv[4 * k + 3]}; }
        } else {
#pragma unroll
            for (int k = 0; k < 4; ++k) *(f32x4*)(gate + (size_t)tok * PSEL + h * PTOPK + 4 * k) = (f32x4){pr[4 * k] * inv * scv[4 * k], pr[4 * k + 1] * inv * scv[4 * k + 1], pr[4 * k + 2] * inv * scv[4 * k + 2], pr[4 * k + 3] * inv * scv[4 * k + 3]};
        }
    }
}

typedef _Float16 f16x2_t __attribute__((ext_vector_type(2)));
typedef _Float16 f16x8_t __attribute__((ext_vector_type(8)));
typedef short v4i16_t __attribute__((ext_vector_type(4)));
__device__ __forceinline__ void p2_mixer(const Args& A, Frame& F) {
    unsigned char* ws = A.ws;
    const bf16* aglu = (const bf16*)(ws + WS_AGLU); const bf16* ug = (const bf16*)(ws + WS_UG); const bf16* vg = (const bf16*)(ws + WS_VG); bf16* cat = (bf16*)(ws + WS_CAT);
    const float* cw = A.in[I_CONVW]; const float* cb = A.in[I_CONVB]; const float* clg = A.in[I_CLNG]; const float* clb = A.in[I_CLNB];
    const float* slg = A.in[I_SLNG]; const float* slb = A.in[I_SLNB]; const float* sb = A.in[I_SGUB]; const bf16* sgw = (const bf16*)(ws + WS_SGW);
    LAS unsigned char* L = F.lds;
    const int lane = F.lane, wave = F.wave;
    for (int unit = blockIdx.x; unit < T / 128; unit += F.G) {
        const int row0 = unit * 128, tin = (unit & 31) * 128;
#pragma unroll 1
        for (int pass = 0; pass < 2; ++pass) {
        if ((pass == 0) != ((blockIdx.x & 1) != 0)) {
        {
            const int cp = F.tid & 255, hf = F.tid >> 8, t0 = hf * 64;
            float w0[31], w1[31], x0[31], x1[31];
#pragma unroll
            for (int j = 0; j < 31; ++j) { const f32x2 ww = *(const f32x2*)(cw + j * 512 + 2 * cp); w0[j] = ww.x; w1[j] = ww.y; }
            const f32x2 bias = *(const f32x2*)(cb + 2 * cp);
            const unsigned char* gb = (const unsigned char*)aglu;
            unsigned o = (unsigned)(((row0 + t0 - 31) * 512 + 2 * cp) * 2);
            x0[0] = 0.f; x1[0] = 0.f;
#pragma unroll
            for (int s = 1; s < 31; ++s) { const int tt = s - 31; o += 1024u; asm volatile("" : "+v"(o)); unsigned wv = 0u; if (tin + t0 + tt >= 0) wv = *(const unsigned*)(gb + o); x0[s] = bf_lo(wv); x1[s] = bf_hi(wv); }
            unsigned lo = (unsigned)(t0 * 1024 + cp * 4);
            unsigned pre[4];
#pragma unroll
            for (int i = 0; i < 4; ++i) pre[i] = *(const unsigned*)(gb + (unsigned)(o + 1024u * (unsigned)(i + 1)));
            const unsigned olast = o + 1024u * 64u;
#pragma unroll 1
            for (int tb = 0; tb < 64; tb += 31) {
#pragma unroll
                for (int s = 0; s < 31; ++s) {
                    const int t = tb + s;
                    if (t < 64) {
                        o += 1024u; asm volatile("" : "+v"(o));
                        const unsigned wv = pre[s & 3]; { unsigned on = o + 4096u; on = on < olast ? on : olast; pre[s & 3] = *(const unsigned*)(gb + on); }
                        x0[s] = bf_lo(wv); x1[s] = bf_hi(wv);
                        float a0 = bias.x, a1 = bias.y;
#pragma unroll
                        for (int j = 0; j < 31; ++j) { a0 += w0[j] * x0[(s + 1 + j) % 31]; a1 += w1[j] * x1[(s + 1 + j) % 31]; }
                        const f16x2_t ov = {(_Float16)a0, (_Float16)a1};
                        *(LAS f16x2_t*)(L + lo) = ov; lo += 1024u; asm volatile("" : "+v"(lo));
                    }
                }
                { const unsigned p0 = pre[3], p1 = pre[0], p2 = pre[1], p3 = pre[2]; pre[0] = p0; pre[1] = p1; pre[2] = p2; pre[3] = p3; }
            }
        }
        __syncthreads();
#pragma unroll 2
        for (int k = 0; k < 16; ++k) {
            const int tl = wave * 16 + k; const f16x8_t hv = *(const LAS f16x8_t*)(L + tl * 1024 + lane * 16);
            float v[8]; float s = 0.f;
#pragma unroll
            for (int i = 0; i < 8; ++i) { v[i] = (float)hv[i]; s += v[i]; }
            const float mu = wave_sum(s) * (1.f / 512.f); float q = 0.f;
#pragma unroll
            for (int i = 0; i < 8; ++i) { v[i] -= mu; q += v[i] * v[i]; }
            const float rstd = rsqrtf(wave_sum(q) * (1.f / 512.f) + EPS);
            const f32x4 g0 = *(const f32x4*)(clg + lane * 8), g1 = *(const f32x4*)(clg + lane * 8 + 4), b0 = *(const f32x4*)(clb + lane * 8), b1 = *(const f32x4*)(clb + lane * 8 + 4);
            const float gg[8] = {g0.x, g0.y, g0.z, g0.w, g1.x, g1.y, g1.z, g1.w}, bb[8] = {b0.x, b0.y, b0.z, b0.w, b1.x, b1.y, b1.z, b1.w};
            float y[8];
#pragma unroll
            for (int i = 0; i < 8; ++i) { const float z = v[i] * rstd * gg[i] + bb[i]; y[i] = z * __builtin_amdgcn_rcpf(1.f + __expf(-z)); }
            v4u o; o.x = pk2(y[0], y[1]); o.y = pk2(y[2], y[3]); o.z = pk2(y[4], y[5]); o.w = pk2(y[6], y[7]);
            *(v4u*)(cat + (size_t)(row0 + tl) * 1024 + lane * 8) = o;
        }
        __syncthreads();
        } else {
#pragma unroll 1
        for (int k4 = 0; k4 < 16; k4 += 8) {
        v4u rawv[8];
#pragma unroll
        for (int k = 0; k < 8; ++k) rawv[k] = *(const v4u*)(vg + (size_t)(row0 + wave * 16 + k4 + k) * 512 + lane * 8);
#pragma unroll
        for (int k = 0; k < 8; ++k) {
            const int tl = wave * 16 + k4 + k;
            const v4u raw = rawv[k];
            float v[8] = {bf_lo(raw.x), bf_hi(raw.x), bf_lo(raw.y), bf_hi(raw.y), bf_lo(raw.z), bf_hi(raw.z), bf_lo(raw.w), bf_hi(raw.w)};
            float s = 0.f;
#pragma unroll
            for (int i = 0; i < 8; ++i) s += v[i];
            const float mu = wave_sum(s) * (1.f / 512.f); float q = 0.f;
#pragma unroll
            for (int i = 0; i < 8; ++i) { v[i] -= mu; q += v[i] * v[i]; }
            const float rstd = rsqrtf(wave_sum(q) * (1.f / 512.f) + EPS);
            const f32x4 g0 = *(const f32x4*)(slg + lane * 8), g1 = *(const f32x4*)(slg + lane * 8 + 4), b0 = *(const f32x4*)(slb + lane * 8), b1 = *(const f32x4*)(slb + lane * 8 + 4);
            const float gg[8] = {g0.x, g0.y, g0.z, g0.w, g1.x, g1.y, g1.z, g1.w}, bb[8] = {b0.x, b0.y, b0.z, b0.w, b1.x, b1.y, b1.z, b1.w};
#pragma unroll
            for (int i = 0; i < 8; ++i) v[i] = v[i] * rstd * gg[i] + bb[i];
            v4u o; o.x = pk2(v[0], v[1]); o.y = pk2(v[2], v[3]); o.z = pk2(v[4], v[5]); o.w = pk2(v[6], v[7]);
            *(LAS v4u*)(L + tl * 1024 + lane * 16) = o;
        }
        }
        __syncthreads();
        {
            const int h = wave, fr = lane & 15, fq = lane >> 4;
            const bf16* wh = sgw + (size_t)h * 128 * 128;
#pragma unroll 1
            for (int nh = 0; nh < 2; ++nh) {
                bf16x8 bfr[4][2];
#pragma unroll
                for (int ks = 0; ks < 4; ++ks)
#pragma unroll
                    for (int nt = 0; nt < 2; ++nt) {
                        const int n0 = h * 64 + (nh * 2 + nt) * 16;
                        const LAS unsigned char* pa = L + (size_t)(32 * ks + 8 * fq + (fr >> 2)) * 1024 + (n0 + 4 * (fr & 3)) * 2;
                        const v4i16_t lo = __builtin_amdgcn_ds_read_tr16_b64_v4i16((LAS v4i16_t*)pa), hi4 = __builtin_amdgcn_ds_read_tr16_b64_v4i16((LAS v4i16_t*)(pa + 4 * 1024));
                        bfr[ks][nt] = (bf16x8){lo[0], lo[1], lo[2], lo[3], hi4[0], hi4[1], hi4[2], hi4[3]};
                    }
                bf16x8 afn[4]; const int c = h * 64 + nh * 32 + 4 * fq;
#pragma unroll
                for (int ks = 0; ks < 4; ++ks) afn[ks] = *(const bf16x8*)(wh + (size_t)fr * 128 + 32 * ks + 8 * fq);
                v2u un0 = *(const v2u*)(ug + (size_t)(row0 + fr) * 512 + c), un1 = *(const v2u*)(ug + (size_t)(row0 + fr) * 512 + c + 16); float btn = sb[h * 128 + fr];
#pragma unroll 1
                for (int mt = 0; mt < 8; ++mt) {
                    bf16x8 af[4];
#pragma unroll
                    for (int ks = 0; ks < 4; ++ks) af[ks] = afn[ks];
                    const int t = 16 * mt + fr;
                    const v2u u0 = un0, u1 = un1; const float bt = btn;
                    { const int mn = mt < 7 ? mt + 1 : mt, tn = 16 * mn + fr;
#pragma unroll
                      for (int ks = 0; ks < 4; ++ks) afn[ks] = *(const bf16x8*)(wh + (size_t)tn * 128 + 32 * ks + 8 * fq);
                      un0 = *(const v2u*)(ug + (size_t)(row0 + tn) * 512 + c); un1 = *(const v2u*)(ug + (size_t)(row0 + tn) * 512 + c + 16); btn = sb[h * 128 + tn]; }
                    f32x4 acc0 = (f32x4){0.f, 0.f, 0.f, 0.f}, acc1 = (f32x4){0.f, 0.f, 0.f, 0.f};
#pragma unroll
                    for (int ks = 0; ks < 4; ++ks)
                        if (2 * ks <= mt) {
                            acc0 = __builtin_amdgcn_mfma_f32_16x16x32_bf16(bfr[ks][0], af[ks], acc0, 0, 0, 0);
                            acc1 = __builtin_amdgcn_mfma_f32_16x16x32_bf16(bfr[ks][1], af[ks], acc1, 0, 0, 0);
                        }
                    v2u o0, o1;
                    o0.x = pk2(bf_lo(u0.x) * (acc0[0] + bt), bf_hi(u0.x) * (acc0[1] + bt)); o0.y = pk2(bf_lo(u0.y) * (acc0[2] + bt), bf_hi(u0.y) * (acc0[3] + bt));
                    o1.x = pk2(bf_lo(u1.x) * (acc1[0] + bt), bf_hi(u1.x) * (acc1[1] + bt)); o1.y = pk2(bf_lo(u1.y) * (acc1[2] + bt), bf_hi(u1.y) * (acc1[3] + bt));
                    *(v2u*)(cat + (size_t)(row0 + t) * 1024 + 512 + c) = o0; *(v2u*)(cat + (size_t)(row0 + t) * 1024 + 512 + c + 16) = o1;
                }
            }
        }
        __syncthreads();
        }
        }
    }
}

struct S1a { int e0, e1; float a0, a1, b0, b1; v4u hq; float hs; };
__device__ __forceinline__ void s1a_load(S1a& s, const unsigned char* ws, int t, int lane) {
    const int* idx = (const int*)(ws + WS_IDX); const float* gsv = (const float*)(ws + WS_GATE); const float* suk = (const float*)(ws + WS_SUK);
    s.e0 = idx[(size_t)t * PSEL + lane]; s.e1 = idx[(size_t)t * PSEL + 64 + lane];
    s.a0 = suk[(size_t)t * PSEL + lane]; s.a1 = suk[(size_t)t * PSEL + 64 + lane];
    s.b0 = gsv[(size_t)t * PSEL + lane]; s.b1 = gsv[(size_t)t * PSEL + 64 + lane];
    s.hq = *(const v4u*)(ws + WS_HQ + (size_t)t * D + lane * 16); s.hs = ((const float*)(ws + WS_HQS))[t];
}
struct ChunkA { v4u rows[8]; v4u hq; float sa, sb; int kk, nv, t; };
struct WalkA { S1a cur, nxt; unsigned long long m0, m1; int it, nit, wrank, nw, nslice, xs0, xstep; bool done; };
__device__ __forceinline__ int walk_tok(const WalkA& w, int it) { return w.wrank + (it / w.nslice) * w.nw; }
__device__ __forceinline__ void walk_masks(WalkA& w) { const int xs = w.xs0 + (w.it % w.nslice) * w.xstep; w.m0 = __ballot((w.cur.e0 >> 11) == xs); w.m1 = __ballot((w.cur.e1 >> 11) == xs); }
template <int MODE> __device__ __forceinline__ void gen_a(ChunkA& c, WalkA& w, const unsigned char* ws, const unsigned char* ut, int lane, int cls) {
    while ((w.m0 | w.m1) == 0ull && !w.done) {
        ++w.it;
        if (w.it >= w.nit) { w.done = true; break; }
        w.cur = w.nxt;
        { const int itn = (w.it + 1 < w.nit) ? w.it + 1 : w.nit - 1; s1a_load(w.nxt, ws, walk_tok(w, itn), lane); }
        walk_masks(w);
    }
    if (w.done) { c.nv = 0; return; }
    int kl = 0, nv = 0, kkv = 0;
    unsigned long long lo = w.m0, hi = w.m1;
#pragma unroll
    for (int i = 0; i < 8; ++i) {
        const bool has = (lo | hi) != 0ull, uselo = lo != 0ull;
        const unsigned long long m = uselo ? lo : hi;
        const int kp = (uselo ? 0 : 64) + __builtin_ctzll(m | 0x8000000000000000ull);
        const unsigned long long mc = m & (m - 1ull);
        lo = uselo ? mc : lo; hi = uselo ? hi : mc;
        const int k = has ? kp : kl; nv += has ? 1 : 0; kl = k;
        const int e = __builtin_amdgcn_readlane(k < 64 ? w.cur.e0 : w.cur.e1, k & 63);
        if (MODE == 1) { c.rows[i] = w.cur.hq; c.rows[i].x += (unsigned)e; } else
        c.rows[i] = *(const v4u*)(ut + (size_t)e * D + lane * 16);
        kkv = (cls == i) ? k : kkv;
    }
    w.m0 = lo; w.m1 = hi;
    const float a0s = __shfl(w.cur.a0, kkv & 63), a1s = __shfl(w.cur.a1, kkv & 63), b0s = __shfl(w.cur.b0, kkv & 63), b1s = __shfl(w.cur.b1, kkv & 63);
    c.sa = w.cur.hs * (kkv < 64 ? a0s : a1s); c.sb = kkv < 64 ? b0s : b1s; c.kk = kkv; c.nv = nv; c.t = walk_tok(w, w.it); c.hq = w.cur.hq;
}
__device__ __forceinline__ void compute_a(const ChunkA& c, float* cb, int lane, int cls) {
    int d[8];
#pragma unroll
    for (int i = 0; i < 8; ++i) { const v4u& ur = c.rows[i];
        int s = __builtin_amdgcn_sdot4((int)ur.x, (int)c.hq.x, 0, false); s = __builtin_amdgcn_sdot4((int)ur.y, (int)c.hq.y, s, false); s = __builtin_amdgcn_sdot4((int)ur.z, (int)c.hq.z, s, false); d[i] = __builtin_amdgcn_sdot4((int)ur.w, (int)c.hq.w, s, false); }
    const bool b3 = lane & 8;
    int q4[4];
#pragma unroll
    for (int i = 0; i < 4; ++i) { const auto rr = __builtin_amdgcn_permlane32_swap((unsigned)d[i], (unsigned)d[i + 4], false, false); q4[i] = (int)rr[0] + (int)rr[1]; }
    int q2[2];
#pragma unroll
    for (int i = 0; i < 2; ++i) {
        const auto ra = __builtin_amdgcn_permlane16_swap((unsigned)q4[i], (unsigned)q4[i], false, false), rb = __builtin_amdgcn_permlane16_swap((unsigned)q4[i + 2], (unsigned)q4[i + 2], false, false);
        const int sa_ = (int)ra[0] + (int)ra[1], sb_ = (int)rb[0] + (int)rb[1]; q2[i] = (lane & 16) ? sb_ : sa_; }
    int q1; { const int send = b3 ? q2[0] : q2[1], keep = b3 ? q2[1] : q2[0]; q1 = keep + dpp_i<DPP_ROR8>(send); }
    q1 += dpp_i<DPP_HMIRROR>(q1); q1 += dpp_i<DPP_XOR2>(q1); q1 += dpp_i<DPP_XOR1>(q1);
    const float cf = c.sb * gelu_tanh((float)q1 * c.sa);
    if ((lane & 7) == 0 && cls < c.nv) cb[(size_t)c.t * PSEL + c.kk] = cf;
}
template <int MODE> __device__ __forceinline__ void p7a_act(const Args& A, Frame& F, int layer) {
    unsigned char* ws = A.ws;
    const unsigned char* ut = ws + WS_PU + (size_t)layer * PNE * D; float* cb = (float*)(ws + (MODE == 0 ? WS_CB : WS_SUK + 0));
    const int lane = F.lane;
    const int cls = ((lane >> 5) & 1) * 4 + ((lane >> 4) & 1) * 2 + ((lane >> 3) & 1);
    WalkA w;
    w.xs0 = F.xi; w.xstep = F.nx; w.nslice = F.xi < 8 ? (7 - F.xi) / F.nx + 1 : 0;
    w.wrank = F.xr * NWAVES + F.wave; w.nw = F.xn * NWAVES;
    const int cnt = (w.wrank < T) ? (T - 1 - w.wrank) / w.nw + 1 : 0;
    w.nit = cnt * w.nslice; w.it = 0; w.done = (w.nit == 0);
    if (w.done) return;
    s1a_load(w.cur, ws, walk_tok(w, 0), lane); s1a_load(w.nxt, ws, walk_tok(w, w.nit > 1 ? 1 : 0), lane);
    walk_masks(w);
    ChunkA ca, cbf;
    gen_a<MODE>(ca, w, ws, ut, lane, cls);
    while (ca.nv > 0) {
        gen_a<MODE>(cbf, w, ws, ut, lane, cls);
        compute_a(ca, cb, lane, cls);
        if (cbf.nv == 0) break;
        gen_a<MODE>(ca, w, ws, ut, lane, cls);
        compute_a(cbf, cb, lane, cls);
    }
}
__device__ __forceinline__ void y_ld_e(v4u (&e)[2], const unsigned char* ws, int t, int r) {
    const int* idx = (const int*)(ws + WS_IDX);
    e[0] = *(const v4u*)(idx + (size_t)t * PSEL + 8 * r); e[1] = *(const v4u*)(idx + (size_t)t * PSEL + 8 * r + 4);
}
template <int MODE> __device__ __forceinline__ void rows_issue8(v4u (&rows)[8], const v4u (&e4)[2], const unsigned char* base, unsigned loff) {
#pragma unroll
    for (int i = 0; i < 8; ++i) { const unsigned e = ((const unsigned*)&e4[i >> 2])[i & 3]; if (MODE == 1) { rows[i] = e4[0]; rows[i].x += e; } else { const unsigned off = e * 128u + loff; rows[i] = *(const v4u*)(base + off); } }
}
__device__ __forceinline__ void part_round(const v4u (&rows)[8], const v4u& hh4, const v4u& hl4, int* po, int j) {
    int sm[8];
    const unsigned hh[4] = {hh4.x, hh4.y, hh4.z, hh4.w}, hl[4] = {hl4.x, hl4.y, hl4.z, hl4.w};
#pragma unroll
    for (int i = 0; i < 8; ++i) {
        const unsigned w[4] = {rows[i].x, rows[i].y, rows[i].z, rows[i].w}; int sh = 0, sl = 0;
#pragma unroll
        for (int q = 0; q < 4; ++q) { sh = __builtin_amdgcn_sdot8((int)w[q], (int)hh[q], sh, false); sl = __builtin_amdgcn_sdot8((int)w[q], (int)hl[q], sl, false); }
        int s_ = (sh << 4) + sl;
        s_ += dpp_i<DPP_XOR1>(s_); s_ += dpp_i<DPP_XOR2>(s_); s_ += dpp_i<DPP_HMIRROR>(s_);
        sm[i] = s_;
    }
    if (j == 0) { *(v4u*)po = (v4u){(unsigned)sm[0], (unsigned)sm[1], (unsigned)sm[2], (unsigned)sm[3]}; *(v4u*)(po + 4) = (v4u){(unsigned)sm[4], (unsigned)sm[5], (unsigned)sm[6], (unsigned)sm[7]}; }
}
template <int MODE> __device__ __forceinline__ void p7a_part(const Args& A, Frame& F, int layer) {
    unsigned char* ws = A.ws;
    const unsigned char* ut = ws + WS_PU + (size_t)layer * PNE * 512; int* part = (int*)(ws + (MODE == 1 ? WS_R4 + 64 * MiB : WS_PART));
    const int lane = F.lane, g = lane >> 3, j = lane & 7;
    const int nslice = F.xi < 8 ? (7 - F.xi) / F.nx + 1 : 0, xs0 = F.xi, xstep = F.nx;
    const int wrank = F.xr * NWAVES + F.wave, nw = F.xn * NWAVES;
    constexpr int NSUP = T / 16;
    const int cnt = (wrank < NSUP) ? (NSUP - 1 - wrank) / nw + 1 : 0, nit = cnt * nslice * 16;
    if (nit == 0) return;
#define IT_T(it) (wrank + ((it) / nslice) * nw)
#define IT_X(it) (xs0 + ((it) % nslice) * xstep)
#define IT_C(it) ((it) < nit ? (it) : nit - 1)
#define Y_TOK(R) (2 * (8 * IT_T((R) >> 4) + g) + (IT_X((R) >> 4) >> 2))
#define Y_SL(R) (IT_X((R) >> 4) & 3)
#define P_LDH(dh, dl, R) do { const unsigned char* hp_ = ws + WS_HN + (size_t)Y_TOK(R) * D + Y_SL(R) * 256 + j * 32; dh = *(const v4u*)hp_; dl = *(const v4u*)(hp_ + 16); } while (0)
    v4u E[4][2]; v4u buf[4][8]; v4u Hh, Hl, Nh, Nl;
    { v4u e0[2];
      y_ld_e(e0, ws, Y_TOK(0), 0); P_LDH(Hh, Hl, 0); rows_issue8<MODE>(buf[0], e0, ut + (size_t)Y_SL(0) * PNE * 128, (unsigned)(j * 16));
      { const int i1 = IT_C(1); y_ld_e(e0, ws, Y_TOK(i1), i1 & 15); rows_issue8<MODE>(buf[1], e0, ut + (size_t)Y_SL(i1) * PNE * 128, (unsigned)(j * 16)); }
      { const int i2 = IT_C(2); y_ld_e(e0, ws, Y_TOK(i2), i2 & 15); rows_issue8<MODE>(buf[2], e0, ut + (size_t)Y_SL(i2) * PNE * 128, (unsigned)(j * 16)); }
      { const int i3 = IT_C(3); y_ld_e(E[3], ws, Y_TOK(i3), i3 & 15); } { const int i4 = IT_C(4); y_ld_e(E[0], ws, Y_TOK(i4), i4 & 15); } { const int i5 = IT_C(5); y_ld_e(E[1], ws, Y_TOK(i5), i5 & 15); }
      Nh = Hh; Nl = Hl; }
#define P_POS(p) do { const int R = it + (p); \
        { const int r6 = IT_C(R + 6), r3 = IT_C(R + 3); y_ld_e(E[((p) + 2) & 3], ws, Y_TOK(r6), r6 & 15); \
          if ((R & 15) == 12) { const int rn = IT_C(R + 4); P_LDH(Nh, Nl, rn); } \
          rows_issue8<MODE>(buf[((p) + 3) & 3], E[((p) + 3) & 3], ut + (size_t)Y_SL(r3) * PNE * 128, (unsigned)(j * 16)); } \
        if ((R & 15) == 0) { Hh = Nh; Hl = Nl; } \
        part_round(buf[(p) & 3], Hh, Hl, part + ((size_t)Y_SL(R) * T + Y_TOK(R)) * PSEL + 8 * (R & 15), j); } while (0)
#pragma unroll 1
    for (int it = 0; it < nit; it += 4) { P_POS(0); P_POS(1); P_POS(2); P_POS(3); }
#undef P_POS
#undef P_LDH
}
__device__ __forceinline__ void p7c_combine(const Args& A, Frame& F) {
    unsigned char* ws = A.ws;
    const int* part = (const int*)(ws + WS_PART); const float* suk = (const float*)(ws + WS_SUK); const float* gsv = (const float*)(ws + WS_GATE); const float* hsb = (const float*)(ws + WS_HQS);
    unsigned* cq = (unsigned*)(ws + WS_CB); float* csc = (float*)(ws + WS_CB + 8 * MiB);
    const size_t gt = (size_t)blockIdx.x * NTHREADS + F.tid, NT = (size_t)F.G * NTHREADS;
    for (size_t i4 = gt; i4 < (size_t)T * PSEL / 4; i4 += NT) {
        int s0 = 0, s1 = 0, s2 = 0, s3 = 0;
#pragma unroll
        for (int x = 0; x < 4; ++x) { const v4u p = *(const v4u*)(part + (size_t)x * T * PSEL + 4 * i4); s0 += (int)p.x; s1 += (int)p.y; s2 += (int)p.z; s3 += (int)p.w; }
        const size_t t = (4 * i4) >> 7;
        const f32x4 a = *(const f32x4*)(suk + 4 * i4), b = *(const f32x4*)(gsv + 4 * i4); const float hs = hsb[t] * (127.f / 119.f);
        const float c0 = b.x * gelu_tanh((float)s0 * hs * a.x), c1 = b.y * gelu_tanh((float)s1 * hs * a.y), c2 = b.z * gelu_tanh((float)s2 * hs * a.z), c3 = b.w * gelu_tanh((float)s3 * hs * a.w);
        float m = fmaxf(fmaxf(fabsf(c0), fabsf(c1)), fmaxf(fabsf(c2), fabsf(c3)));
#pragma unroll
        for (int o = 1; o < 32; o <<= 1) m = fmaxf(m, __shfl_xor(m, o));
        const float inv = m > 0.f ? 127.f / m : 0.f;
        const int q0 = (int)rintf(c0 * inv), q1 = (int)rintf(c1 * inv), q2 = (int)rintf(c2 * inv), q3 = (int)rintf(c3 * inv);
        cq[i4] = (unsigned)(q0 & 255) | ((unsigned)(q1 & 255) << 8) | ((unsigned)(q2 & 255) << 16) | ((unsigned)(q3 & 255) << 24);
        if ((i4 & 31) == 0) csc[t] = m * (1.f / 127.f);
    }
}
__device__ __forceinline__ v2u y_ld_c(const unsigned char* ws, int t, int r) { return *(const v2u*)(ws + WS_CB + (size_t)t * PSEL + 8 * r); }
__device__ __forceinline__ void y_round(int (&y)[32], int& csum, const v4u (&rows)[8], const v2u& cq) {
#pragma unroll
    for (int kq = 0; kq < 2; ++kq) {
        const int c4 = (int)((const unsigned*)&cq)[kq];
        csum = __builtin_amdgcn_sdot4(c4, 0x01010101, csum, false);
#pragma unroll
        for (int q = 0; q < 4; ++q) {
            const unsigned r0 = ((const unsigned*)&rows[4 * kq])[q], r1 = ((const unsigned*)&rows[4 * kq + 1])[q], r2 = ((const unsigned*)&rows[4 * kq + 2])[q], r3 = ((const unsigned*)&rows[4 * kq + 3])[q];
            const unsigned u0 = __builtin_amdgcn_perm(r1, r0, 0x05010400u), u1 = __builtin_amdgcn_perm(r1, r0, 0x07030602u), u2 = __builtin_amdgcn_perm(r3, r2, 0x05010400u), u3 = __builtin_amdgcn_perm(r3, r2, 0x07030602u);
            const unsigned t[4] = {__builtin_amdgcn_perm(u2, u0, 0x05040100u), __builtin_amdgcn_perm(u2, u0, 0x07060302u), __builtin_amdgcn_perm(u3, u1, 0x05040100u), __builtin_amdgcn_perm(u3, u1, 0x07060302u)};
#pragma unroll
            for (int bb = 0; bb < 4; ++bb) {
                y[8 * q + 2 * bb] = __builtin_amdgcn_sdot4((int)t[bb], c4, y[8 * q + 2 * bb], false);
                y[8 * q + 2 * bb + 1] = __builtin_amdgcn_sdot4((int)(t[bb] & 0x0F0F0F0Fu), c4, y[8 * q + 2 * bb + 1], false); }
        }
    }
}
template <bool NN, int MODE = 0> __device__ __forceinline__ void p7b_y(const Args& A, Frame& F, int layer, const float* gnext, bf16* xout) {
    unsigned char* ws = A.ws;
    const unsigned char* vt = ws + WS_PV + (size_t)layer * PNE * 512;
    const int lane = F.lane, g = lane >> 3, j = lane & 7;
    const int nslice = F.xi < 8 ? (7 - F.xi) / F.nx + 1 : 0, xs0 = F.xi, xstep = F.nx;
    const int wrank = F.xr * NWAVES + F.wave, nw = F.xn * NWAVES;
    constexpr int NSUP = T / 16;
    const int cnt = (wrank < NSUP) ? (NSUP - 1 - wrank) / nw + 1 : 0, nit = cnt * nslice * 16;
    if (nit == 0) return;
    v4u E[4][2]; v2u Cq[4]; v4u buf[4][8]; int y[32]; int csum = 0;
    { v4u e0[2];
      y_ld_e(e0, ws, Y_TOK(0), 0); Cq[0] = y_ld_c(ws, Y_TOK(0), 0); rows_issue8<MODE>(buf[0], e0, vt + (size_t)Y_SL(0) * PNE * 128, (unsigned)(j * 16));
      { const int i1 = IT_C(1); y_ld_e(e0, ws, Y_TOK(i1), i1 & 15); Cq[1] = y_ld_c(ws, Y_TOK(i1), i1 & 15); rows_issue8<MODE>(buf[1], e0, vt + (size_t)Y_SL(i1) * PNE * 128, (unsigned)(j * 16)); }
      { const int i2 = IT_C(2); y_ld_e(e0, ws, Y_TOK(i2), i2 & 15); Cq[2] = y_ld_c(ws, Y_TOK(i2), i2 & 15); rows_issue8<MODE>(buf[2], e0, vt + (size_t)Y_SL(i2) * PNE * 128, (unsigned)(j * 16)); }
      { const int i3 = IT_C(3); y_ld_e(E[3], ws, Y_TOK(i3), i3 & 15); } { const int i4 = IT_C(4); y_ld_e(E[0], ws, Y_TOK(i4), i4 & 15); } { const int i5 = IT_C(5); y_ld_e(E[1], ws, Y_TOK(i5), i5 & 15); } }
#define Y_POS(p) do { const int R = it + (p); \
        { const int r6 = IT_C(R + 6), r3 = IT_C(R + 3); y_ld_e(E[((p) + 2) & 3], ws, Y_TOK(r6), r6 & 15); Cq[((p) + 3) & 3] = y_ld_c(ws, Y_TOK(r3), r3 & 15); \
          rows_issue8<MODE>(buf[((p) + 3) & 3], E[((p) + 3) & 3], vt + (size_t)Y_SL(r3) * PNE * 128, (unsigned)(j * 16)); } \
        if ((R & 15) == 0) { _Pragma("unroll") for (int i = 0; i < 32; ++i) y[i] = 0; csum = 0; } \
        y_round(y, csum, buf[(p) & 3], Cq[(p) & 3]); \
        if ((R & 15) == 15) { const int tt = Y_TOK(R); bf16* xo = xout + (size_t)tt * D + Y_SL(R) * 256 + j * 32; const float cs = ((const float*)(ws + WS_CB + 8 * MiB))[tt]; \
            v4u xv[4]; _Pragma("unroll") for (int q = 0; q < 4; ++q) xv[q] = *(const v4u*)(xo + 8 * q); \
            _Pragma("unroll") for (int q = 0; q < 4; ++q) { v4u o; unsigned* op = (unsigned*)&o; const unsigned* xp = (const unsigned*)&xv[q]; \
                  \
                _Pragma("unroll") for (int e = 0; e < 4; ++e) { const int c0 = 2 * e, c1 = 2 * e + 1; \
                    const int v0 = (c0 < 4) ? y[8 * q + 2 * c0 + 1] - 8 * csum : (y[8 * q + 2 * (c0 - 4)] - y[8 * q + 2 * (c0 - 4) + 1]) >> 4; \
                    const int v1 = (c1 < 4) ? y[8 * q + 2 * c1 + 1] - 8 * csum : (y[8 * q + 2 * (c1 - 4)] - y[8 * q + 2 * (c1 - 4) + 1]) >> 4; \
                    op[e] = pk2(bf_lo(xp[e]) + (float)v0 * cs, bf_hi(xp[e]) + (float)v1 * cs); } \
                *(v4u*)(xo + 8 * q) = o; } } } while (0)
#pragma unroll 1
    for (int it = 0; it < nit; it += 4) { Y_POS(0); Y_POS(1); Y_POS(2); Y_POS(3); }
#undef Y_POS
#undef Y_TOK
#undef Y_SL
#undef IT_T
#undef IT_X
#undef IT_C
}
__device__ __forceinline__ void p_norm_final(const Args& A, Frame& F, const bf16* xres, const float* g) {
    const int gw = F.vcu * NWAVES + F.wave, NGW = F.G * NWAVES, lane = F.lane;
    for (int m = gw; m < T; m += NGW) {
        const v4u a = *(const GAS v4u*)(xres + (size_t)m * D + lane * 16), b = *(const GAS v4u*)(xres + (size_t)m * D + lane * 16 + 8);
        f32x4 v[4] = {(f32x4){bf_lo(a.x), bf_hi(a.x), bf_lo(a.y), bf_hi(a.y)}, (f32x4){bf_lo(a.z), bf_hi(a.z), bf_lo(a.w), bf_hi(a.w)}, (f32x4){bf_lo(b.x), bf_hi(b.x), bf_lo(b.y), bf_hi(b.y)}, (f32x4){bf_lo(b.z), bf_hi(b.z), bf_lo(b.w), bf_hi(b.w)}};
        float s = 0.f;
#pragma unroll
        for (int q = 0; q < 4; ++q) s += (v[q].x * v[q].x + v[q].y * v[q].y) + (v[q].z * v[q].z + v[q].w * v[q].w);
        const float r = rsqrtf(wave_sum(s) * (1.f / D) + EPS);
#pragma unroll
        for (int q = 0; q < 4; ++q) *(GAS f32x4*)(A.out + (size_t)m * D + lane * 16 + 4 * q) = v[q] * r * *(const GAS f32x4*)(g + lane * 16 + 4 * q);
    }
}
#ifndef MK_ONE_LAUNCH
#define MK_ONE_LAUNCH 1
#endif
constexpr int NPH = 20;
#ifndef PROBE_DUP
#define PROBE_DUP 0
#endif
__global__ void __launch_bounds__(NTHREADS, 2) fwd(Args args) {
    extern __shared__ __attribute__((aligned(16))) unsigned char lds[];
    Frame F;
    F.lds = (LAS unsigned char*)lds;
    F.MISC = (volatile LAS unsigned*)(F.lds + MISC_OFF);
    F.tid = threadIdx.x; F.lane = F.tid & 63; F.wave = __builtin_amdgcn_readfirstlane(F.tid >> 6);
    F.G = gridDim.x; { const int bx = blockIdx.x; F.vcu = (F.G % 8 == 0) ? (bx % 8) * (F.G / 8) + bx / 8 : bx; }
    unsigned char* ws = args.ws;
    F.ctl = (gu32*)(ws + WS_CTL);
    for (int u = F.tid; u < (LDS_BYTES - LDSCTL_OFF) / 4; u += NTHREADS) ((LAS unsigned*)(F.lds + LDSCTL_OFF))[u] = 0u;
    __syncthreads();
    XcdBarrier bar; bar.bar = (unsigned*)(F.ctl + CW_BAR); bar.x = 0; bar.st = nullptr;
    { bar.bar = (unsigned*)(F.ctl + CW_BAR); bar.x = xb_xcc_id(); bar.st = F.MISC + 8;
      if (F.tid == 0) F.MISC[10] = xb_add(&bar.bar[XB_XCNT(bar.x)], 1u); }
#define GRID_BAR() do { if (MK_ONE_LAUNCH) { xcd_barrier(bar); if (PROBE_DUP == 120) xcd_barrier(bar); } } while (0)
    const int lo = args.ph_lo, hi = args.ph_hi;
#ifdef ONLY_PH
#define IN(k) ((k) == ONLY_PH && lo <= (k) && (k) < hi)
#else
#define IN(k) (lo <= (k) && (k) < hi)
#endif
    bf16* hA = (bf16*)(ws + WS_HA);

    if (IN(0)) { p0_prologue(args, F); GRID_BAR(); if (PROBE_DUP == 100) { p0_prologue(args, F); GRID_BAR(); } p0_weights8(args, F); GRID_BAR(); }
    {
        if (F.tid == 0) { unsigned below = 0u;
#pragma unroll
            for (unsigned j = 0; j < 16; ++j) { const unsigned c = xb_ld(&bar.bar[XB_XCNT(j)]); below += (j < bar.x && c > 0u) ? 1u : 0u; }
            F.MISC[11] = below; }
        __syncthreads();
        F.xi = __builtin_amdgcn_readfirstlane((int)F.MISC[11]); F.xr = __builtin_amdgcn_readfirstlane((int)F.MISC[10]); F.xn = __builtin_amdgcn_readfirstlane((int)F.MISC[8]); F.nx = __builtin_amdgcn_readfirstlane((int)F.MISC[9]);
        if (F.xn < 1) F.xn = 1; if (F.nx < 1) F.nx = 1;
    }
    if (IN(1)) {
        pg8::Gemm g{(const bf16*)(ws + WS_HQ), (const bf16*)(ws + WS_WIN), T, MIX_IN, D / 2}; pg8::StaticOrder S; S.init(T, MIX_IN, F.G, (int)blockIdx.x);
        pg8::EpiI8<pg8::EpiMixIn> E{pg8::EpiMixIn{(bf16*)(ws + WS_AGLU), (bf16*)(ws + WS_UG), (bf16*)(ws + WS_VG)}, (const float*)(ws + WS_HQS), (const float*)(ws + WS_WSC)};
        pg8::gemm_phase<pg8::EpiI8<pg8::EpiMixIn>, pg8::StaticOrder, true, true, true>(F.lds, g, S, E);
        GRID_BAR();
        if (PROBE_DUP == 101) { pg8::gemm_phase<pg8::EpiI8<pg8::EpiMixIn>, pg8::StaticOrder, true, true, true>(F.lds, g, S, E); GRID_BAR(); }
    }
    if (IN(2)) { p2_mixer(args, F); GRID_BAR(); if (PROBE_DUP == 102) { p2_mixer(args, F); GRID_BAR(); } }
    if (IN(3)) {
        pg8::Gemm g{(const bf16*)(ws + WS_CAT), (const bf16*)(ws + WS_WOUT), T, D, D}; pg8::StaticOrder S; S.init(T, D, F.G, (int)blockIdx.x);
        pg8::EpiResB<false> E{args.in[I_X], nullptr, hA, D};
        pg8::gemm_phase<pg8::EpiResB<false>, pg8::StaticOrder, true, true>(F.lds, g, S, E);
        GRID_BAR();
    }
#define PEER_PHASES(layer, pb) do { \
        if (IN(pb)) { p_rms<true>(args, F, hA, args.in[I_GFFN] + (layer) * D); GRID_BAR(); } \
        if (IN((pb) + 1)) { \
            pg8::Gemm g{(const bf16*)(ws + WS_HQ), (const bf16*)(ws + WS_WQ + (size_t)(layer) * 2048 * D), T, 2048, D / 2}; pg8::StaticOrder S; S.init(T, 2048, F.G, (int)blockIdx.x); \
            pg8::EpiI8Bf16<false> E{(bf16*)(ws + WS_QP), 2048, 0, 0, 1.f, (const float*)(ws + WS_HQS), (const float*)(ws + WS_WSC) + 2048 + (layer) * 2048, nullptr, 0}; \
            pg8::gemm_phase<pg8::EpiI8Bf16<false>, pg8::StaticOrder, true, true, true>(F.lds, g, S, E); \
            GRID_BAR(); \
            if (PROBE_DUP == 105) { pg8::gemm_phase<pg8::EpiI8Bf16<false>, pg8::StaticOrder, true, true, true>(F.lds, g, S, E); GRID_BAR(); } \
        } \
        if (IN((pb) + 2)) { if (PROBE_DUP == 116) { p6_route<1>(args, F, (layer)); GRID_BAR(); } p6_route<0>(args, F, (layer)); GRID_BAR(); if (PROBE_DUP == 106) { p6_route<0>(args, F, (layer)); GRID_BAR(); } } \
        if (IN((pb) + 3)) { if (PROBE_DUP == 117) { p7a_part<1>(args, F, (layer)); GRID_BAR(); } p7a_part<0>(args, F, (layer)); GRID_BAR(); if (PROBE_DUP == 107) { p7a_part<0>(args, F, (layer)); GRID_BAR(); } p7c_combine(args, F); GRID_BAR(); if (PROBE_DUP == 108) { p7c_combine(args, F); GRID_BAR(); } } \
        if (IN((pb) + 4)) { if (PROBE_DUP == 118) { p7b_y<false, 1>(args, F, (layer), args.in[I_GFIN], (bf16*)(ws + WS_PART)); GRID_BAR(); } if (PROBE_DUP == 121) { p7b_y<false, 3>(args, F, (layer), args.in[I_GFIN], (bf16*)(ws + WS_PART)); GRID_BAR(); } if (PROBE_DUP == 119) { p7b_y<false, 2>(args, F, (layer), args.in[I_GFIN], (bf16*)(ws + WS_PART)); GRID_BAR(); } p7b_y<false>(args, F, (layer), args.in[I_GFIN], hA); GRID_BAR(); } \
        if (IN((pb) + 5)) { if ((layer) == 0) { p_rms<true, false>(args, F, hA, args.in[I_GMIX] + D); GRID_BAR(); } else p_norm_final(args, F, hA, args.in[I_GFIN]); } \
    } while (0)
    PEER_PHASES(0, 4);
    if (IN(10)) {
        pg8::Gemm g{(const bf16*)(ws + WS_HQ), (const bf16*)(ws + WS_WQKV), T, 3 * D, D / 2}; pg8::StaticOrder S; S.init(T, 3 * D, F.G, (int)blockIdx.x);
        pg8::EpiI8Bf16<true> E{(bf16*)(ws + WS_Q), D, D, (size_t)(WS_K - WS_Q) / 2, attn_body::C2, (const float*)(ws + WS_HQS), (const float*)(ws + WS_WSC) + 6144, (float*)(ws + WS_KMEAN), T / 256};
        pg8::gemm_phase<pg8::EpiI8Bf16<true>, pg8::StaticOrder, true, true, true>(F.lds, g, S, E);
        GRID_BAR();
    }
    if (IN(12)) {
        static_assert(attn_body::ATTN_LDS_BYTES <= RING_BYTES && attn_body::GLUT_OFF == LUT_OFF && attn_body::GLUT_N == LUT_N, "attention body geometry vs frame");
        const attn_body::AttnTensors AT{(const attn_body::bf16*)(ws + WS_Q), (const attn_body::bf16*)(ws + WS_K), (const attn_body::bf16*)(ws + WS_V), (attn_body::bf16*)(ws + WS_Q), (const float*)(ws + WS_KMEAN), (const float*)(ws + WS_LUT)};
        const attn_body::StaticOrder S((int)F.G, (int)blockIdx.x);
        if (PROBE_DUP == 112) { const attn_body::AttnTensors AT2{AT.Q, AT.K, AT.V, (attn_body::bf16*)(ws + WS_HA), AT.KM, AT.GLUT}; attn_body::attn_phase<attn_body::StaticOrder>((char*)lds, AT2, S); GRID_BAR(); }
        if (PROBE_DUP == 113) { const attn_body::AttnTensors AT2{AT.Q, AT.K, AT.V, (attn_body::bf16*)(ws + WS_HA), AT.KM, AT.GLUT}; attn_body::attn_phase<attn_body::StaticOrder, 8, true>((char*)lds, AT2, S); GRID_BAR(); }
        attn_body::attn_phase<attn_body::StaticOrder>((char*)lds, AT, S);
        GRID_BAR();
    }
    { int t_ = threadIdx.x; asm volatile("" : "+v"(t_)); F.tid = t_; F.lane = t_ & 63; }
    if (IN(13)) {
        pg8::Gemm g{(const bf16*)(ws + WS_Q), (const bf16*)(ws + WS_WO), T, D, D}; pg8::StaticOrder S; S.init(T, D, F.G, (int)blockIdx.x);
        pg8::EpiResB<true> E{nullptr, hA, hA, D};
        pg8::gemm_phase<pg8::EpiResB<true>, pg8::StaticOrder, true, true>(F.lds, g, S, E);
        GRID_BAR();
    }
    PEER_PHASES(1, 14);
#undef PEER_PHASES
#undef IN
#undef GRID_BAR
}

extern "C" void kernel_launch(void* const* d_in, const int* in_sizes, int n_in, void* d_out, int out_size, void* d_ws, size_t ws_size, hipStream_t stream) {
    static int grid = 0;
    if (grid == 0) {
        if (n_in != 21 || in_sizes[0] != T * D || out_size != T * D || ws_size < WS_END) { fprintf(stderr, "kernel_launch: unexpected shapes (n_in %d, in0 %d, out %d, ws %zu); nothing launched\n", n_in, n_in > 0 ? in_sizes[0] : -1, out_size, ws_size); grid = -1; return; }
        int dev = 0, cus = 0, per_cu = 0;
        if (hipGetDevice(&dev) != hipSuccess || hipDeviceGetAttribute(&cus, hipDeviceAttributeMultiprocessorCount, dev) != hipSuccess) { grid = -1; return; }
        if (hipFuncSetAttribute((const void*)fwd, hipFuncAttributeMaxDynamicSharedMemorySize, LDS_BYTES) != hipSuccess) { fprintf(stderr, "kernel_launch: hipFuncSetAttribute failed\n"); grid = -1; return; }
        if (hipOccupancyMaxActiveBlocksPerMultiprocessor(&per_cu, (const void*)fwd, NTHREADS, LDS_BYTES) != hipSuccess || per_cu < 1) fprintf(stderr, "kernel_launch: occupancy query reports %d workgroups per CU\n", per_cu);
        (void)hipGetLastError();
        grid = cus;
    }
    if (grid < 0) return;
    if (hipMemsetAsync((char*)d_ws + WS_CTL, 0, CTL_ZERO_BYTES, stream) != hipSuccess) { fprintf(stderr, "kernel_launch: hipMemsetAsync failed\n"); return; }
    Args a{};
    for (int i = 0; i < 21; ++i) a.in[i] = (const float*)d_in[i];
    a.out = (float*)d_out; a.ws = (unsigned char*)d_ws;
#if MK_ONE_LAUNCH
    a.ph_lo = 0; a.ph_hi = NPH; a.li = 0;
    hipLaunchKernelGGL(fwd, dim3(grid), dim3(NTHREADS), LDS_BYTES, stream, a);
#else
    for (int p = 0; p < NPH; ++p) { a.ph_lo = p; a.ph_hi = p + 1; a.li = p; hipLaunchKernelGGL(fwd, dim3(grid), dim3(NTHREADS), LDS_BYTES, stream, a); }
#endif
    const hipError_t le = hipPeekAtLastError();
    if (le != hipSuccess) fprintf(stderr, "kernel_launch: launch failed: %s\n", hipGetErrorName(le));
}
```

```cpp
#include <hip/hip_runtime.h>
#include <cstdio>
#include <cstdint>
namespace pg8 {
#define PG8_LAS __attribute__((address_space(3)))
typedef unsigned short bf16_t;
typedef short bf16x8 __attribute__((ext_vector_type(8)));
typedef float f32x4 __attribute__((ext_vector_type(4)));
typedef unsigned u32x4 __attribute__((ext_vector_type(4)));
constexpr int BM = 256, BK = 64, HALF = 128, HTB = HALF * BK * 2  , STAGE_BYTES = 8 * HTB, NXCD = 8, WGM = 8;

__host__ __device__ __forceinline__ int lds_byte(int r, int c) { const int st = (r >> 4) * 2 + (c >> 5), rr = r & 15, cc = c & 31, ob = rr * 64 + cc * 2; return st * 1024 + (ob ^ (((ob >> 9) & 1) << 5)); }
__host__ __device__ __forceinline__ void stage_rc(int b, int& R, int& C) { const int st = b / 1024, sb = b % 1024, swz = sb ^ (((sb >> 9) & 1) << 5); R = (st >> 1) * 16 + swz / 64; C = (st & 1) * 32 + (swz % 64) / 2; }
__host__ __device__ __forceinline__ int perm32(int rho) { const int n = rho >> 4, i = rho & 15; return 8 * (i >> 2) + 4 * n + (i & 3); }

struct Unit { int pm, pn; };
struct Gemm { const bf16_t* A; const bf16_t* Bt; int M, N, K; };

struct StaticOrder {
    int nM, nN, nwg, G, c;
    __host__ __device__ void init(int M, int N, int G_, int c_) { nM = M / BM; nN = N / BM; nwg = nM * nN; G = G_; c = c_; }
    __host__ __device__ bool next(int i, Unit& u) const {
        const long L = (long)i * G + c; if (L >= nwg) return false;
        int wgid = (int)L; { const int q = nwg / NXCD, r = nwg % NXCD, xcd = wgid % NXCD, off = wgid / NXCD; wgid = (xcd < r ? xcd * (q + 1) : r * (q + 1) + (xcd - r) * q) + off; }
        const int nig = WGM * nN, gid = wgid / nig, fm = gid * WGM, gsz = (nM - fm) < WGM ? (nM - fm) : WGM;
        u.pm = fm + ((wgid % nig) % gsz); u.pn = (wgid % nig) / gsz; return true;
    }
    __device__ __forceinline__ void a_ready(const Unit&) const {}
    __device__ __forceinline__ void done(const Unit&) const {}
};

__device__ __forceinline__ unsigned cvt_pk_bf16(float lo, float hi) { unsigned r; asm volatile("v_cvt_pk_bf16_f32 %0, %1, %2" : "=v"(r) : "v"(lo), "v"(hi)); return r; }
typedef float f32x2 __attribute__((ext_vector_type(2)));
__device__ __forceinline__ f32x2 gelu_pk(f32x2 v) {
    const f32x2 av = __builtin_elementwise_abs(v), d = av * 0.2316418882f + 1.0f;
    f32x2 t; t.x = __builtin_amdgcn_rcpf(d.x); t.y = __builtin_amdgcn_rcpf(d.y);
    f32x2 q = t * 0.5307027145f + (-0.7265760135f); q = q * t + 0.7107068705f; q = q * t + (-0.142248368f); q = q * t + 0.127414796f; q = q * t;
    const f32x2 s = (v * v) * (-0.72134752044f);
    f32x2 e; e.x = __builtin_amdgcn_exp2f(s.x); e.y = __builtin_amdgcn_exp2f(s.y);
    const f32x2 m = v * (q * e), r = v - m;
    f32x2 o; o.x = v.x < 0.f ? m.x : r.x; o.y = v.y < 0.f ? m.y : r.y; return o;
}

template <int ACT  > struct EpiBf16 {
    static constexpr bool PERM = true, AFTER_DRAIN = false; static_assert(ACT == 0 || ACT == 1, "EpiBf16: ACT is 0 (none) or 1 (gelu_pk)");
    bf16_t* O; int ldc; const float* bias; int split_cols; size_t split_stride; float scale0;
    __device__ __forceinline__ void operator()(const f32x4 (&acc)[2][2][4][2], const Unit& u, int wr, int wc, int fr, int fq) const {
        const int row0 = u.pm * BM + wr * 64 + fr; int colt = u.pn * BM; bf16_t* base = O;
        float sc = 1.f; if (split_cols) { const int t = colt / split_cols; base += (size_t)t * split_stride; colt -= t * split_cols; if (t == 0) sc = scale0; }
        const int col0 = colt + wc * 32 + 8 * fq, bcol0 = u.pn * BM + wc * 32 + 8 * fq;
        f32x4 bv[2][2];
#pragma unroll
        for (int bj = 0; bj < 2; ++bj)
#pragma unroll
            for (int n = 0; n < 2; ++n) bv[bj][n] = bias ? *(const f32x4*)(bias + bcol0 + bj * HALF + 4 * n) : (f32x4){0.f, 0.f, 0.f, 0.f};
#pragma unroll
        for (int ai = 0; ai < 2; ++ai)
#pragma unroll
            for (int m = 0; m < 4; ++m) { bf16_t* rowp = base + (size_t)(row0 + ai * HALF + m * 16) * ldc + col0;
#pragma unroll
                for (int bj = 0; bj < 2; ++bj) { f32x4 v0 = acc[ai][bj][m][0] + bv[bj][0], v1 = acc[ai][bj][m][1] + bv[bj][1];
                    if (ACT == 1) { f32x2 a = gelu_pk((f32x2){v0[0], v0[1]}), b = gelu_pk((f32x2){v0[2], v0[3]}), c = gelu_pk((f32x2){v1[0], v1[1]}), d = gelu_pk((f32x2){v1[2], v1[3]});
                        v0 = (f32x4){a.x, a.y, b.x, b.y}; v1 = (f32x4){c.x, c.y, d.x, d.y}; }
                    v0 = v0 * sc; v1 = v1 * sc; u32x4 w; w.x = cvt_pk_bf16(v0[0], v0[1]); w.y = cvt_pk_bf16(v0[2], v0[3]); w.z = cvt_pk_bf16(v1[0], v1[1]); w.w = cvt_pk_bf16(v1[2], v1[3]);
                    *(u32x4*)(rowp + bj * HALF) = w; } }
    }
};
typedef int i32x4 __attribute__((ext_vector_type(4)));
__device__ __forceinline__ float sigmoid_f(float x) { return __builtin_amdgcn_rcpf(1.0f + __expf(-x)); }
__device__ __forceinline__ float gelu_tanh_f(float x) { const float t = 1.5957691216057308f * (x + 0.044715f * x * x * x); return x * sigmoid_f(t); }
struct EpiMixIn {
    static constexpr bool PERM = true, AFTER_DRAIN = false;
    bf16_t* aglu; bf16_t* ug; bf16_t* vg;
    __device__ __forceinline__ void operator()(const f32x4 (&acc)[2][2][4][2], const Unit& u, int wr, int wc, int fr, int fq) const {
        const int row0 = u.pm * BM + wr * 64 + fr;
        if (u.pn < 4) {
            const int col0 = u.pn * 128 + wc * 32 + 8 * fq;
#pragma unroll
            for (int ai = 0; ai < 2; ++ai)
#pragma unroll
                for (int m = 0; m < 4; ++m) {
                    const f32x4 v0 = acc[ai][0][m][0], v1 = acc[ai][0][m][1], g0 = acc[ai][1][m][0], g1 = acc[ai][1][m][1];
                    u32x4 w;
                    w.x = cvt_pk_bf16(v0[0] * sigmoid_f(g0[0]), v0[1] * sigmoid_f(g0[1])); w.y = cvt_pk_bf16(v0[2] * sigmoid_f(g0[2]), v0[3] * sigmoid_f(g0[3]));
                    w.z = cvt_pk_bf16(v1[0] * sigmoid_f(g1[0]), v1[1] * sigmoid_f(g1[1])); w.w = cvt_pk_bf16(v1[2] * sigmoid_f(g1[2]), v1[3] * sigmoid_f(g1[3]));
                    *(u32x4*)(aglu + (size_t)(row0 + ai * HALF + m * 16) * 512 + col0) = w;
                }
        } else {
            bf16_t* dst = (u.pn < 6) ? ug : vg; const int col0 = (u.pn & 1) * 256 + wc * 32 + 8 * fq;
#pragma unroll
            for (int ai = 0; ai < 2; ++ai)
#pragma unroll
                for (int m = 0; m < 4; ++m)
#pragma unroll
                    for (int bj = 0; bj < 2; ++bj) {
                        const f32x4 v0 = acc[ai][bj][m][0], v1 = acc[ai][bj][m][1];
                        u32x4 w;
                        w.x = cvt_pk_bf16(gelu_tanh_f(v0[0]), gelu_tanh_f(v0[1])); w.y = cvt_pk_bf16(gelu_tanh_f(v0[2]), gelu_tanh_f(v0[3]));
                        w.z = cvt_pk_bf16(gelu_tanh_f(v1[0]), gelu_tanh_f(v1[1])); w.w = cvt_pk_bf16(gelu_tanh_f(v1[2]), gelu_tanh_f(v1[3]));
                        *(u32x4*)(dst + (size_t)(row0 + ai * HALF + m * 16) * 512 + col0 + bj * HALF) = w;
                    }
        }
    }
};
struct EpiRes {
    static constexpr bool PERM = false, AFTER_DRAIN = false;
    const float* base; float* out; int ldc;
    __device__ __forceinline__ void operator()(const f32x4 (&acc)[2][2][4][2], const Unit& u, int wr, int wc, int fr, int fq) const {
        const int col0 = u.pn * BM + wc * 32 + 4 * fq;
#pragma unroll
        for (int ai = 0; ai < 2; ++ai)
#pragma unroll
            for (int m = 0; m < 4; ++m) { const size_t off = (size_t)(u.pm * BM + ai * HALF + wr * 64 + m * 16 + fr) * ldc + col0;
#pragma unroll
                for (int bj = 0; bj < 2; ++bj)
#pragma unroll
                    for (int n = 0; n < 2; ++n) { const f32x4 bs = *(const f32x4*)(base + off + bj * HALF + n * 16); *(f32x4*)(out + off + bj * HALF + n * 16) = bs + acc[ai][bj][m][n]; } }
    }
};

struct EpiQKV {
    static constexpr bool PERM = true, AFTER_DRAIN = false;
    bf16_t* Q; size_t split_stride; const float* ssq; float* kmf; float qscale, eps;
    __device__ __forceinline__ void operator()(const f32x4 (&acc)[2][2][4][2], const Unit& u, int wr, int wc, int fr, int fq) const {
        const int row0 = u.pm * BM + wr * 64 + fr; const int tsel = u.pn >> 2, colt = (u.pn & 3) * 256;
        bf16_t* base = Q + (size_t)tsel * split_stride; const int col0 = colt + wc * 32 + 8 * fq;
        const float sc = tsel == 0 ? qscale : 1.f;
        f32x4 cs[2][2];
#pragma unroll
        for (int bj = 0; bj < 2; ++bj) { cs[bj][0] = (f32x4){0.f, 0.f, 0.f, 0.f}; cs[bj][1] = (f32x4){0.f, 0.f, 0.f, 0.f}; }
#pragma unroll
        for (int ai = 0; ai < 2; ++ai)
#pragma unroll
            for (int m = 0; m < 4; ++m) { const int row = row0 + ai * HALF + m * 16; const float rs = rsqrtf(ssq[row] * (1.0f / 1024.0f) + eps) * sc;
#pragma unroll
                for (int bj = 0; bj < 2; ++bj) { const f32x4 v0 = acc[ai][bj][m][0] * rs, v1 = acc[ai][bj][m][1] * rs; cs[bj][0] += v0; cs[bj][1] += v1;
                    u32x4 w; w.x = cvt_pk_bf16(v0[0], v0[1]); w.y = cvt_pk_bf16(v0[2], v0[3]); w.z = cvt_pk_bf16(v1[0], v1[1]); w.w = cvt_pk_bf16(v1[2], v1[3]);
                    *(u32x4*)(base + (size_t)row * 1024 + col0 + bj * HALF) = w; } }
        if (tsel == 1) {
#pragma unroll
            for (int bj = 0; bj < 2; ++bj)
#pragma unroll
                for (int n = 0; n < 2; ++n)
#pragma unroll
                    for (int e = 0; e < 4; ++e) { float v = cs[bj][n][e];
                        v += __builtin_bit_cast(float, __builtin_amdgcn_update_dpp(0, __builtin_bit_cast(int, v), 0xB1, 0xf, 0xf, true)); v += __builtin_bit_cast(float, __builtin_amdgcn_update_dpp(0, __builtin_bit_cast(int, v), 0x4E, 0xf, 0xf, true));
                        v += __builtin_bit_cast(float, __builtin_amdgcn_update_dpp(0, __builtin_bit_cast(int, v), 0x141, 0xf, 0xf, true)); v += __builtin_bit_cast(float, __builtin_amdgcn_update_dpp(0, __builtin_bit_cast(int, v), 0x128, 0xf, 0xf, true));
                        if (fr == 0) atomicAdd(kmf + (size_t)u.pm * 1024 + col0 + bj * HALF + 4 * n + e, v * (1.0f / 256.0f)); }
        }
    }
};

template <class Inner> struct EpiI8 {
    static constexpr bool PERM = true, AFTER_DRAIN = false; static_assert(Inner::PERM, "EpiI8 wraps PERM epilogues");
    Inner E; const float* sa; const float* sb;
    __device__ __forceinline__ void operator()(const f32x4 (&acc)[2][2][4][2], const Unit& u, int wr, int wc, int fr, int fq) const {
        const int cb0 = u.pn * BM + wc * 32 + 8 * fq, row0 = u.pm * BM + wr * 64 + fr;
        f32x4 sbv[2][2];
#pragma unroll
        for (int bj = 0; bj < 2; ++bj)
#pragma unroll
            for (int n = 0; n < 2; ++n) sbv[bj][n] = *(const f32x4*)(sb + cb0 + bj * HALF + 4 * n);
        f32x4 cv[2][2][4][2];
#pragma unroll
        for (int ai = 0; ai < 2; ++ai)
#pragma unroll
            for (int m = 0; m < 4; ++m) { const float ra = sa[row0 + ai * HALF + m * 16];
#pragma unroll
                for (int bj = 0; bj < 2; ++bj)
#pragma unroll
                    for (int n = 0; n < 2; ++n) { const i32x4 iv = __builtin_bit_cast(i32x4, acc[ai][bj][m][n]);
                        cv[ai][bj][m][n] = (f32x4){(float)iv[0], (float)iv[1], (float)iv[2], (float)iv[3]} * ra * sbv[bj][n]; } }
        E(cv, u, wr, wc, fr, fq);
    }
};

template <bool BF> struct EpiResB {
    static constexpr bool PERM = false, AFTER_DRAIN = false;
    const float* basef; const bf16_t* baseb; bf16_t* outb; int ldc;
    __device__ __forceinline__ void operator()(const f32x4 (&acc)[2][2][4][2], const Unit& u, int wr, int wc, int fr, int fq) const {
        typedef unsigned u32x2 __attribute__((ext_vector_type(2)));
        const int col0 = u.pn * BM + wc * 32 + 4 * fq;
#pragma unroll
        for (int ai = 0; ai < 2; ++ai)
#pragma unroll
            for (int m = 0; m < 4; ++m) { const size_t off = (size_t)(u.pm * BM + ai * HALF + wr * 64 + m * 16 + fr) * ldc + col0;
#pragma unroll
                for (int bj = 0; bj < 2; ++bj)
#pragma unroll
                    for (int n = 0; n < 2; ++n) { const size_t o = off + bj * HALF + n * 16; f32x4 bs;
                        if (BF) { const u32x2 w = *(const u32x2*)(baseb + o); bs = (f32x4){__builtin_bit_cast(float, w.x << 16), __builtin_bit_cast(float, w.x & 0xffff0000u), __builtin_bit_cast(float, w.y << 16), __builtin_bit_cast(float, w.y & 0xffff0000u)}; }
                        else bs = *(const f32x4*)(basef + o);
                        const f32x4 v = bs + acc[ai][bj][m][n]; u32x2 wv; wv.x = cvt_pk_bf16(v[0], v[1]); wv.y = cvt_pk_bf16(v[2], v[3]); *(u32x2*)(outb + o) = wv; } }
    }
};

struct EpiQKVM {
    static constexpr bool PERM = true, AFTER_DRAIN = false;
    EpiBf16<0> B; float* kmp; int ntm;
    __device__ __forceinline__ void operator()(const f32x4 (&acc)[2][2][4][2], const Unit& u, int wr, int wc, int fr, int fq) const {
        B(acc, u, wr, wc, fr, fq);
        if (u.pn >= 4 && u.pn < 8) {
            float* dst = kmp + ((size_t)wr * ntm + u.pm) * 1024 + (u.pn - 4) * BM + wc * 32 + 8 * fq;
#pragma unroll
            for (int bj = 0; bj < 2; ++bj)
#pragma unroll
                for (int n = 0; n < 2; ++n) { f32x4 cs = (acc[0][bj][0][n] + acc[0][bj][1][n]) + (acc[0][bj][2][n] + acc[0][bj][3][n]) + ((acc[1][bj][0][n] + acc[1][bj][1][n]) + (acc[1][bj][2][n] + acc[1][bj][3][n]));
#pragma unroll
                    for (int e = 0; e < 4; ++e) { float v = cs[e];
                        v += __builtin_bit_cast(float, __builtin_amdgcn_update_dpp(0, __builtin_bit_cast(int, v), 0xB1, 0xf, 0xf, true)); v += __builtin_bit_cast(float, __builtin_amdgcn_update_dpp(0, __builtin_bit_cast(int, v), 0x4E, 0xf, 0xf, true));
                        v += __builtin_bit_cast(float, __builtin_amdgcn_update_dpp(0, __builtin_bit_cast(int, v), 0x141, 0xf, 0xf, true)); v += __builtin_bit_cast(float, __builtin_amdgcn_update_dpp(0, __builtin_bit_cast(int, v), 0x128, 0xf, 0xf, true));
                        cs[e] = v * (1.0f / 256.0f); }
                    if (fr == 0) *(f32x4*)(dst + bj * HALF + 4 * n) = cs; }
        }
    }
};

template <bool KM> struct EpiI8Bf16 {
    static constexpr bool PERM = true, AFTER_DRAIN = false;
    bf16_t* O; int ldc; int split_cols; size_t split_stride; float scale0; const float* sa; const float* sb; float* kmp; int ntm;
    __device__ __forceinline__ void operator()(const f32x4 (&acc)[2][2][4][2], const Unit& u, int wr, int wc, int fr, int fq) const {
        const int row0 = u.pm * BM + wr * 64 + fr; int colt = u.pn * BM, tsel = 0; bf16_t* base = O; float sc = 1.f;
        if (split_cols) { tsel = colt / split_cols; base += (size_t)tsel * split_stride; colt -= tsel * split_cols; if (tsel == 0) sc = scale0; }
        const int col0 = colt + wc * 32 + 8 * fq, cb0 = u.pn * BM + wc * 32 + 8 * fq;
        f32x4 sbv[2][2], cs[2][2];
#pragma unroll
        for (int bj = 0; bj < 2; ++bj)
#pragma unroll
            for (int n = 0; n < 2; ++n) { sbv[bj][n] = *(const f32x4*)(sb + cb0 + bj * HALF + 4 * n) * sc; cs[bj][n] = (f32x4){0.f, 0.f, 0.f, 0.f}; }
#pragma unroll
        for (int ai = 0; ai < 2; ++ai)
#pragma unroll
            for (int m = 0; m < 4; ++m) { const int row = row0 + ai * HALF + m * 16; const float ra = sa[row]; bf16_t* rowp = base + (size_t)row * ldc + col0;
#pragma unroll
                for (int bj = 0; bj < 2; ++bj) { const i32x4 i0 = __builtin_bit_cast(i32x4, acc[ai][bj][m][0]), i1 = __builtin_bit_cast(i32x4, acc[ai][bj][m][1]);
                    const f32x4 v0 = (f32x4){(float)i0[0], (float)i0[1], (float)i0[2], (float)i0[3]} * ra * sbv[bj][0], v1 = (f32x4){(float)i1[0], (float)i1[1], (float)i1[2], (float)i1[3]} * ra * sbv[bj][1];
                    if (KM) { cs[bj][0] += v0; cs[bj][1] += v1; }
                    u32x4 w; w.x = cvt_pk_bf16(v0[0], v0[1]); w.y = cvt_pk_bf16(v0[2], v0[3]); w.z = cvt_pk_bf16(v1[0], v1[1]); w.w = cvt_pk_bf16(v1[2], v1[3]);
                    *(u32x4*)(rowp + bj * HALF) = w; } }
        if (KM && tsel == 1) {
            float* dst = kmp + ((size_t)wr * ntm + u.pm) * 1024 + colt + wc * 32 + 8 * fq;
#pragma unroll
            for (int bj = 0; bj < 2; ++bj)
#pragma unroll
                for (int n = 0; n < 2; ++n) { f32x4 c = cs[bj][n];
#pragma unroll
                    for (int e = 0; e < 4; ++e) { float v = c[e];
                        v += __builtin_bit_cast(float, __builtin_amdgcn_update_dpp(0, __builtin_bit_cast(int, v), 0xB1, 0xf, 0xf, true)); v += __builtin_bit_cast(float, __builtin_amdgcn_update_dpp(0, __builtin_bit_cast(int, v), 0x4E, 0xf, 0xf, true));
                        v += __builtin_bit_cast(float, __builtin_amdgcn_update_dpp(0, __builtin_bit_cast(int, v), 0x141, 0xf, 0xf, true)); v += __builtin_bit_cast(float, __builtin_amdgcn_update_dpp(0, __builtin_bit_cast(int, v), 0x128, 0xf, 0xf, true));
                        c[e] = v * (1.0f / 256.0f); }
                    if (fr == 0) *(f32x4*)(dst + bj * HALF + 4 * n) = c; }
        }
    }
};
template <bool I8> __device__ __forceinline__ f32x4 mma_step(const bf16x8& b, const bf16x8& a, const f32x4& c) {
    if constexpr (I8) return __builtin_bit_cast(f32x4, __builtin_amdgcn_mfma_i32_16x16x64_i8(__builtin_bit_cast(i32x4, b), __builtin_bit_cast(i32x4, a), __builtin_bit_cast(i32x4, c), 0, 0, 0));
    else return __builtin_amdgcn_mfma_f32_16x16x32_bf16(b, a, c, 0, 0, 0);
}
template <class Epi, class Sched, bool ALIGN_EPI = false, bool SP2 = false, bool I8 = false>
__device__ __forceinline__ void gemm_phase(PG8_LAS unsigned char* lds, const Gemm g, const Sched& S, const Epi& E) {
    const int tid = threadIdx.x, wid = __builtin_amdgcn_readfirstlane(tid >> 6), lane = tid & 63, wr = wid >> 2, wc = wid & 3, fr = lane & 15, fq = lane >> 4;
    const int K = g.K, nt = K / BK;
    unsigned voffA[2], voffB[2];
#pragma unroll
    for (int i = 0; i < 2; ++i) { int R, C; stage_rc(tid * 16 + i * 8192, R, C); const int Rb = Epi::PERM ? ((R & ~31) + perm32(R & 31)) : R;
        voffA[i] = (unsigned)(R * K + C) * 2u; voffB[i] = (unsigned)(Rb * K + C) * 2u; }
    const size_t kstep = (size_t)(BK * 2);
    const size_t hstep = (size_t)HALF * K * 2;
    const size_t tstep = 2 * hstep;
    const unsigned ldsw = (unsigned)wid * 1024u;
    const int aoff = lds_byte(wr * 64 + fr, fq * 8), boff = lds_byte(wc * 32 + fr, fq * 8);
#define PG8_SA(b, h) (((b) * 2 + (h)) * HTB)
#define PG8_SB(b, h) ((4 + (b) * 2 + (h)) * HTB)
#define PG8_STAGE(bufoff, gbase, voff) do { _Pragma("unroll") for (int _i = 0; _i < 2; ++_i) \
        __builtin_amdgcn_global_load_lds((const unsigned*)((const char*)(gbase) + (voff)[_i]), (PG8_LAS unsigned*)(lds + (bufoff) + ldsw + _i * 8192), 16, 0, 0); } while (0)
#define PG8_LDA(dst, b, h) do { _Pragma("unroll") for (int m = 0; m < 4; ++m) _Pragma("unroll") for (int k = 0; k < 2; ++k) dst[m][k] = *(const PG8_LAS bf16x8*)(lds + PG8_SA(b, h) + aoff + m * 2048 + k * 1024); } while (0)
#define PG8_LDB(dst, b, h) do { _Pragma("unroll") for (int n = 0; n < 2; ++n) _Pragma("unroll") for (int k = 0; k < 2; ++k) dst[n][k] = *(const PG8_LAS bf16x8*)(lds + PG8_SB(b, h) + boff + n * 2048 + k * 1024); } while (0)
#define PG8_MMA(ai, bj, At, Bt) do { __builtin_amdgcn_s_setprio(1); _Pragma("unroll") for (int m = 0; m < 4; ++m) _Pragma("unroll") for (int n = 0; n < 2; ++n) _Pragma("unroll") for (int k = 0; k < 2; ++k) \
        acc[ai][bj][m][n] = mma_step<I8>(Bt[n][k], At[m][k], acc[ai][bj][m][n]); __builtin_amdgcn_s_setprio(0); } while (0)
#define PG8_WAIT_V(n) asm volatile("s_waitcnt vmcnt(" #n ")" ::: "memory")
#define PG8_WAIT_L(n) asm volatile("s_waitcnt lgkmcnt(" #n ")" ::: "memory")
#define PG8_BAR __builtin_amdgcn_s_barrier()
#define PG8_SCHED __builtin_amdgcn_sched_barrier(0)
    Unit cur, nxt; int ui = 0;
    if (!S.next(0, cur)) return;
    f32x4 acc[2][2][4][2];
#pragma unroll
    for (int a = 0; a < 2; ++a)
#pragma unroll
        for (int b = 0; b < 2; ++b)
#pragma unroll
            for (int m = 0; m < 4; ++m)
#pragma unroll
                for (int n = 0; n < 2; ++n) acc[a][b][m][n] = (f32x4){0.f, 0.f, 0.f, 0.f};
    bf16x8 At[4][2], B0[2][2], B1[2][2];
    const char* cA = (const char*)g.A + (size_t)cur.pm * tstep; const char* cB = (const char*)g.Bt + (size_t)cur.pn * tstep;
    S.a_ready(cur);
    if constexpr (SP2) {
        PG8_STAGE(PG8_SB(0, 0), cB, voffB); PG8_STAGE(PG8_SB(0, 1), cB + hstep, voffB); PG8_STAGE(PG8_SA(0, 0), cA, voffA); PG8_STAGE(PG8_SA(0, 1), cA + hstep, voffA);
        if (wr == 1) PG8_BAR;
        PG8_WAIT_V(2); PG8_BAR;
        PG8_STAGE(PG8_SB(1, 0), cB + kstep, voffB); PG8_STAGE(PG8_SA(1, 0), cA + kstep, voffA); PG8_STAGE(PG8_SB(1, 1), cB + hstep + kstep, voffB);
        PG8_WAIT_V(6); PG8_BAR;
    } else {
        PG8_STAGE(PG8_SB(0, 0), cB, voffB); PG8_STAGE(PG8_SA(0, 0), cA, voffA); PG8_STAGE(PG8_SB(0, 1), cB + hstep, voffB); PG8_STAGE(PG8_SA(0, 1), cA + hstep, voffA);
        if (wr == 1) PG8_BAR;
        PG8_WAIT_V(4); PG8_BAR;
        PG8_STAGE(PG8_SB(1, 0), cB + kstep, voffB); PG8_STAGE(PG8_SA(1, 0), cA + kstep, voffA); PG8_STAGE(PG8_SB(1, 1), cB + hstep + kstep, voffB);
        PG8_WAIT_V(6); PG8_BAR;
    }
    for (;;) {
        const bool has_next = S.next(ui + 1, nxt);
        const char* nA = has_next ? (const char*)g.A + (size_t)nxt.pm * tstep : cA; const char* nB = has_next ? (const char*)g.Bt + (size_t)nxt.pn * tstep : cB;
        for (int t = 0; t < nt; t += 2) {
            const bool last = (t == nt - 2);
            const char* a1 = cA + (size_t)(t + 1) * kstep;
            const char* a2 = last ? nA : cA + (size_t)(t + 2) * kstep; const char* b2 = last ? nB : cB + (size_t)(t + 2) * kstep;
            const char* a3 = a2 + kstep; const char* b3 = b2 + kstep;
            if (last && has_next) S.a_ready(nxt);
            if constexpr (SP2) {
            PG8_LDB(B0, 0, 0); PG8_LDB(B1, 0, 1); PG8_SCHED; PG8_LDA(At, 0, 0); PG8_STAGE(PG8_SA(1, 1), a1 + hstep, voffA);
            PG8_WAIT_V(8); PG8_WAIT_L(0); PG8_BAR; PG8_MMA(0, 0, At, B0); PG8_MMA(0, 1, At, B1); PG8_BAR; PG8_SCHED;
            PG8_LDA(At, 0, 1); PG8_STAGE(PG8_SB(0, 0), b2, voffB); PG8_STAGE(PG8_SB(0, 1), b2 + hstep, voffB); PG8_STAGE(PG8_SA(0, 0), a2, voffA);
            PG8_WAIT_V(8); PG8_WAIT_L(0); PG8_BAR; PG8_MMA(1, 0, At, B0); PG8_MMA(1, 1, At, B1); PG8_BAR; PG8_SCHED;
            PG8_LDB(B0, 1, 0); PG8_LDB(B1, 1, 1); PG8_SCHED; PG8_LDA(At, 1, 0); PG8_STAGE(PG8_SA(0, 1), a2 + hstep, voffA);
            PG8_WAIT_V(8); PG8_WAIT_L(0); PG8_BAR; PG8_MMA(0, 0, At, B0); PG8_MMA(0, 1, At, B1); PG8_BAR; PG8_SCHED;
            PG8_LDA(At, 1, 1); PG8_STAGE(PG8_SB(1, 0), b3, voffB); PG8_STAGE(PG8_SB(1, 1), b3 + hstep, voffB); PG8_STAGE(PG8_SA(1, 0), a3, voffA);
            PG8_WAIT_V(8); PG8_WAIT_L(0); PG8_BAR; PG8_MMA(1, 0, At, B0); PG8_MMA(1, 1, At, B1); PG8_BAR; PG8_SCHED;
            } else {
            PG8_LDB(B0, 0, 0); PG8_SCHED; PG8_LDA(At, 0, 0); PG8_STAGE(PG8_SA(1, 1), a1 + hstep, voffA);
            PG8_WAIT_L(8); PG8_BAR; PG8_WAIT_L(0); PG8_MMA(0, 0, At, B0); PG8_BAR; PG8_SCHED;
            PG8_LDB(B1, 0, 1); PG8_STAGE(PG8_SB(0, 0), b2, voffB);
            PG8_BAR; PG8_WAIT_L(0); PG8_MMA(0, 1, At, B1); PG8_BAR;
            PG8_LDA(At, 0, 1); PG8_STAGE(PG8_SA(0, 0), a2, voffA);
            PG8_BAR; PG8_WAIT_L(0); PG8_MMA(1, 0, At, B0); PG8_BAR; PG8_SCHED;
            PG8_STAGE(PG8_SB(0, 1), b2 + hstep, voffB);
            PG8_WAIT_V(6); PG8_BAR; PG8_MMA(1, 1, At, B1); PG8_BAR;
            PG8_LDB(B0, 1, 0); PG8_SCHED; PG8_LDA(At, 1, 0); PG8_STAGE(PG8_SA(0, 1), a2 + hstep, voffA);
            PG8_WAIT_L(8); PG8_BAR; PG8_WAIT_L(0); PG8_MMA(0, 0, At, B0); PG8_BAR; PG8_SCHED;
            PG8_LDB(B1, 1, 1); PG8_STAGE(PG8_SB(1, 0), b3, voffB);
            PG8_BAR; PG8_WAIT_L(0); PG8_MMA(0, 1, At, B1); PG8_BAR;
            PG8_LDA(At, 1, 1); PG8_STAGE(PG8_SA(1, 0), a3, voffA);
            PG8_BAR; PG8_WAIT_L(0); PG8_MMA(1, 0, At, B0); PG8_BAR; PG8_SCHED;
            PG8_STAGE(PG8_SB(1, 1), b3 + hstep, voffB);
            PG8_WAIT_V(6); PG8_BAR; PG8_MMA(1, 1, At, B1); PG8_BAR;
            }
        }
        if constexpr (ALIGN_EPI) { if (wr == 0) PG8_BAR; }
        if constexpr (!Epi::AFTER_DRAIN) { E(acc, cur, wr, wc, fr, fq); S.done(cur); }
        if (!has_next) break;
#pragma unroll
        for (int a = 0; a < 2; ++a)
#pragma unroll
            for (int b = 0; b < 2; ++b)
#pragma unroll
                for (int m = 0; m < 4; ++m)
#pragma unroll
                    for (int n = 0; n < 2; ++n) acc[a][b][m][n] = (f32x4){0.f, 0.f, 0.f, 0.f};
        cur = nxt; cA = nA; cB = nB; ++ui;
        if constexpr (ALIGN_EPI) { if (wr == 1) PG8_BAR; }
    }
    PG8_WAIT_V(0);
    if constexpr (!ALIGN_EPI) { if (wr == 0) PG8_BAR; }
    PG8_BAR;
    if constexpr (Epi::AFTER_DRAIN) { E.fused(acc, cur, wr, wc, fr, fq, lds, wid, lane); S.done(cur); }
#undef PG8_SA
#undef PG8_SB
#undef PG8_STAGE
#undef PG8_LDA
#undef PG8_LDB
#undef PG8_MMA
#undef PG8_WAIT_V
#undef PG8_WAIT_L
#undef PG8_BAR
#undef PG8_SCHED
}
}
#include <hip/hip_bf16.h>
#include <cmath>
namespace attn_body {
using bf16=__hip_bfloat16;
using bf16x8=__attribute__((ext_vector_type(8)))short;
using s16x4=__attribute__((ext_vector_type(4)))short;
using f32x16=__attribute__((ext_vector_type(16)))float;
using u32x4=__attribute__((ext_vector_type(4)))unsigned;
using f32x4_t=__attribute__((ext_vector_type(4)))float;
constexpr int BATCH=8,NHEAD=16,SEQ=4096,D=64,DM=NHEAD*D;
constexpr int NW=8,QBLK=32,QB=QBLK*NW,KVBLK=64,NQB=SEQ/QB;
constexpr int ATTN_PITCH=DM, ATTN_UNIT_ROWS=QB;
__device__ __forceinline__ int crow(int r,int hi){return (r&3)+8*(r>>2)+4*hi;}
#define SBAR() __builtin_amdgcn_sched_barrier(0)
__device__ __forceinline__ void cmask(f32x16&p0,f32x16&p1,int jb,int qrel,int hi){
  const float NEG=-INFINITY; int kb=64*jb+4*hi;
  #pragma unroll
  for(int r=0;r<16;++r){int kv=kb+(r&3)+8*(r>>2); if(kv>qrel)p0[r]=NEG; if(kv+32>qrel)p1[r]=NEG;}
}

constexpr int NSLOT=3, SLOTB=8192;
constexpr int LDS_K=0, LDS_V=NSLOT*SLOTB, LDS_WS=2*NSLOT*SLOTB, LDS_OST=LDS_WS+NW*64*4, LDS_LUTB=LDS_OST+NW*4096, LUTL_OFF=256, LUTL_N=SEQ+LUTL_OFF, LDS_BYTES=LDS_LUTB+LUTL_N*4;
constexpr float C2=0.125f*1.4426950408889634f; constexpr int GLUT_OFF=256, GLUT_N=SEQ+GLUT_OFF;
__device__ __forceinline__ void glds16(const void*gsrc,unsigned lds_dst){unsigned keep;
  asm volatile("s_mov_b32 %0, m0\n\ts_mov_b32 m0, %2\n\ts_nop 0\n\tglobal_load_lds_dwordx4 %1, off\n\ts_mov_b32 m0, %0":"=&s"(keep):"v"(gsrc),"s"(lds_dst):"memory");}
__device__ __forceinline__ float max3f(float a,float b,float c){float r;asm("v_max3_f32 %0, %1, %2, %3":"=v"(r):"v"(a),"v"(b),"v"(c));return r;}
__device__ __forceinline__ float max2f(float a,float b){float r;asm("v_max_f32_e32 %0, %1, %2":"=v"(r):"v"(a),"v"(b));return r;}
__device__ __forceinline__ float fadd_s(float a,float b){float r;asm("v_add_f32_e32 %0, %1, %2":"=v"(r):"v"(a),"v"(b));return r;}
__device__ __forceinline__ float fsub_s(float a,float b){float r;asm("v_sub_f32_e32 %0, %1, %2":"=v"(r):"v"(a),"v"(b));return r;}
typedef float f32x2_t __attribute__((ext_vector_type(2))); typedef __bf16 bf16x2_t __attribute__((ext_vector_type(2)));
__device__ __forceinline__ unsigned cvtpk_s(float lo,float hi){f32x2_t v={lo,hi};bf16x2_t b=__builtin_convertvector(v,bf16x2_t);return __builtin_bit_cast(unsigned,b);}
#define WAIT_BAR(N) asm volatile("s_waitcnt vmcnt(" #N ") lgkmcnt(0)\n\ts_barrier":::"memory")

__device__ __forceinline__ void qkt(f32x16&p0,f32x16&p1,const char*Kslot,const bf16x8*qr,int r32,int hi){
  const char*kb=Kslot+hi*1024+r32*16;
  #pragma unroll
  for(int d0=0;d0<4;++d0){
    const bf16x8 b0=*reinterpret_cast<const bf16x8*>(kb+d0*2048);
    const bf16x8 b1=*reinterpret_cast<const bf16x8*>(kb+d0*2048+512);
    {p0=__builtin_amdgcn_mfma_f32_32x32x16_bf16(b0,qr[d0],p0,0,0,0);p1=__builtin_amdgcn_mfma_f32_32x32x16_bf16(b1,qr[d0],p1,0,0,0);}}
}
typedef __attribute__((address_space(3))) const char* lds_cptr; typedef __attribute__((address_space(3))) float* lds_fptr;
typedef short v4i16_t __attribute__((ext_vector_type(4)));
__device__ __forceinline__ void kload8(bf16x8*kf,lds_cptr kp){
  kf[0]=*(const __attribute__((address_space(3))) bf16x8*)(kp);      kf[1]=*(const __attribute__((address_space(3))) bf16x8*)(kp+512);
  kf[2]=*(const __attribute__((address_space(3))) bf16x8*)(kp+2048); kf[3]=*(const __attribute__((address_space(3))) bf16x8*)(kp+2560);
  kf[4]=*(const __attribute__((address_space(3))) bf16x8*)(kp+4096); kf[5]=*(const __attribute__((address_space(3))) bf16x8*)(kp+4608);
  kf[6]=*(const __attribute__((address_space(3))) bf16x8*)(kp+6144); kf[7]=*(const __attribute__((address_space(3))) bf16x8*)(kp+6656);
}
__device__ __forceinline__ void kload2(bf16x8*kf,lds_cptr kp,int j){ kf[2*j]=*(const __attribute__((address_space(3))) bf16x8*)(kp+j*2048); kf[2*j+1]=*(const __attribute__((address_space(3))) bf16x8*)(kp+j*2048+512); }
__device__ __forceinline__ s16x4 vtr(lds_cptr p){ return __builtin_bit_cast(s16x4,__builtin_amdgcn_ds_read_tr16_b64_v4i16((__attribute__((address_space(3))) v4i16_t*)p)); }
__device__ __forceinline__ float rowmax(const f32x16&p0,const f32x16&p1){
  float a=max3f(p0[0],p0[1],p1[0]),b=max3f(p0[2],p0[3],p1[1]);a=max3f(a,p1[2],p1[3]);
  #pragma unroll
  for(int r=4;r<16;r+=4){a=max3f(a,p0[r],p0[r+1]);b=max3f(b,p0[r+2],p0[r+3]);a=max3f(a,p1[r],p1[r+1]);b=max3f(b,p1[r+2],p1[r+3]);}
  const float m=max2f(a,b);
  auto rr=__builtin_amdgcn_permlane32_swap(__float_as_uint(m),__float_as_uint(m),false,false);
  return max2f(__uint_as_float(rr[0]),__uint_as_float(rr[1]));
}
__device__ __forceinline__ void pv(f32x16*o,int vb,bf16x8 pa0,bf16x8 pa1,bf16x8 pa2,bf16x8 pa3){
  #pragma unroll
  for(int d0=0;d0<2;++d0){s16x4 lo[4],hi[4];
    #pragma unroll
    for(int ks=0;ks<4;++ks){
      asm volatile("ds_read_b64_tr_b16 %0,%1 offset:%c2":"=&v"(lo[ks]):"v"(vb),"i"(d0*4096+ks*1024):"memory");
      asm volatile("ds_read_b64_tr_b16 %0,%1 offset:%c2":"=&v"(hi[ks]):"v"(vb),"i"(d0*4096+ks*1024+512):"memory");}
    asm volatile("s_waitcnt lgkmcnt(0)":::"memory");SBAR();
    #define PK(k) (bf16x8){lo[k][0],lo[k][1],lo[k][2],lo[k][3],hi[k][0],hi[k][1],hi[k][2],hi[k][3]}
    o[d0]=__builtin_amdgcn_mfma_f32_32x32x16_bf16(pa0,PK(0),o[d0],0,0,0);
    o[d0]=__builtin_amdgcn_mfma_f32_32x32x16_bf16(pa1,PK(1),o[d0],0,0,0);
    o[d0]=__builtin_amdgcn_mfma_f32_32x32x16_bf16(pa2,PK(2),o[d0],0,0,0);
    o[d0]=__builtin_amdgcn_mfma_f32_32x32x16_bf16(pa3,PK(3),o[d0],0,0,0);
    #undef PK
  }
}

#ifndef ATTN_STORE16
#define ATTN_STORE16(p,v) (*(u32x4*)(p)=(v))
#endif
template<int THRL,int PLAIN=0> __device__ __forceinline__ void attn_unit(int b,int h,int qb,const bf16*Q,const bf16*K,const bf16*V,bf16*O,const float*KM,const float*GLUT,char*shm,bool newhead){
  int tid_=threadIdx.x; asm volatile("":"+v"(tid_));
  const int tid=tid_,lane=tid&63,r32=lane&31,hi=lane>>5; const int wid=__builtin_amdgcn_readfirstlane(tid>>6);
  const long rowbase=(long)b*SEQ; const int q0=qb*QB;
  const bf16*Qw=Q+(rowbase+q0+wid*QBLK)*DM+h*D;
  const bf16*Kh=K+rowbase*DM+h*D,*Vh=V+rowbase*DM+h*D;
  const unsigned lds0=(unsigned)(uintptr_t)shm; const lds_cptr shm3=(lds_cptr)shm;
  float*wsf=(float*)(shm+LDS_WS)+wid*64;
  const bf16*ksrc=Kh+(long)lane*DM+wid*8;
  const bf16*vsrc=Vh+(long)(16*(wid&3)+(lane>>2))*DM+(wid>>2)*32+(lane&3)*8;
  const unsigned kdst=lds0+LDS_K+wid*1024, vdst=lds0+LDS_V+wid*1024;
  #define DMA_K(t,slot) glds16(ksrc+(long)(t)*KVBLK*DM,(unsigned)__builtin_amdgcn_readfirstlane(kdst+(slot)))
  #define DMA_V(t,slot) glds16(vsrc+(long)(t)*KVBLK*DM,(unsigned)__builtin_amdgcn_readfirstlane(vdst+(slot)))
  const int vb0=(int)(lds0+LDS_V)+((lane>>4)&1)*32+(lane&3)*8+(4*hi+((lane&15)>>2))*64;
  const char*Kbase=shm+LDS_K; bf16x8 kf[8];
  const lds_cptr kp0=shm3+LDS_K+hi*1024+r32*16; const lds_cptr vp0=shm3+LDS_V+((lane>>4)&1)*32+(lane&3)*8+(4*hi+((lane&15)>>2))*64;
  const int NT=(q0+QB)/KVBLK;
  if(newhead){ lds_fptr lutw=(lds_fptr)(shm3+LDS_LUTB); const float*gl=GLUT+(long)h*GLUT_N+(GLUT_OFF-LUTL_OFF);
    for(int i=tid;i<LUTL_N;i+=NW*64){ const int n=i-LUTL_OFF>0?i-LUTL_OFF:0; int bk=n;
        if(n>=16){ bk=16+(n>=22)+(n>=30)+(n>=40)+(n>=54)+(n>=73)+(n>=99)+(n>=134)+(n>=182)+(n>=246)+(n>=332)+(n>=450)+(n>=609)+(n>=825)+(n>=1117)+(n>=1513); }
        lutw[i]=__uint_as_float((__float_as_uint(gl[i]*1.4426950408889634f)&~31u)|(unsigned)bk); } }
  DMA_K(0,0);DMA_V(0,0);DMA_K(1,SLOTB);
  bf16x8 qr[4];
  #pragma unroll
  for(int d0=0;d0<4;++d0)qr[d0]=*reinterpret_cast<const bf16x8*>(&Qw[(long)r32*DM+d0*16+hi*8]);
  unsigned selmask=0u;
  if(qb>0){ f32x16 g=f32x16{};
    #pragma unroll
    for(int d0=0;d0<4;++d0){ const float*kp_=KM+((long)b*16+(r32&15))*DM+h*D+d0*16+hi*8; const f32x4_t ka_=*reinterpret_cast<const f32x4_t*>(kp_)+*reinterpret_cast<const f32x4_t*>(kp_+BATCH*16*DM),kb_=*reinterpret_cast<const f32x4_t*>(kp_+4)+*reinterpret_cast<const f32x4_t*>(kp_+4+BATCH*16*DM);     const u32x4 kw_={cvtpk_s(ka_[0],ka_[1]),cvtpk_s(ka_[2],ka_[3]),cvtpk_s(kb_[0],kb_[1]),cvtpk_s(kb_[2],kb_[3])}; const bf16x8 kmf=__builtin_bit_cast(bf16x8,kw_); g=__builtin_amdgcn_mfma_f32_32x32x16_bf16(kmf,qr[d0],g,0,0,0); }
    float G[16];
    #pragma unroll
    for(int i=0;i<4;++i){ const float o0=__shfl_xor(g[i],32),o1=__shfl_xor(g[4+i],32); G[i]=hi?o0:g[i]; G[4+i]=hi?g[i]:o0; G[8+i]=hi?o1:g[4+i]; G[12+i]=hi?g[4+i]:o1; }
    float m1_=-INFINITY,m2_=-INFINITY,m3_=-INFINITY;
    #pragma unroll
    for(int i=0;i<15;++i){ const float t0_=(i<qb)?G[i]:-INFINITY; G[i]=t0_; const float t1_=__builtin_fminf(m1_,t0_); m1_=__builtin_fmaxf(m1_,t0_); const float t2_=__builtin_fminf(m2_,t1_); m2_=__builtin_fmaxf(m2_,t1_); m3_=__builtin_fmaxf(m3_,t2_); }
    unsigned gt_=0u,ge_=0u;
    #pragma unroll
    for(int j=14;j>=0;--j){ gt_=gt_+gt_+(unsigned)(G[j]>m3_); ge_=ge_+ge_+(unsigned)(G[j]>=m3_); }
    { const unsigned eq_=ge_^gt_; const int need_=3-__builtin_popcount(gt_);
      const unsigned e1_=eq_&(0u-eq_), r1_=eq_^e1_, e2_=r1_&(0u-r1_), r2_=r1_^e2_, e3_=r2_&(0u-r2_);
      selmask=(gt_|e1_|(need_>=2?e2_:0u)|(need_>=3?e3_:0u))&((1u<<qb)-1u); } }
  const lds_fptr lutu=(lds_fptr)(shm3+LDS_LUTB)+(LUTL_OFF+q0+wid*QBLK);
  const lds_fptr lutq=(lds_fptr)(shm3+LDS_LUTB)+(LUTL_OFF-59+q0+wid*QBLK+r32-4*hi);
  float mhat=0.f,l_reg=0.f;f32x16 o[2];o[0]=f32x16{};o[1]=f32x16{};
  const int qrel=wid*QBLK+r32;
  #define CMASK(P0,P1,t) do{int jb_=(t)-(NT-4); if(jb_>=0)cmask(P0,P1,jb_,qrel,hi);}while(0)
  #define BIAS(P0,P1,t) do{ if(PLAIN==1){ _Pragma("unroll") for(int r_=0;r_<16;++r_){ P0[r_]=-mhat; P1[r_]=-mhat; } SBAR(); } else { \
      const bool keep_=((t)>=NT-4)||((selmask>>((t)>>2))&1u); const float mh_=keep_?mhat:INFINITY; \
      const lds_fptr lu_=lutu-64*(t); const unsigned umax_=__builtin_amdgcn_readfirstlane(__float_as_uint(lu_[31])), umin_=__builtin_amdgcn_readfirstlane(__float_as_uint(lu_[-63])); \
      if(PLAIN!=3&&(PLAIN==2||((umax_^umin_)&31u)==0u)){ const float cv_=__uint_as_float(umax_)-mh_; _Pragma("unroll") for(int r_=0;r_<16;++r_){ P0[r_]=cv_; P1[r_]=cv_; } } \
      else { const lds_fptr lp_=lutq-64*(t); _Pragma("unroll") for(int g_=0;g_<4;++g_){ float b0_[4],b1_[4]; \
        _Pragma("unroll") for(int k_=0;k_<4;++k_){ b0_[k_]=lp_[59-8*g_-k_]; b1_[k_]=lp_[27-8*g_-k_]; } \
        _Pragma("unroll") for(int k_=0;k_<4;++k_){ P0[4*g_+k_]=b0_[k_]-mh_; P1[4*g_+k_]=b1_[k_]-mh_; } } } SBAR(); } }while(0)
  #define MMASK(P0,P1,t) do{}while(0)
  bool resc=false;
  #define START(P0,P1) do{ const float rm=rowmax(P0,P1); resc=false; \
    { const float dl=max2f(rm,-64.f); mhat=fadd_s(mhat,dl); \
      _Pragma("unroll") for(int r=0;r<16;++r){P0[r]=fsub_s(P0[r],dl);P1[r]=fsub_s(P1[r],dl);} \
      } \
    _Pragma("unroll") for(int r=0;r<16;++r)P0[r]=__builtin_amdgcn_exp2f(P0[r]); }while(0)
  #define RESC() do{ if(resc){ asm volatile("s_waitcnt lgkmcnt(0)":::"memory"); \
      _Pragma("unroll") for(int d_=0;d_<2;++d_) _Pragma("unroll") for(int r=0;r<16;++r)o[d_][r]*=wsf[crow(r,hi)]; } }while(0)
  f32x16 pA0,pA1,pB0,pB1;
  int sl_prev=0,sl_cur=0,sl_next=SLOTB;
  #define ROT() do{sl_prev=sl_cur;sl_cur=sl_next;sl_next=(sl_next==(NSLOT-1)*SLOTB)?0:sl_next+SLOTB;}while(0)
  DMA_K(2,2*SLOTB);
  WAIT_BAR(3);
  BIAS(pA0,pA1,0);qkt(pA0,pA1,Kbase,qr,r32,hi);asm volatile("s_nop 15\n\ts_nop 7":"+v"(pA0),"+v"(pA1));if(NT>4){MMASK(pA0,pA1,0);}CMASK(pA0,pA1,0);
  START(pA0,pA1);
  _Pragma("unroll") for(int r=0;r<16;++r)pA1[r]=__builtin_amdgcn_exp2f(pA1[r]);
  WAIT_BAR(0);
  DMA_K(3,0);DMA_V(1,SLOTB);
  ROT();
  kload8(kf,kp0+sl_cur);
  WAIT_BAR(2);
  s16x4 vlo[8],vhi[8]; u32x4 pw0,pw1,pw2,pw3;
  #define PKW(P,B) cvtpk_s(P[B],P[B+1])
  #define PAF(k) __builtin_bit_cast(bf16x8,pw##k)
  #define VFR(i) (bf16x8){vlo[i][0],vlo[i][1],vlo[i][2],vlo[i][3],vhi[i][0],vhi[i][1],vhi[i][2],vhi[i][3]}
  #define PIN(x) asm volatile("":"+v"(x))
  #define MX3(a,b,c) __builtin_fmaxf(__builtin_fmaxf((a),(b)),(c))
  #define GAPA(MF,A0,A1,A2,A3,W0,W1,PW) do{ MF; sacc+=A0; sacc+=A1; sacc+=A2; sacc+=A3; PIN(sacc); W0; W1; PIN(PW); SBAR(); }while(0)
  #define EX(v) __builtin_amdgcn_exp2f(v)
  #define GAPB(MF,X,B) do{ MF; X[B]=EX(X[B]); X[B+1]=EX(X[B+1]); X[B+2]=EX(X[B+2]); X[B+3]=EX(X[B+3]); PIN(X); SBAR(); }while(0)
  #define VRD(i) do{ vlo[i]=vtr(vp_+(((i)>>2)*4096+((i)&3)*1024)); vhi[i]=vtr(vp_+(((i)>>2)*4096+((i)&3)*1024+512)); }while(0)
  #define KRD(G,j) do{ if(G){ kload2(kf,kp0+sl_next,j); SBAR(); } }while(0)
  #define STEP(C0,C1,P0,P1,t,GK,GV,GL) do{ SBAR(); BIAS(C0,C1,t); \
    const lds_cptr vp_=vp0+sl_prev; \
    VRD(0); SBAR(); float sacc=(P0[0]+P0[1]); \
    GAPA(C0=__builtin_amdgcn_mfma_f32_32x32x16_bf16(kf[0],qr[0],C0,0,0,0), P0[2],P0[3],P0[4],P0[5],     pw0[0]=PKW(P0,0), pw0[1]=PKW(P0,2), pw0); \
    VRD(4); SBAR(); GAPA(C1=__builtin_amdgcn_mfma_f32_32x32x16_bf16(kf[1],qr[0],C1,0,0,0), P0[6],P0[7],P0[8],P0[9],     pw0[2]=PKW(P0,4), pw0[3]=PKW(P0,6), pw0); \
    VRD(1); SBAR(); GAPA(C0=__builtin_amdgcn_mfma_f32_32x32x16_bf16(kf[2],qr[1],C0,0,0,0),   P0[10],P0[11],P0[12],P0[13], pw1[0]=PKW(P0,8), pw1[1]=PKW(P0,10), pw1); \
    VRD(5); SBAR(); GAPA(C1=__builtin_amdgcn_mfma_f32_32x32x16_bf16(kf[3],qr[1],C1,0,0,0),   P0[14],P0[15],P1[0],P1[1],   pw1[2]=PKW(P0,12),pw1[3]=PKW(P0,14), pw1); \
    VRD(2); SBAR(); GAPA(C0=__builtin_amdgcn_mfma_f32_32x32x16_bf16(kf[4],qr[2],C0,0,0,0),   P1[2],P1[3],P1[4],P1[5],     pw2[0]=PKW(P1,0), pw2[1]=PKW(P1,2), pw2); \
    VRD(6); SBAR(); GAPA(C1=__builtin_amdgcn_mfma_f32_32x32x16_bf16(kf[5],qr[2],C1,0,0,0),   P1[6],P1[7],P1[8],P1[9],     pw2[2]=PKW(P1,4), pw2[3]=PKW(P1,6), pw2); \
    VRD(3); SBAR(); GAPA(C0=__builtin_amdgcn_mfma_f32_32x32x16_bf16(kf[6],qr[3],C0,0,0,0),   P1[10],P1[11],P1[12],P1[13], pw3[0]=PKW(P1,8), pw3[1]=PKW(P1,10), pw3); \
    VRD(7); SBAR(); GAPA(C1=__builtin_amdgcn_mfma_f32_32x32x16_bf16(kf[7],qr[3],C1,0,0,0),   P1[14],P1[15],0.f,0.f,       pw3[2]=PKW(P1,12),pw3[3]=PKW(P1,14), pw3); \
    l_reg+=sacc; \
    if(GK){DMA_K((t)+3,sl_cur);} if(GV){DMA_V((t)+1,sl_next);} \
    MMASK(C0,C1,t); CMASK(C0,C1,t); \
    { float a=MX3(C0[0],C0[1],C1[0]),b=MX3(C0[2],C0[3],C1[1]); a=MX3(a,C1[2],C1[3]); \
      _Pragma("unroll") for(int r=4;r<16;r+=4){a=MX3(a,C0[r],C0[r+1]);b=MX3(b,C0[r+2],C0[r+3]);a=MX3(a,C1[r],C1[r+1]);b=MX3(b,C1[r+2],C1[r+3]);} \
      float rm=__builtin_fmaxf(a,b); { auto rr=__builtin_amdgcn_permlane32_swap(__float_as_uint(rm),__float_as_uint(rm),false,false); rm=__builtin_fmaxf(__uint_as_float(rr[0]),__uint_as_float(rr[1])); } \
      resc=false; \
      if(__builtin_expect(__any(rm>(float)THRL),0)){ const float dl=__builtin_fmaxf(rm,0.f); mhat+=dl; \
        _Pragma("unroll") for(int r=0;r<16;++r){C0[r]-=dl;C1[r]-=dl;} \
        const float f=__builtin_amdgcn_exp2f(-dl); l_reg*=f; if(hi==0)wsf[r32]=f; resc=true; } } \
    SBAR(); \
    GAPB(o[0]=__builtin_amdgcn_mfma_f32_32x32x16_bf16(PAF(0),VFR(0),o[0],0,0,0), C0,0); \
    GAPB(o[1]=__builtin_amdgcn_mfma_f32_32x32x16_bf16(PAF(0),VFR(4),o[1],0,0,0), C0,4); \
    KRD(GL,0); GAPB(o[0]=__builtin_amdgcn_mfma_f32_32x32x16_bf16(PAF(1),VFR(1),o[0],0,0,0), C0,8); \
    KRD(GL,1); GAPB(o[1]=__builtin_amdgcn_mfma_f32_32x32x16_bf16(PAF(1),VFR(5),o[1],0,0,0), C0,12); \
    KRD(GL,2); GAPB(o[0]=__builtin_amdgcn_mfma_f32_32x32x16_bf16(PAF(2),VFR(2),o[0],0,0,0), C1,0); \
    KRD(GL,3); GAPB(o[1]=__builtin_amdgcn_mfma_f32_32x32x16_bf16(PAF(2),VFR(6),o[1],0,0,0), C1,4); \
    GAPB(o[0]=__builtin_amdgcn_mfma_f32_32x32x16_bf16(PAF(3),VFR(3),o[0],0,0,0), C1,8); \
    GAPB(o[1]=__builtin_amdgcn_mfma_f32_32x32x16_bf16(PAF(3),VFR(7),o[1],0,0,0), C1,12); \
    }while(0)
  int t=1;
  #undef CMASK
  #define CMASK(P0,P1,t) do{}while(0)
  for(;t+5<NT;t+=2){
    STEP(pB0,pB1,pA0,pA1,t,true,true,true);     WAIT_BAR(2); RESC(); ROT();
    STEP(pA0,pA1,pB0,pB1,t+1,true,true,true);   WAIT_BAR(2); RESC(); ROT();
  }
  #undef CMASK
  #define CMASK(P0,P1,t) do{int jb_=(t)-(NT-4); if(jb_>=0)cmask(P0,P1,jb_,qrel,hi);}while(0)
  #define ENDW(tt) do{ if((tt)+3<NT){WAIT_BAR(2);} else if((tt)+2<NT){WAIT_BAR(1);} else {WAIT_BAR(0);} }while(0)
  for(;t+1<NT;t+=2){
    STEP(pB0,pB1,pA0,pA1,t,(t+3<NT),(t+1<NT),(t+1<NT));       ENDW(t);   RESC(); ROT();
    STEP(pA0,pA1,pB0,pB1,t+1,(t+4<NT),(t+2<NT),(t+2<NT));     ENDW(t+1); RESC(); ROT();
  }
  STEP(pB0,pB1,pA0,pA1,NT-1,false,false,false); RESC();
  { float sacc=pB0[0]+pB0[1]; _Pragma("unroll") for(int r=2;r<16;++r)sacc+=pB0[r]; _Pragma("unroll") for(int r=0;r<16;++r)sacc+=pB1[r]; l_reg+=sacc;
    pw0=(u32x4){PKW(pB0,0),PKW(pB0,2),PKW(pB0,4),PKW(pB0,6)};pw1=(u32x4){PKW(pB0,8),PKW(pB0,10),PKW(pB0,12),PKW(pB0,14)};pw2=(u32x4){PKW(pB1,0),PKW(pB1,2),PKW(pB1,4),PKW(pB1,6)};pw3=(u32x4){PKW(pB1,8),PKW(pB1,10),PKW(pB1,12),PKW(pB1,14)};
    SBAR(); pv(o,vb0+sl_cur,PAF(0),PAF(1),PAF(2),PAF(3)); }
  #undef PKW
  #undef PAF
  #undef VFR
  #undef PIN
  #undef MX3
  #undef GAPA
  #undef GAPB
  #undef EX
  #undef VRD
  #undef KRD
  #undef STEP
  #undef ENDW
  {auto rr=__builtin_amdgcn_permlane32_swap(__float_as_uint(l_reg),__float_as_uint(l_reg),false,false);l_reg=__uint_as_float(rr[0])+__uint_as_float(rr[1]);}
  if(hi==0)wsf[32+r32]=l_reg;asm volatile("s_waitcnt lgkmcnt(0)":::"memory");
  float rli[16];
  #pragma unroll
  for(int r=0;r<16;++r)rli[r]=__builtin_amdgcn_rcpf(wsf[32+crow(r,hi)]);
  bf16*Ow=O+(rowbase+q0+wid*QBLK)*DM+h*D;
  { bf16*stg=(bf16*)(shm+LDS_OST)+wid*2048;
    #pragma unroll
    for(int r=0;r<16;++r){const int orow=crow(r,hi);
      #pragma unroll
      for(int d0=0;d0<2;++d0)stg[orow*64+d0*32+r32]=__float2bfloat16(o[d0][r]*rli[r]);}
    asm volatile("s_waitcnt lgkmcnt(0)":::"memory");
    #pragma unroll
    for(int i=0;i<4;++i){const int row=i*8+(lane>>3),ch=lane&7; const u32x4 v=*(const u32x4*)(stg+row*64+ch*8); ATTN_STORE16(Ow+(long)row*DM+ch*8,v);} }
  asm volatile("s_waitcnt lgkmcnt(0)\n\ts_barrier":::"memory");
  #undef DMA_K
  #undef DMA_V
  #undef CMASK
  #undef BIAS
  #undef MMASK
  #undef START
  #undef RESC
  #undef ROT
}
constexpr int ATTN_LDS_BYTES=LDS_BYTES;
struct AttnTensors { const bf16* Q; const bf16* K; const bf16* V; bf16* O; const float* KM; const float* GLUT; };
struct AttnUnit { int bh; int qb; };
struct StaticOrder {
  int vcu,G;
  __device__ __forceinline__ explicit StaticOrder(int grid,int block):vcu((grid%8==0)?(block%8)*(grid/8)+block/8:block),G(grid){}
  __device__ __forceinline__ bool next(int i,AttnUnit&u)const{
    if(G==256){ if(i>=8)return false; const int s=vcu&1; u.bh=vcu>>1; const int k=i>>1; u.qb=(i&1)?(4*k+3-s):(4*k+s); return true; }
    const int L=i*G+vcu; if(L>=BATCH*NHEAD*NQB)return false; u.bh=L/NQB; u.qb=L%NQB; return true; }
  __device__ __forceinline__ void a_ready(const AttnUnit&)const{}
  __device__ __forceinline__ void done(const AttnUnit&)const{}
};
template<class Sched,int THRL=8,int PLAIN=0> __device__ __forceinline__ void attn_phase(char*lds,const AttnTensors&T,const Sched&S){
  AttnUnit u;
  int lasth=-1;
  for(int i=0;S.next(i,u);++i){ S.a_ready(u); const int hh=u.bh%NHEAD; attn_unit<THRL,PLAIN>(u.bh/NHEAD,hh,u.qb,T.Q,T.K,T.V,T.O,T.KM,T.GLUT,lds,hh!=lasth); lasth=hh; S.done(u); }
}
#undef SBAR
#undef WAIT_BAR
}
constexpr int NWAVES = 8, NTHREADS = 512;
constexpr int BATCH = 8, SEQ = 4096, D = 1024, T = BATCH * SEQ;
constexpr int A_CH = 512, CONV_W = 31, B_HEADS = 8, B_CH = 512, SGU_CHUNK = 128, MIX_IN = 2048;
constexpr int MH = 16, MHD = 64, MBLK = 256, NBLK = SEQ / MBLK, MTOPK = 3;
constexpr int PH = 8, PNK = 128, PNE = PNK * PNK, PDK = 256, PTOPK = 16, PSEL = PH * PTOPK;
constexpr float EPS = 1e-6f;
constexpr int LUT_OFF = 256, LUT_N = SEQ + LUT_OFF;

constexpr size_t MiB = 1u << 20;
constexpr size_t WS_CTL = 0, CTL_ZERO_BYTES = 1 * MiB;
constexpr size_t WS_WIN = 1 * MiB, WS_WOUT = 5 * MiB, WS_WQKV = 7 * MiB, WS_WO = 13 * MiB, WS_WQ = 15 * MiB  , WS_SK = 23 * MiB  ;
constexpr size_t WS_WSC = 24 * MiB + 896 * 1024  ;
constexpr size_t WS_SGW = 24 * MiB  , WS_LUT = 24 * MiB + 512 * 1024  , WS_KMEAN = 25 * MiB  , WS_SSQ = 25 * MiB + 512 * 1024  ;
constexpr size_t WS_PU = 32 * MiB  , WS_PV = 64 * MiB  , WS_PSU = 96 * MiB  , WS_PSV = 96 * MiB + 256 * 1024;
constexpr size_t WS_HN = 128 * MiB;
constexpr size_t WS_HA = 160 * MiB;
constexpr size_t WS_R4 = 224 * MiB;
constexpr size_t WS_AGLU = WS_R4, WS_UG = WS_R4 + 32 * MiB, WS_VG = WS_R4 + 64 * MiB, WS_CAT = WS_R4 + 96 * MiB;
constexpr size_t WS_Q = WS_R4, WS_K = WS_R4 + 64 * MiB, WS_V = WS_R4 + 128 * MiB;
constexpr size_t WS_QP = WS_R4;
constexpr size_t WS_PART = WS_R4;
constexpr size_t WS_CB = WS_R4 + 160 * MiB;
constexpr size_t WS_IDX = 416 * MiB, WS_GATE = 432 * MiB, WS_HQ = 448 * MiB  , WS_HQS = 480 * MiB  , WS_SUK = 481 * MiB  , WS_END = 497 * MiB;
constexpr int CW_TMO = 0, CW_BAR = 4096, CW_CMAX = 65536  ;

constexpr int RING_BYTES = 131072, LDSCTL_OFF = RING_BYTES, MISC_OFF = LDSCTL_OFF + 320, LDS_BYTES = 147456;

#define GAS __attribute__((address_space(1)))
#define LAS __attribute__((address_space(3)))
typedef unsigned short bf16;
typedef unsigned v4u __attribute__((ext_vector_type(4)));
typedef unsigned v2u __attribute__((ext_vector_type(2)));
typedef float f32x4 __attribute__((ext_vector_type(4)));
typedef float f32x2 __attribute__((ext_vector_type(2)));
typedef short bf16x8 __attribute__((ext_vector_type(8)));
typedef GAS unsigned gu32;
typedef GAS unsigned long long gu64;
#define RLX_AGENT __ATOMIC_RELAXED, __HIP_MEMORY_SCOPE_AGENT
#define LDS_WAIT() asm volatile("s_waitcnt lgkmcnt(0)" ::: "memory")
#define VM_WAIT() asm volatile("s_waitcnt vmcnt(0)" ::: "memory")
__device__ __forceinline__ unsigned f2bf(float f) { unsigned u = __builtin_bit_cast(unsigned, f); return (u + 0x7fffu + ((u >> 16) & 1u)) >> 16; }
__device__ __forceinline__ unsigned pk2(float lo, float hi) { return f2bf(lo) | (f2bf(hi) << 16); }
__device__ __forceinline__ float bf_lo(unsigned w) { return __builtin_bit_cast(float, w << 16); }
__device__ __forceinline__ float bf_hi(unsigned w) { return __builtin_bit_cast(float, w & 0xffff0000u); }
__device__ __forceinline__ float bf2f(bf16 h) { return __builtin_bit_cast(float, (unsigned)h << 16); }

__device__ __forceinline__ float gelu_tanh(float x) { const float t = 1.5957691216057308f * (x + 0.044715f * x * x * x); return x / (1.0f + __expf(-t)); }
template <int CTRL> __device__ __forceinline__ int dpp_i(int x) { return __builtin_amdgcn_update_dpp(0, x, CTRL, 0xf, 0xf, true); }
template <int CTRL> __device__ __forceinline__ float dpp_f(float x) { return __builtin_bit_cast(float, __builtin_amdgcn_update_dpp(0, __builtin_bit_cast(int, x), CTRL, 0xf, 0xf, true)); }
constexpr int DPP_XOR1 = 0xB1, DPP_XOR2 = 0x4E, DPP_HMIRROR = 0x141, DPP_ROR8 = 0x128;
__device__ __forceinline__ float wave_sum(float v) {
    v += dpp_f<DPP_XOR1>(v); v += dpp_f<DPP_XOR2>(v); v += dpp_f<DPP_HMIRROR>(v); v += dpp_f<DPP_ROR8>(v);
    { const unsigned u = __builtin_bit_cast(unsigned, v); const auto r = __builtin_amdgcn_permlane16_swap(u, u, false, false); v = __builtin_bit_cast(float, (unsigned)r[0]) + __builtin_bit_cast(float, (unsigned)r[1]); }
    { const unsigned u = __builtin_bit_cast(unsigned, v); const auto r = __builtin_amdgcn_permlane32_swap(u, u, false, false); v = __builtin_bit_cast(float, (unsigned)r[0]) + __builtin_bit_cast(float, (unsigned)r[1]); }
    return v;
}
__device__ __forceinline__ float wave_max(float m) {
    m = fmaxf(m, dpp_f<DPP_XOR1>(m)); m = fmaxf(m, dpp_f<DPP_XOR2>(m)); m = fmaxf(m, dpp_f<DPP_HMIRROR>(m)); m = fmaxf(m, dpp_f<DPP_ROR8>(m));
    { const unsigned u = __builtin_bit_cast(unsigned, m); const auto r = __builtin_amdgcn_permlane16_swap(u, u, false, false); m = fmaxf(__builtin_bit_cast(float, (unsigned)r[0]), __builtin_bit_cast(float, (unsigned)r[1])); }
    { const unsigned u = __builtin_bit_cast(unsigned, m); const auto r = __builtin_amdgcn_permlane32_swap(u, u, false, false); m = fmaxf(__builtin_bit_cast(float, (unsigned)r[0]), __builtin_bit_cast(float, (unsigned)r[1])); }
    return m;
}
#define XB_TMO      128
#define XB_XCNT(j)  (256  + 64 * (j))
#define XB_XSUB(j)  (1280 + 64 * (j))
#define XB_XGEN(j)  (2304 + 64 * (j))
#define XB_TOP      3328
#define XB_TOPGEN   3392
#define XCD_BAR_WORDS 3456
#define XB_SPIN_CAP (1u << 18)

__device__ __forceinline__ unsigned xb_ld(unsigned* p)              { return __hip_atomic_load(p, __ATOMIC_RELAXED, __HIP_MEMORY_SCOPE_AGENT); }
__device__ __forceinline__ unsigned xb_add(unsigned* p, unsigned v) { return __hip_atomic_fetch_add(p, v, __ATOMIC_RELAXED, __HIP_MEMORY_SCOPE_AGENT); }
__device__ __forceinline__ unsigned xb_xcc_id() { return (unsigned)__builtin_amdgcn_s_getreg((3 << 11) | 20) & 0xFu; }
#define XB_SPIN(cond, bar) do { unsigned _sp = 0; while (cond) { __builtin_amdgcn_s_sleep(1); \
    if ((++_sp & 255u) == 0u) { if (xb_ld(&(bar)[XB_TMO])) break; if (_sp > XB_SPIN_CAP) { atomicAdd(&(bar)[XB_TMO], 1u); break; } } } } while (0)

struct XcdBarrier {
    unsigned* bar; unsigned x;
    volatile LAS unsigned* st;
};

__device__ __forceinline__ XcdBarrier xcd_barrier_post(unsigned* bar, volatile LAS unsigned* st) {
    XcdBarrier b; b.bar = bar; b.x = xb_xcc_id(); b.st = st;
    if (threadIdx.x == 0) (void)xb_add(&bar[XB_XCNT(b.x)], 1u);
    return b;
}
__device__ __forceinline__ void xcd_barrier_complete(unsigned* bar, unsigned x, unsigned& nloc, unsigned& nx) {
    const unsigned G = gridDim.x * gridDim.y * gridDim.z;
    unsigned sum, cnt, mine, sp = 0u;
    for (;;) {
        sum = 0u; cnt = 0u; mine = 0u;
#pragma unroll
        for (unsigned j = 0; j < 16; ++j) { const unsigned c = xb_ld(&bar[XB_XCNT(j)]); sum += c; cnt += (c > 0u) ? 1u : 0u; mine = (j == x) ? c : mine; }
        if (sum == G) break;
        __builtin_amdgcn_s_sleep(1);
        if ((++sp & 255u) == 0u) { if (xb_ld(&bar[XB_TMO])) break; if (sp > XB_SPIN_CAP) { atomicAdd(&bar[XB_TMO], 1u); break; } }
    }
    nloc = mine > 0u ? mine : 1u; nx = cnt > 0u ? cnt : 1u;
}

__device__ __forceinline__ void xcd_barrier(const XcdBarrier& b) {
    asm volatile("s_waitcnt vmcnt(0)" ::: "memory");
    __syncthreads();
    if (threadIdx.x == 0) {
        unsigned* bar = b.bar;
        __builtin_amdgcn_s_waitcnt(0);
        unsigned nloc = b.st[0], nx = b.st[1];
        if (nloc == 0u) { xcd_barrier_complete(bar, b.x, nloc, nx); b.st[0] = nloc; b.st[1] = nx; }
        const unsigned old = xb_add(&bar[XB_XSUB(b.x)], 1u);
        const unsigned gen = old / nloc;
        if (old + 1u == (gen + 1u) * nloc) {
            __builtin_amdgcn_fence(__ATOMIC_RELEASE, "agent");
            asm volatile("s_waitcnt vmcnt(0)" ::: "memory");
            const unsigned og = xb_add(&bar[XB_TOP], 1u);
            const unsigned tg = og / nx;
            if (og + 1u == (tg + 1u) * nx) xb_add(&bar[XB_TOPGEN], 1u);
            else XB_SPIN(xb_ld(&bar[XB_TOPGEN]) == tg, bar);
            __builtin_amdgcn_fence(__ATOMIC_ACQUIRE, "agent");
            xb_add(&bar[XB_XGEN(b.x)], 1u);
            asm volatile("s_waitcnt vmcnt(0)" ::: "memory");
        } else {
            XB_SPIN(xb_ld(&bar[XB_XGEN(b.x)]) == gen, bar);
            __builtin_amdgcn_fence(__ATOMIC_ACQUIRE, "agent");
            asm volatile("s_waitcnt vmcnt(0)" ::: "memory");
        }
    }
    __syncthreads();
}
struct Args { const float* in[21]; float* out; unsigned char* ws; int ph_lo, ph_hi, li, pad; };
struct Frame {
    LAS unsigned char* lds;
    volatile LAS unsigned* MISC;
    gu32* ctl;
    int tid, lane, wave, vcu, G;
    int xi, xr, xn, nx;
};
enum { I_X = 0, I_WIN, I_CONVW, I_CONVB, I_CLNG, I_CLNB, I_SLNG, I_SLNB, I_SGUW, I_SGUB, I_WOUT, I_WQKV, I_WO, I_RELB, I_PWQ, I_PSK, I_PU, I_PV, I_GMIX, I_GFFN, I_GFIN };

template <int MODE>
__device__ __forceinline__ void p0_transpose_item(const float* W, int K, int N, bf16* WT, LAS float* scr, int item, int lane) {
    const int nblk = N / 32, kb = item / nblk, nb = item % nblk, k0 = 64 * kb, n0 = 32 * nb;
    int d0 = n0;
    if (MODE == 1) { const int seg = n0 >> 9, c = n0 & 511; d0 = (seg == 0) ? ((c >> 7) * 256 + (c & 127)) : (seg == 1) ? ((c >> 7) * 256 + 128 + (c & 127)) : n0; }
#pragma unroll 8
    for (int i = 0; i < 32; ++i) { const int kk = 2 * i + (lane >> 5); scr[kk * 33 + (lane & 31)] = W[(size_t)(k0 + kk) * N + n0 + (lane & 31)]; }
    LDS_WAIT(); asm volatile("" ::: "memory");
    const int c = lane & 7;
#pragma unroll
    for (int j = 0; j < 4; ++j) { const int n = (lane >> 3) + 8 * j; const LAS float* s = scr + (8 * c) * 33 + n;
        v4u o; o.x = pk2(s[0 * 33], s[1 * 33]); o.y = pk2(s[2 * 33], s[3 * 33]); o.z = pk2(s[4 * 33], s[5 * 33]); o.w = pk2(s[6 * 33], s[7 * 33]);
        *(GAS v4u*)(WT + (size_t)(d0 + n) * K + k0 + 8 * c) = o; }
    LDS_WAIT(); asm volatile("" ::: "memory");
}
template <int MODE> __device__ __forceinline__ int wq8_dst(int n0) { if (MODE == 1) { const int seg = n0 >> 9, c = n0 & 511; return (seg == 0) ? ((c >> 7) * 256 + (c & 127)) : (seg == 1) ? ((c >> 7) * 256 + 128 + (c & 127)) : n0; } return n0; }
template <int MODE>
__device__ __forceinline__ void p0_colmax_item(const float* W, int N, unsigned* cmax, int item, int lane) {
    const int nblk = N / 32, kb = item / nblk, nb = item % nblk, k0 = 64 * kb, n0 = 32 * nb, d0 = wq8_dst<MODE>(n0);
    float m = 0.f;
#pragma unroll 8
    for (int i = 0; i < 32; ++i) m = fmaxf(m, fabsf(W[(size_t)(k0 + 2 * i + (lane >> 5)) * N + n0 + (lane & 31)]));
    m = fmaxf(m, __shfl_xor(m, 32));
    if (lane < 32) atomicMax(cmax + d0 + lane, __builtin_bit_cast(unsigned, m));
}
template <int MODE>
__device__ __forceinline__ void p0_wq8_item(const float* W, int N, unsigned char* WT, const unsigned* cmax, float* sc, LAS float* scr, int item, int lane) {
    const int nblk = N / 32, kb = item / nblk, nb = item % nblk, k0 = 64 * kb, n0 = 32 * nb, d0 = wq8_dst<MODE>(n0);
    const float m = __builtin_bit_cast(float, cmax[d0 + (lane & 31)]), inv = m > 0.f ? 127.f / m : 0.f;
    if (kb == 0 && lane < 32) sc[d0 + lane] = m * (1.f / 127.f);
#pragma unroll 8
    for (int i = 0; i < 32; ++i) { const int kk = 2 * i + (lane >> 5); scr[kk * 33 + (lane & 31)] = W[(size_t)(k0 + kk) * N + n0 + (lane & 31)] * inv; }
    LDS_WAIT(); asm volatile("" ::: "memory");
    const int c = lane & 7;
#pragma unroll
    for (int j = 0; j < 4; ++j) { const int n = (lane >> 3) + 8 * j; const LAS float* sp = scr + (8 * c) * 33 + n;
        int q[8];
#pragma unroll
        for (int i = 0; i < 8; ++i) q[i] = (int)rintf(sp[i * 33]);
        v2u o; o.x = (unsigned)(q[0] & 255) | ((unsigned)(q[1] & 255) << 8) | ((unsigned)(q[2] & 255) << 16) | ((unsigned)(q[3] & 255) << 24); o.y = (unsigned)(q[4] & 255) | ((unsigned)(q[5] & 255) << 8) | ((unsigned)(q[6] & 255) << 16) | ((unsigned)(q[7] & 255) << 24);
        *(GAS v2u*)(WT + (size_t)(d0 + n) * D + k0 + 8 * c) = o; }
    LDS_WAIT(); asm volatile("" ::: "memory");
}
__device__ __forceinline__ void rms_row_to_bf16(const float* xrow, const float* g, bf16* orow, int lane) {
    const GAS f32x4* xr = (const GAS f32x4*)xrow + lane;
    f32x4 v[4]; float s = 0.f;
#pragma unroll
    for (int j = 0; j < 4; ++j) { v[j] = xr[64 * j]; s += (v[j].x * v[j].x + v[j].y * v[j].y) + (v[j].z * v[j].z + v[j].w * v[j].w); }
    const float r = rsqrtf(wave_sum(s) * (1.f / D) + EPS);
    GAS v2u* o8 = (GAS v2u*)orow + lane;
#pragma unroll
    for (int j = 0; j < 4; ++j) { const f32x4 gg = ((const GAS f32x4*)g)[lane + 64 * j]; v2u o; o.x = pk2(v[j].x * r * gg.x, v[j].y * r * gg.y); o.y = pk2(v[j].z * r * gg.z, v[j].w * r * gg.w); o8[64 * j] = o; }
}
__device__ __forceinline__ int t5_bucket(int d) {
    const int n = d > 0 ? d : 0;
    if (n < 16) return n;
    int b = 16;
    b += (n >= 22); b += (n >= 30); b += (n >= 40); b += (n >= 54); b += (n >= 73); b += (n >= 99); b += (n >= 134); b += (n >= 182);
    b += (n >= 246); b += (n >= 332); b += (n >= 450); b += (n >= 609); b += (n >= 825); b += (n >= 1117); b += (n >= 1513);
    return b;
}
__device__ __forceinline__ void cvt8(const float* src, bf16* dst, size_t i8) {
    const f32x4 a = ((const GAS f32x4*)src)[2 * i8], b = ((const GAS f32x4*)src)[2 * i8 + 1];
    v4u o; o.x = pk2(a.x, a.y); o.y = pk2(a.z, a.w); o.z = pk2(b.x, b.y); o.w = pk2(b.z, b.w);
    ((GAS v4u*)dst)[i8] = o;
}
template <bool SRCB, bool NIB = true> __device__ __forceinline__ void p_rms(const Args& A, Frame& F, const void* srcv, const float* g) {
    const float* src = (const float*)srcv; const bf16* srcb = (const bf16*)srcv;
    const int gw = F.vcu * NWAVES + F.wave, NGW = F.G * NWAVES, lane = F.lane;
    f32x4 nv[4];
    auto ldrow = [&](int row, f32x4 (&o)[4]) {
        if (SRCB) { const v4u a = *(const GAS v4u*)(srcb + (size_t)row * D + lane * 16), b = *(const GAS v4u*)(srcb + (size_t)row * D + lane * 16 + 8);
            o[0] = (f32x4){bf_lo(a.x), bf_hi(a.x), bf_lo(a.y), bf_hi(a.y)}; o[1] = (f32x4){bf_lo(a.z), bf_hi(a.z), bf_lo(a.w), bf_hi(a.w)}; o[2] = (f32x4){bf_lo(b.x), bf_hi(b.x), bf_lo(b.y), bf_hi(b.y)}; o[3] = (f32x4){bf_lo(b.z), bf_hi(b.z), bf_lo(b.w), bf_hi(b.w)}; }
        else {
#pragma unroll
            for (int j = 0; j < 4; ++j) o[j] = *(const GAS f32x4*)(src + (size_t)row * D + lane * 16 + 4 * j); } };
    if (gw < T) ldrow(gw, nv);
    f32x4 gg[4];
#pragma unroll
    for (int j = 0; j < 4; ++j) gg[j] = *(const GAS f32x4*)(g + lane * 16 + 4 * j);
    for (int m = gw; m < T; m += NGW) {
        f32x4 v[4]; float s = 0.f;
#pragma unroll
        for (int j = 0; j < 4; ++j) v[j] = nv[j];
        { const int mn = (m + NGW < T) ? m + NGW : m; ldrow(mn, nv); }
#pragma unroll
        for (int j = 0; j < 4; ++j) s += (v[j].x * v[j].x + v[j].y * v[j].y) + (v[j].z * v[j].z + v[j].w * v[j].w);
        const float r = rsqrtf(wave_sum(s) * (1.f / D) + EPS); float mx = 0.f;
#pragma unroll
        for (int j = 0; j < 4; ++j) { v[j] = v[j] * r * gg[j]; mx = fmaxf(mx, fmaxf(fmaxf(fabsf(v[j].x), fabsf(v[j].y)), fmaxf(fabsf(v[j].z), fabsf(v[j].w)))); }
        mx = wave_max(mx);
        constexpr float QL = NIB ? 119.f : 127.f;
        const float inv = mx > 0.f ? QL / mx : 0.f;
        v4u oq; unsigned* qp = (unsigned*)&oq;
#pragma unroll
        for (int j = 0; j < 4; ++j) { const int a = (int)rintf(v[j].x * inv), b = (int)rintf(v[j].y * inv), c = (int)rintf(v[j].z * inv), d = (int)rintf(v[j].w * inv);
            qp[j] = (unsigned)(a & 255) | ((unsigned)(b & 255) << 8) | ((unsigned)(c & 255) << 16) | ((unsigned)(d & 255) << 24); }
        *(GAS v4u*)(A.ws + WS_HQ + (size_t)m * D + lane * 16) = oq;
        if (lane == 0) ((float*)(A.ws + WS_HQS))[m] = mx * (1.f / QL);
    }
}

__device__ __forceinline__ void p0_prologue(const Args& A, Frame& F) {
    unsigned char* ws = A.ws;
    LAS float* scr = (LAS float*)(F.lds + F.wave * 16384);
    const int gw = F.vcu * NWAVES + F.wave, NGW = F.G * NWAVES;
    constexpr int I_OUT = 16 * 32, I_O = 16 * 32, J_IN = 16 * (MIX_IN / 32), J_WQ = 16 * (2048 / 32), J_QKV = 16 * (3 * D / 32);
    constexpr int NITEMS = I_OUT + I_O + J_IN + 2 * J_WQ + J_QKV;
    unsigned* cmax = (unsigned*)(ws + WS_CTL) + CW_CMAX;
    for (int it = gw; it < NITEMS; it += NGW) {
        int r = it;
        if (r < I_OUT) { p0_transpose_item<0>(A.in[I_WOUT], D, D, (bf16*)(ws + WS_WOUT), scr, r, F.lane); continue; } r -= I_OUT;
        if (r < I_O) { p0_transpose_item<0>(A.in[I_WO], D, D, (bf16*)(ws + WS_WO), scr, r, F.lane); continue; } r -= I_O;
        if (r < J_IN) { p0_colmax_item<1>(A.in[I_WIN], MIX_IN, cmax, r, F.lane); continue; } r -= J_IN;
        if (r < J_WQ) { p0_colmax_item<0>(A.in[I_PWQ], 2048, cmax + 2048, r, F.lane); continue; } r -= J_WQ;
        if (r < J_WQ) { p0_colmax_item<0>(A.in[I_PWQ] + (size_t)D * 2048, 2048, cmax + 4096, r, F.lane); continue; } r -= J_WQ;
        p0_colmax_item<0>(A.in[I_WQKV], 3 * D, cmax + 6144, r, F.lane);
    }
    const size_t gt = (size_t)blockIdx.x * NTHREADS + F.tid, NT = (size_t)F.G * NTHREADS;
    constexpr size_t N8_SK = (size_t)2 * PH * 2 * PNK * 128 / 8;
    f32x4 nv[4];
    if (gw < 4 * PNE) { const float* src0 = (gw >= 2 * PNE ? A.in[I_PV] + (size_t)(gw - 2 * PNE) * D : A.in[I_PU] + (size_t)gw * D) + F.lane * 16;
#pragma unroll
        for (int j = 0; j < 4; ++j) nv[j] = *(const GAS f32x4*)(src0 + 4 * j); }
    for (int row = gw; row < 4 * PNE; row += NGW) {
        const bool isv = row >= 2 * PNE; const int r = isv ? row - 2 * PNE : row;
        f32x4 v[4]; float m = 0.f;
#pragma unroll
        for (int j = 0; j < 4; ++j) v[j] = nv[j];
        { const int rn = (row + NGW < 4 * PNE) ? row + NGW : row;
          const float* srcn = (rn >= 2 * PNE ? A.in[I_PV] + (size_t)(rn - 2 * PNE) * D : A.in[I_PU] + (size_t)rn * D) + F.lane * 16;
#pragma unroll
          for (int j = 0; j < 4; ++j) nv[j] = *(const GAS f32x4*)(srcn + 4 * j); }
#pragma unroll
        for (int j = 0; j < 4; ++j) m = fmaxf(m, fmaxf(fmaxf(fabsf(v[j].x), fabsf(v[j].y)), fmaxf(fabsf(v[j].z), fabsf(v[j].w))));
        m = wave_max(m);
        float ss = 0.f;
#pragma unroll
        for (int j = 0; j < 4; ++j) ss += (v[j].x * v[j].x + v[j].y * v[j].y) + (v[j].z * v[j].z + v[j].w * v[j].w);
        ss = wave_sum(ss);
        {
            const float clip = fminf(m, 2.5f * sqrtf(ss * (1.f / D)));
            const float inv = clip > 0.f ? 7.f / clip : 0.f;
            v2u o2; unsigned* op = (unsigned*)&o2;
#pragma unroll
            for (int w = 0; w < 2; ++w) { unsigned ow = 0;
#pragma unroll
                for (int bb = 0; bb < 4; ++bb) { const int l = (int)fminf(fmaxf(rintf(v[2 * w][bb] * inv), -7.f), 7.f), h = (int)fminf(fmaxf(rintf(v[2 * w + 1][bb] * inv), -7.f), 7.f);
                    ow |= (unsigned)(((isv ? l + 8 : l) & 15) | ((h & 15) << 4)) << (8 * bb); }
                op[w] = ow; }
            *(GAS v2u*)(ws + (isv ? WS_PV : WS_PU) + (size_t)(r / PNE) * PNE * 512 + (size_t)(F.lane >> 4) * PNE * 128 + (size_t)(r % PNE) * 128 + (F.lane & 15) * 8) = o2;
            if (F.lane == 0) ((float*)(ws + (isv ? WS_PSV : WS_PSU)))[r] = clip * (1.f / 7.f);
        }
    }
    for (size_t i = gt; i < N8_SK; i += NT) cvt8(A.in[I_PSK], (bf16*)(ws + WS_SK), i);
    for (size_t i = gt; i < (size_t)B_HEADS * 128 * 128; i += NT) { const int s = (int)(i & 127), t = (int)((i >> 7) & 127); ((bf16*)(ws + WS_SGW))[i] = (bf16)f2bf(s <= t ? A.in[I_SGUW][i] : 0.f); }
    for (size_t i = gt; i < (size_t)MH * LUT_N; i += NT) { const int h = (int)(i / LUT_N), d = (int)(i % LUT_N) - LUT_OFF; ((float*)(ws + WS_LUT))[i] = A.in[I_RELB][t5_bucket(d) * MH + h]; }
    for (size_t i = gt; i < (size_t)(BATCH * NBLK * D + T); i += NT) ((float*)(ws + WS_KMEAN))[i] = 0.f;
    p_rms<false, false>(A, F, A.in[I_X], A.in[I_GMIX]);
}
__device__ __forceinline__ void p0_weights8(const Args& A, Frame& F) {
    unsigned char* ws = A.ws;
    LAS float* scr = (LAS float*)(F.lds + F.wave * 16384);
    const int gw = F.vcu * NWAVES + F.wave, NGW = F.G * NWAVES;
    constexpr int J_IN = 16 * (MIX_IN / 32), J_WQ = 16 * (2048 / 32), J_QKV = 16 * (3 * D / 32);
    const unsigned* cmax = (const unsigned*)(ws + WS_CTL) + CW_CMAX; float* wsc = (float*)(ws + WS_WSC);
    for (int it = gw; it < J_IN + 2 * J_WQ + J_QKV; it += NGW) {
        int r = it;
        if (r < J_IN) { p0_wq8_item<1>(A.in[I_WIN], MIX_IN, ws + WS_WIN, cmax, wsc, scr, r, F.lane); continue; } r -= J_IN;
        if (r < J_WQ) { p0_wq8_item<0>(A.in[I_PWQ], 2048, ws + WS_WQ, cmax + 2048, wsc + 2048, scr, r, F.lane); continue; } r -= J_WQ;
        if (r < J_WQ) { p0_wq8_item<0>(A.in[I_PWQ] + (size_t)D * 2048, 2048, ws + WS_WQ + (size_t)2048 * D, cmax + 4096, wsc + 4096, scr, r, F.lane); continue; } r -= J_WQ;
        p0_wq8_item<0>(A.in[I_WQKV], 3 * D, ws + WS_WQKV, cmax + 6144, wsc + 6144, scr, r, F.lane);
    }
}

__device__ __forceinline__ void p9_kmean(const Args& A, Frame& F) {
    const bf16* K = (const bf16*)(A.ws + WS_K); float* km = (float*)(A.ws + WS_KMEAN);
    const size_t gt = (size_t)blockIdx.x * NTHREADS + F.tid, NT = (size_t)F.G * NTHREADS;
    for (size_t i = gt; i < (size_t)BATCH * NBLK * D; i += NT) {
        const int col = (int)(i & 1023); const size_t bb = i >> 10; float s = 0.f;
        for (int r = 0; r < MBLK; ++r) s += bf2f(K[(bb * MBLK + r) * D + col]);
        km[i] = s * (1.f / MBLK);
    }
}

typedef float f32x16_t __attribute__((ext_vector_type(16)));
#define PK_CE(a, i, j) { const float hi_ = __builtin_fmaxf(a[i], a[j]), lo_ = __builtin_fminf(a[i], a[j]); a[i] = hi_; a[j] = lo_; }
__device__ __forceinline__ void pk_sort16(float (&a)[16]) {
#pragma unroll
    for (int p = 1; p < 16; p <<= 1)
#pragma unroll
        for (int k = p; k >= 1; k >>= 1)
#pragma unroll
            for (int j = k % p; j + k < 16; j += 2 * k)
#pragma unroll
                for (int i = 0; i < k; ++i)
                    if (i + j + k < 16 && (i + j) / (2 * p) == (i + j + k) / (2 * p)) PK_CE(a, i + j, i + j + k);
}
__device__ __forceinline__ void pk_bitonic16(float (&a)[16]) {
#pragma unroll
    for (int s = 8; s >= 1; s >>= 1)
#pragma unroll
        for (int i = 0; i < 16; ++i) if ((i & s) == 0) PK_CE(a, i, i + s);
}
__device__ __forceinline__ void pk_merge_top16(float (&a)[16], const float (&b)[16]) {
#pragma unroll
    for (int i = 0; i < 16; ++i) a[i] = __builtin_fmaxf(a[i], b[15 - i]);
    pk_bitonic16(a);
}
__device__ __forceinline__ float pk_key(float v, unsigned clr, unsigned id) { return __builtin_bit_cast(float, (__builtin_bit_cast(unsigned, v) & clr) | id); }
template <int MODE = 0> __device__ __forceinline__ void p6_route(const Args& A, Frame& F, int layer) {
    unsigned char* ws = A.ws;
    const bf16* qp = (const bf16*)(ws + WS_QP); const bf16* skb = (const bf16*)(ws + WS_SK) + (size_t)layer * PH * 2 * PNK * 128;
    int* idx = (int*)(ws + WS_IDX); float* gate = (float*)(ws + WS_GATE); float* suk = (float*)(ws + WS_SUK);
    LAS unsigned char* skl = F.lds;
    LAS unsigned char* tab = F.lds + 65536 + F.tid * 32;
    const int lane = F.lane, r32 = lane & 31, hi = lane >> 5;
    int cur_h = -1;
    bf16x8 qn[16];
    if (F.vcu < (T / 256) * PH) { const bf16* q0p = qp + (size_t)((F.vcu >> 3) * 256 + F.wave * 32 + r32) * 2048 + (F.vcu & 7) * 256 + hi * 8;
#pragma unroll
        for (int i = 0; i < 16; ++i) qn[i] = *(const bf16x8*)(q0p + 16 * i); }
    for (int u = F.vcu; u < (T / 256) * PH; u += F.G) {
        const int h = u & 7, tile = u >> 3;
        bf16x8 qc[16];
#pragma unroll
        for (int i = 0; i < 16; ++i) qc[i] = qn[i];
        { const int un = (u + F.G < (T / 256) * PH) ? u + F.G : u;
          const bf16* qnp = qp + (size_t)((un >> 3) * 256 + F.wave * 32 + r32) * 2048 + (un & 7) * 256 + hi * 8;
#pragma unroll
          for (int i = 0; i < 16; ++i) qn[i] = *(const bf16x8*)(qnp + 16 * i); }
        if (h != cur_h) {
            __syncthreads();
#pragma unroll
            for (int c = 0; c < 8; ++c) { const int id = F.tid + 512 * c, row = id >> 4, ch = id & 15;
                *(LAS v4u*)(skl + row * 256 + ((ch ^ (row & 15)) << 4)) = *(const v4u*)(skb + ((size_t)h * 256 + row) * 128 + ch * 8); }
            __syncthreads(); cur_h = h;
        }
        const int tok = tile * 256 + F.wave * 32 + r32;
        float top0[16], top1[16];
#pragma unroll
        for (int p = 0; p < 2; ++p) {
            bf16x8 qf[8];
#pragma unroll
            for (int ks = 0; ks < 8; ++ks) qf[ks] = qc[p * 8 + ks];
#pragma unroll
            for (int kt = 0; kt < 4; ++kt) {
                f32x16_t acc = {};
#pragma unroll
                for (int ks = 0; ks < 8; ++ks) { const bf16x8 a = *(const LAS bf16x8*)(skl + p * 32768 + (32 * kt + r32) * 256 + (((2 * ks + hi) ^ (r32 & 15)) << 4)); acc = __builtin_amdgcn_mfma_f32_32x32x16_bf16(a, qf[ks], acc, 0, 0, 0); }
                float g[16];
#pragma unroll
                for (int r = 0; r < 16; ++r) g[r] = pk_key(acc[r], 0xffffff80u, (unsigned)(32 * kt + (r & 3) + 8 * (r >> 2)));
                if (MODE != 1) pk_sort16(g);
                if (p == 0) { if (kt == 0) {
#pragma unroll
                        for (int i = 0; i < 16; ++i) top0[i] = g[i]; } else if (MODE != 1) pk_merge_top16(top0, g); else top0[kt] += g[kt]; }
                else { if (kt == 0) {
#pragma unroll
                        for (int i = 0; i < 16; ++i) top1[i] = g[i]; } else if (MODE != 1) pk_merge_top16(top1, g); else top1[kt] += g[kt]; }
            }
        }
        float mine[16], oth[16];
#pragma unroll
        for (int i = 0; i < 16; ++i) {
            const unsigned a0 = __builtin_bit_cast(unsigned, top0[i]) | ((unsigned)hi << 2), a1 = __builtin_bit_cast(unsigned, top1[i]) | ((unsigned)hi << 2);
            const auto rr = __builtin_amdgcn_permlane32_swap(a0, a1, false, false);
            mine[i] = __builtin_bit_cast(float, (unsigned)rr[0]); oth[i] = __builtin_bit_cast(float, (unsigned)rr[1]);
        }
        pk_merge_top16(mine, oth);
        float s1[16], s2[16];
#pragma unroll
        for (int i = 0; i < 16; ++i) { const unsigned m = __builtin_bit_cast(unsigned, mine[i]); const auto rr = __builtin_amdgcn_permlane32_swap(m, m, false, false);
            s1[i] = __builtin_bit_cast(float, (unsigned)rr[0]); s2[i] = __builtin_bit_cast(float, (unsigned)rr[1]); }
#pragma unroll
        for (int q4 = 0; q4 < 4; ++q4) {
            unsigned w1 = 0, w2 = 0;
#pragma unroll
            for (int k = 0; k < 4; ++k) { w1 |= (__builtin_bit_cast(unsigned, s1[4 * q4 + k]) & 127u) << (8 * k); w2 |= (__builtin_bit_cast(unsigned, s2[4 * q4 + k]) & 127u) << (8 * k); }
            *(LAS unsigned*)(tab + 4 * q4) = w1; *(LAS unsigned*)(tab + 16 + 4 * q4) = w2;
        }
#define PK_CAND(a, b) pk_key(s1[a] + s2[b], 0xffffff00u, (unsigned)((15 - (a)) * 16 + (15 - (b))))
        float G1[16], G2[16], G3[16];
#pragma unroll
        for (int b = 0; b < 16; ++b) G1[b] = PK_CAND(0, b);
#pragma unroll
        for (int b = 0; b < 8; ++b) { G2[b] = PK_CAND(1, b); G2[8 + b] = PK_CAND(15 - b, 0); }
        pk_bitonic16(G2);
        pk_merge_top16(G1, G2);
        G3[0] = PK_CAND(2, 0); G3[1] = PK_CAND(2, 1); G3[2] = PK_CAND(2, 2); G3[3] = PK_CAND(2, 3); G3[4] = PK_CAND(2, 4);
        G3[5] = PK_CAND(3, 0); G3[6] = PK_CAND(3, 1); G3[7] = PK_CAND(3, 2); G3[8] = PK_CAND(3, 3);
        G3[9] = PK_CAND(4, 0); G3[10] = PK_CAND(4, 1); G3[11] = PK_CAND(4, 2);
        G3[12] = PK_CAND(5, 0); G3[13] = PK_CAND(5, 1); G3[14] = PK_CAND(6, 0); G3[15] = PK_CAND(6, 1);
        pk_sort16(G3);
        G3[15] = __builtin_fmaxf(G3[15], PK_CAND(7, 0)); G3[14] = __builtin_fmaxf(G3[14], PK_CAND(7, 1));
        pk_bitonic16(G3);
        pk_merge_top16(G1, G3);
#undef PK_CAND
        LDS_WAIT();
        int e[16]; float pr[16]; float den = 0.f;
#pragma unroll
        for (int k = 0; k < 16; ++k) {
            const unsigned id = __builtin_bit_cast(unsigned, G1[k]) & 255u; const int a = 15 - (int)(id >> 4), b = 15 - (int)(id & 15u);
            const int i1 = *(const LAS unsigned char*)(tab + a), i2 = *(const LAS unsigned char*)(tab + 16 + b);
            e[k] = i1 * PNK + i2;
            pr[k] = __builtin_amdgcn_exp2f((G1[k] - G1[0]) * 1.4426950408889634f); den += pr[k];
        }
        const float inv = 1.f / den;
        const float* sc = (const float*)(ws + (hi == 0 ? WS_PSU : WS_PSV)) + layer * PNE;
        float scv[16];
#pragma unroll
        for (int k = 0; k < 16; ++k) scv[k] = sc[e[k]];
        if (hi == 0) {
#pragma unroll
            for (int k = 0; k < 4; ++k) { *(v4u*)(idx + (size_t)tok * PSEL + h * PTOPK + 4 * k) = (v4u){(unsigned)e[4 * k], (unsigned)e[4 * k + 1], (unsigned)e[4 * k + 2], (unsigned)e[4 * k + 3]};
                *(f32x4*)(suk + (size_t)tok * PSEL + h * PTOPK + 4 * k) = (f32x4){scv[4 * k], scv[4 * k + 1], scv[4 * k + 2], scv[4 * k + 3]}; }
        } else {
#pragma unroll
            for (int k = 0; k < 4; ++k) *(f32x4*)(gate + (size_t)tok * PSEL + h * PTOPK + 4 * k) = (f32x4){pr[4 * k] * inv * scv[4 * k], pr[4 * k + 1] * inv * scv[4 * k + 1], pr[4 * k + 2] * inv * scv[4 * k + 2], pr[4 * k + 3] * inv * scv[4 * k + 3]};
        }
    }
}

typedef _Float16 f16x2_t __attribute__((ext_vector_type(2)));
typedef _Float16 f16x8_t __attribute__((ext_vector_type(8)));
typedef short v4i16_t __attribute__((ext_vector_type(4)));
__device__ __forceinline__ void p2_mixer(const Args& A, Frame& F) {
    unsigned char* ws = A.ws;
    const bf16* aglu = (const bf16*)(ws + WS_AGLU); const bf16* ug = (const bf16*)(ws + WS_UG); const bf16* vg = (const bf16*)(ws + WS_VG); bf16* cat = (bf16*)(ws + WS_CAT);
    const float* cw = A.in[I_CONVW]; const float* cb = A.in[I_CONVB]; const float* clg = A.in[I_CLNG]; const float* clb = A.in[I_CLNB];
    const float* slg = A.in[I_SLNG]; const float* slb = A.in[I_SLNB]; const float* sb = A.in[I_SGUB]; const bf16* sgw = (const bf16*)(ws + WS_SGW);
    LAS unsigned char* L = F.lds;
    const int lane = F.lane, wave = F.wave;
    for (int unit = blockIdx.x; unit < T / 128; unit += F.G) {
        const int row0 = unit * 128, tin = (unit & 31) * 128;
#pragma unroll 1
        for (int pass = 0; pass < 2; ++pass) {
        if ((pass == 0) != ((blockIdx.x & 1) != 0)) {
        {
            const int cp = F.tid & 255, hf = F.tid >> 8, t0 = hf * 64;
            float w0[31], w1[31], x0[31], x1[31];
#pragma unroll
            for (int j = 0; j < 31; ++j) { const f32x2 ww = *(const f32x2*)(cw + j * 512 + 2 * cp); w0[j] = ww.x; w1[j] = ww.y; }
            const f32x2 bias = *(const f32x2*)(cb + 2 * cp);
            const unsigned char* gb = (const unsigned char*)aglu;
            unsigned o = (unsigned)(((row0 + t0 - 31) * 512 + 2 * cp) * 2);
            x0[0] = 0.f; x1[0] = 0.f;
#pragma unroll
            for (int s = 1; s < 31; ++s) { const int tt = s - 31; o += 1024u; asm volatile("" : "+v"(o)); unsigned wv = 0u; if (tin + t0 + tt >= 0) wv = *(const unsigned*)(gb + o); x0[s] = bf_lo(wv); x1[s] = bf_hi(wv); }
            unsigned lo = (unsigned)(t0 * 1024 + cp * 4);
            unsigned pre[4];
#pragma unroll
            for (int i = 0; i < 4; ++i) pre[i] = *(const unsigned*)(gb + (unsigned)(o + 1024u * (unsigned)(i + 1)));
            const unsigned olast = o + 1024u * 64u;
#pragma unroll 1
            for (int tb = 0; tb < 64; tb += 31) {
#pragma unroll
                for (int s = 0; s < 31; ++s) {
                    const int t = tb + s;
                    if (t < 64) {
                        o += 1024u; asm volatile("" : "+v"(o));
                        const unsigned wv = pre[s & 3]; { unsigned on = o + 4096u; on = on < olast ? on : olast; pre[s & 3] = *(const unsigned*)(gb + on); }
                        x0[s] = bf_lo(wv); x1[s] = bf_hi(wv);
                        float a0 = bias.x, a1 = bias.y;
#pragma unroll
                        for (int j = 0; j < 31; ++j) { a0 += w0[j] * x0[(s + 1 + j) % 31]; a1 += w1[j] * x1[(s + 1 + j) % 31]; }
                        const f16x2_t ov = {(_Float16)a0, (_Float16)a1};
                        *(LAS f16x2_t*)(L + lo) = ov; lo += 1024u; asm volatile("" : "+v"(lo));
                    }
                }
                { const unsigned p0 = pre[3], p1 = pre[0], p2 = pre[1], p3 = pre[2]; pre[0] = p0; pre[1] = p1; pre[2] = p2; pre[3] = p3; }
            }
        }
        __syncthreads();
#pragma unroll 2
        for (int k = 0; k < 16; ++k) {
            const int tl = wave * 16 + k; const f16x8_t hv = *(const LAS f16x8_t*)(L + tl * 1024 + lane * 16);
            float v[8]; float s = 0.f;
#pragma unroll
            for (int i = 0; i < 8; ++i) { v[i] = (float)hv[i]; s += v[i]; }
            const float mu = wave_sum(s) * (1.f / 512.f); float q = 0.f;
#pragma unroll
            for (int i = 0; i < 8; ++i) { v[i] -= mu; q += v[i] * v[i]; }
            const float rstd = rsqrtf(wave_sum(q) * (1.f / 512.f) + EPS);
            const f32x4 g0 = *(const f32x4*)(clg + lane * 8), g1 = *(const f32x4*)(clg + lane * 8 + 4), b0 = *(const f32x4*)(clb + lane * 8), b1 = *(const f32x4*)(clb + lane * 8 + 4);
            const float gg[8] = {g0.x, g0.y, g0.z, g0.w, g1.x, g1.y, g1.z, g1.w}, bb[8] = {b0.x, b0.y, b0.z, b0.w, b1.x, b1.y, b1.z, b1.w};
            float y[8];
#pragma unroll
            for (int i = 0; i < 8; ++i) { const float z = v[i] * rstd * gg[i] + bb[i]; y[i] = z * __builtin_amdgcn_rcpf(1.f + __expf(-z)); }
            v4u o; o.x = pk2(y[0], y[1]); o.y = pk2(y[2], y[3]); o.z = pk2(y[4], y[5]); o.w = pk2(y[6], y[7]);
            *(v4u*)(cat + (size_t)(row0 + tl) * 1024 + lane * 8) = o;
        }
        __syncthreads();
        } else {
#pragma unroll 1
        for (int k4 = 0; k4 < 16; k4 += 8) {
        v4u rawv[8];
#pragma unroll
        for (int k = 0; k < 8; ++k) rawv[k] = *(const v4u*)(vg + (size_t)(row0 + wave * 16 + k4 + k) * 512 + lane * 8);
#pragma unroll
        for (int k = 0; k < 8; ++k) {
            const int tl = wave * 16 + k4 + k;
            const v4u raw = rawv[k];
            float v[8] = {bf_lo(raw.x), bf_hi(raw.x), bf_lo(raw.y), bf_hi(raw.y), bf_lo(raw.z), bf_hi(raw.z), bf_lo(raw.w), bf_hi(raw.w)};
            float s = 0.f;
#pragma unroll
            for (int i = 0; i < 8; ++i) s += v[i];
            const float mu = wave_sum(s) * (1.f / 512.f); float q = 0.f;
#pragma unroll
            for (int i = 0; i < 8; ++i) { v[i] -= mu; q += v[i] * v[i]; }
            const float rstd = rsqrtf(wave_sum(q) * (1.f / 512.f) + EPS);
            const f32x4 g0 = *(const f32x4*)(slg + lane * 8), g1 = *(const f32x4*)(slg + lane * 8 + 4), b0 = *(const f32x4*)(slb + lane * 8), b1 = *(const f32x4*)(slb + lane * 8 + 4);
            const float gg[8] = {g0.x, g0.y, g0.z, g0.w, g1.x, g1.y, g1.z, g1.w}, bb[8] = {b0.x, b0.y, b0.z, b0.w, b1.x, b1.y, b1.z, b1.w};
#pragma unroll
            for (int i = 0; i < 8; ++i) v[i] = v[i] * rstd * gg[i] + bb[i];
            v4u o; o.x = pk2(v[0], v[1]); o.y = pk2(v[2], v[3]); o.z = pk2(v[4], v[5]); o.w = pk2(v[6], v[7]);
            *(LAS v4u*)(L + tl * 1024 + lane * 16) = o;
        }
        }
        __syncthreads();
        {
            const int h = wave, fr = lane & 15, fq = lane >> 4;
            const bf16* wh = sgw + (size_t)h * 128 * 128;
#pragma unroll 1
            for (int nh = 0; nh < 2; ++nh) {
                bf16x8 bfr[4][2];
#pragma unroll
                for (int ks = 0; ks < 4; ++ks)
#pragma unroll
                    for (int nt = 0; nt < 2; ++nt) {
                        const int n0 = h * 64 + (nh * 2 + nt) * 16;
                        const LAS unsigned char* pa = L + (size_t)(32 * ks + 8 * fq + (fr >> 2)) * 1024 + (n0 + 4 * (fr & 3)) * 2;
                        const v4i16_t lo = __builtin_amdgcn_ds_read_tr16_b64_v4i16((LAS v4i16_t*)pa), hi4 = __builtin_amdgcn_ds_read_tr16_b64_v4i16((LAS v4i16_t*)(pa + 4 * 1024));
                        bfr[ks][nt] = (bf16x8){lo[0], lo[1], lo[2], lo[3], hi4[0], hi4[1], hi4[2], hi4[3]};
                    }
                bf16x8 afn[4]; const int c = h * 64 + nh * 32 + 4 * fq;
#pragma unroll
                for (int ks = 0; ks < 4; ++ks) afn[ks] = *(const bf16x8*)(wh + (size_t)fr * 128 + 32 * ks + 8 * fq);
                v2u un0 = *(const v2u*)(ug + (size_t)(row0 + fr) * 512 + c), un1 = *(const v2u*)(ug + (size_t)(row0 + fr) * 512 + c + 16); float btn = sb[h * 128 + fr];
#pragma unroll 1
                for (int mt = 0; mt < 8; ++mt) {
                    bf16x8 af[4];
#pragma unroll
                    for (int ks = 0; ks < 4; ++ks) af[ks] = afn[ks];
                    const int t = 16 * mt + fr;
                    const v2u u0 = un0, u1 = un1; const float bt = btn;
                    { const int mn = mt < 7 ? mt + 1 : mt, tn = 16 * mn + fr;
#pragma unroll
                      for (int ks = 0; ks < 4; ++ks) afn[ks] = *(const bf16x8*)(wh + (size_t)tn * 128 + 32 * ks + 8 * fq);
                      un0 = *(const v2u*)(ug + (size_t)(row0 + tn) * 512 + c); un1 = *(const v2u*)(ug + (size_t)(row0 + tn) * 512 + c + 16); btn = sb[h * 128 + tn]; }
                    f32x4 acc0 = (f32x4){0.f, 0.f, 0.f, 0.f}, acc1 = (f32x4){0.f, 0.f, 0.f, 0.f};
#pragma unroll
                    for (int ks = 0; ks < 4; ++ks)
                        if (2 * ks <= mt) {
                            acc0 = __builtin_amdgcn_mfma_f32_16x16x32_bf16(bfr[ks][0], af[ks], acc0, 0, 0, 0);
                            acc1 = __builtin_amdgcn_mfma_f32_16x16x32_bf16(bfr[ks][1], af[ks], acc1, 0, 0, 0);
                        }
                    v2u o0, o1;
                    o0.x = pk2(bf_lo(u0.x) * (acc0[0] + bt), bf_hi(u0.x) * (acc0[1] + bt)); o0.y = pk2(bf_lo(u0.y) * (acc0[2] + bt), bf_hi(u0.y) * (acc0[3] + bt));
                    o1.x = pk2(bf_lo(u1.x) * (acc1[0] + bt), bf_hi(u1.x) * (acc1[1] + bt)); o1.y = pk2(bf_lo(u1.y) * (acc1[2] + bt), bf_hi(u1.y) * (acc1[3] + bt));
                    *(v2u*)(cat + (size_t)(row0 + t) * 1024 + 512 + c) = o0; *(v2u*)(cat + (size_t)(row0 + t) * 1024 + 512 + c + 16) = o1;
                }
            }
        }
        __syncthreads();
        }
        }
    }
}

struct S1a { int e0, e1; float a0, a1, b0, b1; v4u hq; float hs; };
__device__ __forceinline__ void s1a_load(S1a& s, const unsigned char* ws, int t, int lane) {
    const int* idx = (const int*)(ws + WS_IDX); const float* gsv = (const float*)(ws + WS_GATE); const float* suk = (const float*)(ws + WS_SUK);
    s.e0 = idx[(size_t)t * PSEL + lane]; s.e1 = idx[(size_t)t * PSEL + 64 + lane];
    s.a0 = suk[(size_t)t * PSEL + lane]; s.a1 = suk[(size_t)t * PSEL + 64 + lane];
    s.b0 = gsv[(size_t)t * PSEL + lane]; s.b1 = gsv[(size_t)t * PSEL + 64 + lane];
    s.hq = *(const v4u*)(ws + WS_HQ + (size_t)t * D + lane * 16); s.hs = ((const float*)(ws + WS_HQS))[t];
}
struct ChunkA { v4u rows[8]; v4u hq; float sa, sb; int kk, nv, t; };
struct WalkA { S1a cur, nxt; unsigned long long m0, m1; int it, nit, wrank, nw, nslice, xs0, xstep; bool done; };
__device__ __forceinline__ int walk_tok(const WalkA& w, int it) { return w.wrank + (it / w.nslice) * w.nw; }
__device__ __forceinline__ void walk_masks(WalkA& w) { const int xs = w.xs0 + (w.it % w.nslice) * w.xstep; w.m0 = __ballot((w.cur.e0 >> 11) == xs); w.m1 = __ballot((w.cur.e1 >> 11) == xs); }
template <int MODE> __device__ __forceinline__ void gen_a(ChunkA& c, WalkA& w, const unsigned char* ws, const unsigned char* ut, int lane, int cls) {
    while ((w.m0 | w.m1) == 0ull && !w.done) {
        ++w.it;
        if (w.it >= w.nit) { w.done = true; break; }
        w.cur = w.nxt;
        { const int itn = (w.it + 1 < w.nit) ? w.it + 1 : w.nit - 1; s1a_load(w.nxt, ws, walk_tok(w, itn), lane); }
        walk_masks(w);
    }
    if (w.done) { c.nv = 0; return; }
    int kl = 0, nv = 0, kkv = 0;
    unsigned long long lo = w.m0, hi = w.m1;
#pragma unroll
    for (int i = 0; i < 8; ++i) {
        const bool has = (lo | hi) != 0ull, uselo = lo != 0ull;
        const unsigned long long m = uselo ? lo : hi;
        const int kp = (uselo ? 0 : 64) + __builtin_ctzll(m | 0x8000000000000000ull);
        const unsigned long long mc = m & (m - 1ull);
        lo = uselo ? mc : lo; hi = uselo ? hi : mc;
        const int k = has ? kp : kl; nv += has ? 1 : 0; kl = k;
        const int e = __builtin_amdgcn_readlane(k < 64 ? w.cur.e0 : w.cur.e1, k & 63);
        if (MODE == 1) { c.rows[i] = w.cur.hq; c.rows[i].x += (unsigned)e; } else
        c.rows[i] = *(const v4u*)(ut + (size_t)e * D + lane * 16);
        kkv = (cls == i) ? k : kkv;
    }
    w.m0 = lo; w.m1 = hi;
    const float a0s = __shfl(w.cur.a0, kkv & 63), a1s = __shfl(w.cur.a1, kkv & 63), b0s = __shfl(w.cur.b0, kkv & 63), b1s = __shfl(w.cur.b1, kkv & 63);
    c.sa = w.cur.hs * (kkv < 64 ? a0s : a1s); c.sb = kkv < 64 ? b0s : b1s; c.kk = kkv; c.nv = nv; c.t = walk_tok(w, w.it); c.hq = w.cur.hq;
}
__device__ __forceinline__ void compute_a(const ChunkA& c, float* cb, int lane, int cls) {
    int d[8];
#pragma unroll
    for (int i = 0; i < 8; ++i) { const v4u& ur = c.rows[i];
        int s = __builtin_amdgcn_sdot4((int)ur.x, (int)c.hq.x, 0, false); s = __builtin_amdgcn_sdot4((int)ur.y, (int)c.hq.y, s, false); s = __builtin_amdgcn_sdot4((int)ur.z, (int)c.hq.z, s, false); d[i] = __builtin_amdgcn_sdot4((int)ur.w, (int)c.hq.w, s, false); }
    const bool b3 = lane & 8;
    int q4[4];
#pragma unroll
    for (int i = 0; i < 4; ++i) { const auto rr = __builtin_amdgcn_permlane32_swap((unsigned)d[i], (unsigned)d[i + 4], false, false); q4[i] = (int)rr[0] + (int)rr[1]; }
    int q2[2];
#pragma unroll
    for (int i = 0; i < 2; ++i) {
        const auto ra = __builtin_amdgcn_permlane16_swap((unsigned)q4[i], (unsigned)q4[i], false, false), rb = __builtin_amdgcn_permlane16_swap((unsigned)q4[i + 2], (unsigned)q4[i + 2], false, false);
        const int sa_ = (int)ra[0] + (int)ra[1], sb_ = (int)rb[0] + (int)rb[1]; q2[i] = (lane & 16) ? sb_ : sa_; }
    int q1; { const int send = b3 ? q2[0] : q2[1], keep = b3 ? q2[1] : q2[0]; q1 = keep + dpp_i<DPP_ROR8>(send); }
    q1 += dpp_i<DPP_HMIRROR>(q1); q1 += dpp_i<DPP_XOR2>(q1); q1 += dpp_i<DPP_XOR1>(q1);
    const float cf = c.sb * gelu_tanh((float)q1 * c.sa);
    if ((lane & 7) == 0 && cls < c.nv) cb[(size_t)c.t * PSEL + c.kk] = cf;
}
template <int MODE> __device__ __forceinline__ void p7a_act(const Args& A, Frame& F, int layer) {
    unsigned char* ws = A.ws;
    const unsigned char* ut = ws + WS_PU + (size_t)layer * PNE * D; float* cb = (float*)(ws + (MODE == 0 ? WS_CB : WS_SUK + 0));
    const int lane = F.lane;
    const int cls = ((lane >> 5) & 1) * 4 + ((lane >> 4) & 1) * 2 + ((lane >> 3) & 1);
    WalkA w;
    w.xs0 = F.xi; w.xstep = F.nx; w.nslice = F.xi < 8 ? (7 - F.xi) / F.nx + 1 : 0;
    w.wrank = F.xr * NWAVES + F.wave; w.nw = F.xn * NWAVES;
    const int cnt = (w.wrank < T) ? (T - 1 - w.wrank) / w.nw + 1 : 0;
    w.nit = cnt * w.nslice; w.it = 0; w.done = (w.nit == 0);
    if (w.done) return;
    s1a_load(w.cur, ws, walk_tok(w, 0), lane); s1a_load(w.nxt, ws, walk_tok(w, w.nit > 1 ? 1 : 0), lane);
    walk_masks(w);
    ChunkA ca, cbf;
    gen_a<MODE>(ca, w, ws, ut, lane, cls);
    while (ca.nv > 0) {
        gen_a<MODE>(cbf, w, ws, ut, lane, cls);
        compute_a(ca, cb, lane, cls);
        if (cbf.nv == 0) break;
        gen_a<MODE>(ca, w, ws, ut, lane, cls);
        compute_a(cbf, cb, lane, cls);
    }
}
__device__ __forceinline__ void y_ld_e(v4u (&e)[2], const unsigned char* ws, int t, int r) {
    const int* idx = (const int*)(ws + WS_IDX);
    e[0] = *(const v4u*)(idx + (size_t)t * PSEL + 8 * r); e[1] = *(const v4u*)(idx + (size_t)t * PSEL + 8 * r + 4);
}
template <int MODE> __device__ __forceinline__ void rows_issue8(v4u (&rows)[8], const v4u (&e4)[2], const unsigned char* base, unsigned loff) {
#pragma unroll
    for (int i = 0; i < 8; ++i) { const unsigned e = ((const unsigned*)&e4[i >> 2])[i & 3]; if (MODE == 1) { rows[i] = e4[0]; rows[i].x += e; } else { const unsigned off = e * 128u + loff; rows[i] = *(const v4u*)(base + off); } }
}
__device__ __forceinline__ void part_planes(v4u& hh, v4u& hl, const v4u& a, const v4u& b) {
    const unsigned w[8] = {a.x, a.y, a.z, a.w, b.x, b.y, b.z, b.w}; unsigned oh[4], ol[4];
#pragma unroll
    for (int q = 0; q < 4; ++q) { const unsigned w0 = w[2 * q], w1 = w[2 * q + 1];
        const unsigned h0 = (((w0 >> 4) & 0x0F0F0F0Fu) + ((w0 >> 3) & 0x01010101u)) & 0x0F0F0F0Fu, h1 = (((w1 >> 4) & 0x0F0F0F0Fu) + ((w1 >> 3) & 0x01010101u)) & 0x0F0F0F0Fu;
        ol[q] = (w0 & 0x0F0F0F0Fu) | ((w1 & 0x0F0F0F0Fu) << 4); oh[q] = h0 | (h1 << 4); }
    hh = (v4u){oh[0], oh[1], oh[2], oh[3]}; hl = (v4u){ol[0], ol[1], ol[2], ol[3]};
}
__device__ __forceinline__ void part_round(const v4u (&rows)[8], const v4u& hh4, const v4u& hl4, int* po, int j) {
    int sm[8];
    const unsigned hh[4] = {hh4.x, hh4.y, hh4.z, hh4.w}, hl[4] = {hl4.x, hl4.y, hl4.z, hl4.w};
#pragma unroll
    for (int i = 0; i < 8; ++i) {
        const unsigned w[4] = {rows[i].x, rows[i].y, rows[i].z, rows[i].w}; int sh = 0, sl = 0;
#pragma unroll
        for (int q = 0; q < 4; ++q) { sh = __builtin_amdgcn_sdot8((int)w[q], (int)hh[q], sh, false); sl = __builtin_amdgcn_sdot8((int)w[q], (int)hl[q], sl, false); }
        int s_ = (sh << 4) + sl;
        s_ += dpp_i<DPP_XOR1>(s_); s_ += dpp_i<DPP_XOR2>(s_); s_ += dpp_i<DPP_HMIRROR>(s_);
        sm[i] = s_;
    }
    if (j == 0) { *(v4u*)po = (v4u){(unsigned)sm[0], (unsigned)sm[1], (unsigned)sm[2], (unsigned)sm[3]}; *(v4u*)(po + 4) = (v4u){(unsigned)sm[4], (unsigned)sm[5], (unsigned)sm[6], (unsigned)sm[7]}; }
}
template <int MODE> __device__ __forceinline__ void p7a_part(const Args& A, Frame& F, int layer) {
    unsigned char* ws = A.ws;
    const unsigned char* ut = ws + WS_PU + (size_t)layer * PNE * 512; int* part = (int*)(ws + (MODE == 1 ? WS_R4 + 64 * MiB : WS_PART));
    const int lane = F.lane, g = lane >> 3, j = lane & 7;
    const int nslice = F.xi < 8 ? (7 - F.xi) / F.nx + 1 : 0, xs0 = F.xi, xstep = F.nx;
    const int wrank = F.xr * NWAVES + F.wave, nw = F.xn * NWAVES;
    constexpr int NSUP = T / 16;
    const int cnt = (wrank < NSUP) ? (NSUP - 1 - wrank) / nw + 1 : 0, nit = cnt * nslice * 16;
    if (nit == 0) return;
#define IT_T(it) (wrank + ((it) / nslice) * nw)
#define IT_X(it) (xs0 + ((it) % nslice) * xstep)
#define IT_C(it) ((it) < nit ? (it) : nit - 1)
#define Y_TOK(R) (2 * (8 * IT_T((R) >> 4) + g) + (IT_X((R) >> 4) >> 2))
#define Y_SL(R) (IT_X((R) >> 4) & 3)
#define P_LDH(dh, dl, R) do { const unsigned char* hp_ = ws + WS_HQ + (size_t)Y_TOK(R) * D + Y_SL(R) * 256 + j * 32; dh = *(const v4u*)hp_; dl = *(const v4u*)(hp_ + 16); } while (0)
    v4u E[4][2]; v4u buf[4][8]; v4u Hh, Hl, Nh, Nl;
    { v4u e0[2];
      y_ld_e(e0, ws, Y_TOK(0), 0); P_LDH(Hh, Hl, 0); rows_issue8<MODE>(buf[0], e0, ut + (size_t)Y_SL(0) * PNE * 128, (unsigned)(j * 16));
      { const int i1 = IT_C(1); y_ld_e(e0, ws, Y_TOK(i1), i1 & 15); rows_issue8<MODE>(buf[1], e0, ut + (size_t)Y_SL(i1) * PNE * 128, (unsigned)(j * 16)); }
      { const int i2 = IT_C(2); y_ld_e(e0, ws, Y_TOK(i2), i2 & 15); rows_issue8<MODE>(buf[2], e0, ut + (size_t)Y_SL(i2) * PNE * 128, (unsigned)(j * 16)); }
      { const int i3 = IT_C(3); y_ld_e(E[3], ws, Y_TOK(i3), i3 & 15); } { const int i4 = IT_C(4); y_ld_e(E[0], ws, Y_TOK(i4), i4 & 15); } { const int i5 = IT_C(5); y_ld_e(E[1], ws, Y_TOK(i5), i5 & 15); }
      Nh = Hh; Nl = Hl; }
#define P_POS(p) do { const int R = it + (p); \
        { const int r6 = IT_C(R + 6), r3 = IT_C(R + 3); y_ld_e(E[((p) + 2) & 3], ws, Y_TOK(r6), r6 & 15); \
          if ((R & 15) == 12) { const int rn = IT_C(R + 4); P_LDH(Nh, Nl, rn); } \
          rows_issue8<MODE>(buf[((p) + 3) & 3], E[((p) + 3) & 3], ut + (size_t)Y_SL(r3) * PNE * 128, (unsigned)(j * 16)); } \
        if ((R & 15) == 0) { part_planes(Hh, Hl, Nh, Nl); } \
        part_round(buf[(p) & 3], Hh, Hl, part + ((size_t)Y_SL(R) * T + Y_TOK(R)) * PSEL + 8 * (R & 15), j); } while (0)
#pragma unroll 1
    for (int it = 0; it < nit; it += 4) { P_POS(0); P_POS(1); P_POS(2); P_POS(3); }
#undef P_POS
#undef P_LDH
}
__device__ __forceinline__ void p7c_combine(const Args& A, Frame& F) {
    unsigned char* ws = A.ws;
    const int* part = (const int*)(ws + WS_PART); const float* suk = (const float*)(ws + WS_SUK); const float* gsv = (const float*)(ws + WS_GATE); const float* hsb = (const float*)(ws + WS_HQS);
    unsigned* cq = (unsigned*)(ws + WS_CB); float* csc = (float*)(ws + WS_CB + 8 * MiB);
    const size_t gt = (size_t)blockIdx.x * NTHREADS + F.tid, NT = (size_t)F.G * NTHREADS;
    for (size_t i4 = gt; i4 < (size_t)T * PSEL / 4; i4 += NT) {
        int s0 = 0, s1 = 0, s2 = 0, s3 = 0;
#pragma unroll
        for (int x = 0; x < 4; ++x) { const v4u p = *(const v4u*)(part + (size_t)x * T * PSEL + 4 * i4); s0 += (int)p.x; s1 += (int)p.y; s2 += (int)p.z; s3 += (int)p.w; }
        const size_t t = (4 * i4) >> 7;
        const f32x4 a = *(const f32x4*)(suk + 4 * i4), b = *(const f32x4*)(gsv + 4 * i4); const float hs = hsb[t];
        const float c0 = b.x * gelu_tanh((float)s0 * hs * a.x), c1 = b.y * gelu_tanh((float)s1 * hs * a.y), c2 = b.z * gelu_tanh((float)s2 * hs * a.z), c3 = b.w * gelu_tanh((float)s3 * hs * a.w);
        float m = fmaxf(fmaxf(fabsf(c0), fabsf(c1)), fmaxf(fabsf(c2), fabsf(c3)));
#pragma unroll
        for (int o = 1; o < 32; o <<= 1) m = fmaxf(m, __shfl_xor(m, o));
        const float inv = m > 0.f ? 127.f / m : 0.f;
        const int q0 = (int)rintf(c0 * inv), q1 = (int)rintf(c1 * inv), q2 = (int)rintf(c2 * inv), q3 = (int)rintf(c3 * inv);
        cq[i4] = (unsigned)(q0 & 255) | ((unsigned)(q1 & 255) << 8) | ((unsigned)(q2 & 255) << 16) | ((unsigned)(q3 & 255) << 24);
        if ((i4 & 31) == 0) csc[t] = m * (1.f / 127.f);
    }
}
__device__ __forceinline__ v2u y_ld_c(const unsigned char* ws, int t, int r) { return *(const v2u*)(ws + WS_CB + (size_t)t * PSEL + 8 * r); }
__device__ __forceinline__ void y_round(int (&y)[32], int& csum, const v4u (&rows)[8], const v2u& cq) {
#pragma unroll
    for (int kq = 0; kq < 2; ++kq) {
        const int c4 = (int)((const unsigned*)&cq)[kq];
        csum = __builtin_amdgcn_sdot4(c4, 0x01010101, csum, false);
#pragma unroll
        for (int q = 0; q < 4; ++q) {
            const unsigned r0 = ((const unsigned*)&rows[4 * kq])[q], r1 = ((const unsigned*)&rows[4 * kq + 1])[q], r2 = ((const unsigned*)&rows[4 * kq + 2])[q], r3 = ((const unsigned*)&rows[4 * kq + 3])[q];
            const unsigned u0 = __builtin_amdgcn_perm(r1, r0, 0x05010400u), u1 = __builtin_amdgcn_perm(r1, r0, 0x07030602u), u2 = __builtin_amdgcn_perm(r3, r2, 0x05010400u), u3 = __builtin_amdgcn_perm(r3, r2, 0x07030602u);
            const unsigned t[4] = {__builtin_amdgcn_perm(u2, u0, 0x05040100u), __builtin_amdgcn_perm(u2, u0, 0x07060302u), __builtin_amdgcn_perm(u3, u1, 0x05040100u), __builtin_amdgcn_perm(u3, u1, 0x07060302u)};
#pragma unroll
            for (int bb = 0; bb < 4; ++bb) {
                y[8 * q + 2 * bb] = __builtin_amdgcn_sdot4((int)t[bb], c4, y[8 * q + 2 * bb], false);
                y[8 * q + 2 * bb + 1] = __builtin_amdgcn_sdot4((int)(t[bb] & 0x0F0F0F0Fu), c4, y[8 * q + 2 * bb + 1], false); }
        }
    }
}
template <bool NN, int MODE = 0> __device__ __forceinline__ void p7b_y(const Args& A, Frame& F, int layer, const float* gnext, bf16* xout) {
    unsigned char* ws = A.ws;
    const unsigned char* vt = ws + WS_PV + (size_t)layer * PNE * 512;
    const int lane = F.lane, g = lane >> 3, j = lane & 7;
    const int nslice = F.xi < 8 ? (7 - F.xi) / F.nx + 1 : 0, xs0 = F.xi, xstep = F.nx;
    const int wrank = F.xr * NWAVES + F.wave, nw = F.xn * NWAVES;
    constexpr int NSUP = T / 16;
    const int cnt = (wrank < NSUP) ? (NSUP - 1 - wrank) / nw + 1 : 0, nit = cnt * nslice * 16;
    if (nit == 0) return;
    v4u E[4][2]; v2u Cq[4]; v4u buf[4][8]; int y[32]; int csum = 0;
    { v4u e0[2];
      y_ld_e(e0, ws, Y_TOK(0), 0); Cq[0] = y_ld_c(ws, Y_TOK(0), 0); rows_issue8<MODE>(buf[0], e0, vt + (size_t)Y_SL(0) * PNE * 128, (unsigned)(j * 16));
      { const int i1 = IT_C(1); y_ld_e(e0, ws, Y_TOK(i1), i1 & 15); Cq[1] = y_ld_c(ws, Y_TOK(i1), i1 & 15); rows_issue8<MODE>(buf[1], e0, vt + (size_t)Y_SL(i1) * PNE * 128, (unsigned)(j * 16)); }
      { const int i2 = IT_C(2); y_ld_e(e0, ws, Y_TOK(i2), i2 & 15); Cq[2] = y_ld_c(ws, Y_TOK(i2), i2 & 15); rows_issue8<MODE>(buf[2], e0, vt + (size_t)Y_SL(i2) * PNE * 128, (unsigned)(j * 16)); }
      { const int i3 = IT_C(3); y_ld_e(E[3], ws, Y_TOK(i3), i3 & 15); } { const int i4 = IT_C(4); y_ld_e(E[0], ws, Y_TOK(i4), i4 & 15); } { const int i5 = IT_C(5); y_ld_e(E[1], ws, Y_TOK(i5), i5 & 15); } }
#define Y_POS(p) do { const int R = it + (p); \
        { const int r6 = IT_C(R + 6), r3 = IT_C(R + 3); y_ld_e(E[((p) + 2) & 3], ws, Y_TOK(r6), r6 & 15); Cq[((p) + 3) & 3] = y_ld_c(ws, Y_TOK(r3), r3 & 15); \
          rows_issue8<MODE>(buf[((p) + 3) & 3], E[((p) + 3) & 3], vt + (size_t)Y_SL(r3) * PNE * 128, (unsigned)(j * 16)); } \
        if ((R & 15) == 0) { _Pragma("unroll") for (int i = 0; i < 32; ++i) y[i] = 0; csum = 0; } \
        y_round(y, csum, buf[(p) & 3], Cq[(p) & 3]); \
        if ((R & 15) == 15) { const int tt = Y_TOK(R); bf16* xo = xout + (size_t)tt * D + Y_SL(R) * 256 + j * 32; const float cs = ((const float*)(ws + WS_CB + 8 * MiB))[tt]; \
            v4u xv[4]; _Pragma("unroll") for (int q = 0; q < 4; ++q) xv[q] = *(const v4u*)(xo + 8 * q); \
            _Pragma("unroll") for (int q = 0; q < 4; ++q) { v4u o; unsigned* op = (unsigned*)&o; const unsigned* xp = (const unsigned*)&xv[q]; \
                  \
                _Pragma("unroll") for (int e = 0; e < 4; ++e) { const int c0 = 2 * e, c1 = 2 * e + 1; \
                    const int v0 = (c0 < 4) ? y[8 * q + 2 * c0 + 1] - 8 * csum : (y[8 * q + 2 * (c0 - 4)] - y[8 * q + 2 * (c0 - 4) + 1]) >> 4; \
                    const int v1 = (c1 < 4) ? y[8 * q + 2 * c1 + 1] - 8 * csum : (y[8 * q + 2 * (c1 - 4)] - y[8 * q + 2 * (c1 - 4) + 1]) >> 4; \
                    op[e] = pk2(bf_lo(xp[e]) + (float)v0 * cs, bf_hi(xp[e]) + (float)v1 * cs); } \
                *(v4u*)(xo + 8 * q) = o; } } } while (0)
#pragma unroll 1
    for (int it = 0; it < nit; it += 4) { Y_POS(0); Y_POS(1); Y_POS(2); Y_POS(3); }
#undef Y_POS
#undef Y_TOK
#undef Y_SL
#undef IT_T
#undef IT_X
#undef IT_C
}
__device__ __forceinline__ void p_norm_final(const Args& A, Frame& F, const bf16* xres, const float* g) {
    const int gw = F.vcu * NWAVES + F.wave, NGW = F.G * NWAVES, lane = F.lane;
    for (int m = gw; m < T; m += NGW) {
        const v4u a = *(const GAS v4u*)(xres + (size_t)m * D + lane * 16), b = *(const GAS v4u*)(xres + (size_t)m * D + lane * 16 + 8);
        f32x4 v[4] = {(f32x4){bf_lo(a.x), bf_hi(a.x), bf_lo(a.y), bf_hi(a.y)}, (f32x4){bf_lo(a.z), bf_hi(a.z), bf_lo(a.w), bf_hi(a.w)}, (f32x4){bf_lo(b.x), bf_hi(b.x), bf_lo(b.y), bf_hi(b.y)}, (f32x4){bf_lo(b.z), bf_hi(b.z), bf_lo(b.w), bf_hi(b.w)}};
        float s = 0.f;
#pragma unroll
        for (int q = 0; q < 4; ++q) s += (v[q].x * v[q].x + v[q].y * v[q].y) + (v[q].z * v[q].z + v[q].w * v[q].w);
        const float r = rsqrtf(wave_sum(s) * (1.f / D) + EPS);
#pragma unroll
        for (int q = 0; q < 4; ++q) *(GAS f32x4*)(A.out + (size_t)m * D + lane * 16 + 4 * q) = v[q] * r * *(const GAS f32x4*)(g + lane * 16 + 4 * q);
    }
}
#ifndef MK_ONE_LAUNCH
#define MK_ONE_LAUNCH 1
#endif
constexpr int NPH = 20;
#ifndef PROBE_DUP
#define PROBE_DUP 0
#endif
__global__ void __launch_bounds__(NTHREADS, 2) fwd(Args args) {
    extern __shared__ __attribute__((aligned(16))) unsigned char lds[];
    Frame F;
    F.lds = (LAS unsigned char*)lds;
    F.MISC = (volatile LAS unsigned*)(F.lds + MISC_OFF);
    F.tid = threadIdx.x; F.lane = F.tid & 63; F.wave = __builtin_amdgcn_readfirstlane(F.tid >> 6);
    F.G = gridDim.x; { const int bx = blockIdx.x; F.vcu = (F.G % 8 == 0) ? (bx % 8) * (F.G / 8) + bx / 8 : bx; }
    unsigned char* ws = args.ws;
    F.ctl = (gu32*)(ws + WS_CTL);
    for (int u = F.tid; u < (LDS_BYTES - LDSCTL_OFF) / 4; u += NTHREADS) ((LAS unsigned*)(F.lds + LDSCTL_OFF))[u] = 0u;
    __syncthreads();
    XcdBarrier bar; bar.bar = (unsigned*)(F.ctl + CW_BAR); bar.x = 0; bar.st = nullptr;
    { bar.bar = (unsigned*)(F.ctl + CW_BAR); bar.x = xb_xcc_id(); bar.st = F.MISC + 8;
      if (F.tid == 0) F.MISC[10] = xb_add(&bar.bar[XB_XCNT(bar.x)], 1u); }
#define GRID_BAR() do { if (MK_ONE_LAUNCH) { xcd_barrier(bar); if (PROBE_DUP == 120) xcd_barrier(bar); } } while (0)
    const int lo = args.ph_lo, hi = args.ph_hi;
#ifdef ONLY_PH
#define IN(k) ((k) == ONLY_PH && lo <= (k) && (k) < hi)
#else
#define IN(k) (lo <= (k) && (k) < hi)
#endif
    bf16* hA = (bf16*)(ws + WS_HA);

    if (IN(0)) { p0_prologue(args, F); GRID_BAR(); if (PROBE_DUP == 100) { p0_prologue(args, F); GRID_BAR(); } p0_weights8(args, F); GRID_BAR(); }
    {
        if (F.tid == 0) { unsigned below = 0u;
#pragma unroll
            for (unsigned j = 0; j < 16; ++j) { const unsigned c = xb_ld(&bar.bar[XB_XCNT(j)]); below += (j < bar.x && c > 0u) ? 1u : 0u; }
            F.MISC[11] = below; }
        __syncthreads();
        F.xi = __builtin_amdgcn_readfirstlane((int)F.MISC[11]); F.xr = __builtin_amdgcn_readfirstlane((int)F.MISC[10]); F.xn = __builtin_amdgcn_readfirstlane((int)F.MISC[8]); F.nx = __builtin_amdgcn_readfirstlane((int)F.MISC[9]);
        if (F.xn < 1) F.xn = 1; if (F.nx < 1) F.nx = 1;
    }
    if (IN(1)) {
        pg8::Gemm g{(const bf16*)(ws + WS_HQ), (const bf16*)(ws + WS_WIN), T, MIX_IN, D / 2}; pg8::StaticOrder S; S.init(T, MIX_IN, F.G, (int)blockIdx.x);
        pg8::EpiI8<pg8::EpiMixIn> E{pg8::EpiMixIn{(bf16*)(ws + WS_AGLU), (bf16*)(ws + WS_UG), (bf16*)(ws + WS_VG)}, (const float*)(ws + WS_HQS), (const float*)(ws + WS_WSC)};
        pg8::gemm_phase<pg8::EpiI8<pg8::EpiMixIn>, pg8::StaticOrder, true, true, true>(F.lds, g, S, E);
        GRID_BAR();
        if (PROBE_DUP == 101) { pg8::gemm_phase<pg8::EpiI8<pg8::EpiMixIn>, pg8::StaticOrder, true, true, true>(F.lds, g, S, E); GRID_BAR(); }
    }
    if (IN(2)) { p2_mixer(args, F); GRID_BAR(); if (PROBE_DUP == 102) { p2_mixer(args, F); GRID_BAR(); } }
    if (IN(3)) {
        pg8::Gemm g{(const bf16*)(ws + WS_CAT), (const bf16*)(ws + WS_WOUT), T, D, D}; pg8::StaticOrder S; S.init(T, D, F.G, (int)blockIdx.x);
        pg8::EpiResB<false> E{args.in[I_X], nullptr, hA, D};
        pg8::gemm_phase<pg8::EpiResB<false>, pg8::StaticOrder, true, true>(F.lds, g, S, E);
        GRID_BAR();
    }
#define PEER_PHASES(layer, pb) do { \
        if (IN(pb)) { p_rms<true>(args, F, hA, args.in[I_GFFN] + (layer) * D); GRID_BAR(); } \
        if (IN((pb) + 1)) { \
            pg8::Gemm g{(const bf16*)(ws + WS_HQ), (const bf16*)(ws + WS_WQ + (size_t)(layer) * 2048 * D), T, 2048, D / 2}; pg8::StaticOrder S; S.init(T, 2048, F.G, (int)blockIdx.x); \
            pg8::EpiI8Bf16<false> E{(bf16*)(ws + WS_QP), 2048, 0, 0, 1.f, (const float*)(ws + WS_HQS), (const float*)(ws + WS_WSC) + 2048 + (layer) * 2048, nullptr, 0}; \
            pg8::gemm_phase<pg8::EpiI8Bf16<false>, pg8::StaticOrder, true, true, true>(F.lds, g, S, E); \
            GRID_BAR(); \
            if (PROBE_DUP == 105) { pg8::gemm_phase<pg8::EpiI8Bf16<false>, pg8::StaticOrder, true, true, true>(F.lds, g, S, E); GRID_BAR(); } \
        } \
        if (IN((pb) + 2)) { if (PROBE_DUP == 116) { p6_route<1>(args, F, (layer)); GRID_BAR(); } p6_route<0>(args, F, (layer)); GRID_BAR(); if (PROBE_DUP == 106) { p6_route<0>(args, F, (layer)); GRID_BAR(); } } \
        if (IN((pb) + 3)) { if (PROBE_DUP == 117) { p7a_part<1>(args, F, (layer)); GRID_BAR(); } p7a_part<0>(args, F, (layer)); GRID_BAR(); if (PROBE_DUP == 107) { p7a_part<0>(args, F, (layer)); GRID_BAR(); } p7c_combine(args, F); GRID_BAR(); if (PROBE_DUP == 108) { p7c_combine(args, F); GRID_BAR(); } } \
        if (IN((pb) + 4)) { if (PROBE_DUP == 118) { p7b_y<false, 1>(args, F, (layer), args.in[I_GFIN], (bf16*)(ws + WS_PART)); GRID_BAR(); } if (PROBE_DUP == 121) { p7b_y<false, 3>(args, F, (layer), args.in[I_GFIN], (bf16*)(ws + WS_PART)); GRID_BAR(); } if (PROBE_DUP == 119) { p7b_y<false, 2>(args, F, (layer), args.in[I_GFIN], (bf16*)(ws + WS_PART)); GRID_BAR(); } p7b_y<false>(args, F, (layer), args.in[I_GFIN], hA); GRID_BAR(); } \
        if (IN((pb) + 5)) { if ((layer) == 0) { p_rms<true, false>(args, F, hA, args.in[I_GMIX] + D); GRID_BAR(); } else p_norm_final(args, F, hA, args.in[I_GFIN]); } \
    } while (0)
    PEER_PHASES(0, 4);
    if (IN(10)) {
        pg8::Gemm g{(const bf16*)(ws + WS_HQ), (const bf16*)(ws + WS_WQKV), T, 3 * D, D / 2}; pg8::StaticOrder S; S.init(T, 3 * D, F.G, (int)blockIdx.x);
        pg8::EpiI8Bf16<true> E{(bf16*)(ws + WS_Q), D, D, (size_t)(WS_K - WS_Q) / 2, attn_body::C2, (const float*)(ws + WS_HQS), (const float*)(ws + WS_WSC) + 6144, (float*)(ws + WS_KMEAN), T / 256};
        pg8::gemm_phase<pg8::EpiI8Bf16<true>, pg8::StaticOrder, true, true, true>(F.lds, g, S, E);
        GRID_BAR();
    }
    if (IN(12)) {
        static_assert(attn_body::ATTN_LDS_BYTES <= RING_BYTES && attn_body::GLUT_OFF == LUT_OFF && attn_body::GLUT_N == LUT_N, "attention body geometry vs frame");
        const attn_body::AttnTensors AT{(const attn_body::bf16*)(ws + WS_Q), (const attn_body::bf16*)(ws + WS_K), (const attn_body::bf16*)(ws + WS_V), (attn_body::bf16*)(ws + WS_Q), (const float*)(ws + WS_KMEAN), (const float*)(ws + WS_LUT)};
        const attn_body::StaticOrder S((int)F.G, (int)blockIdx.x);
        if (PROBE_DUP == 112) { const attn_body::AttnTensors AT2{AT.Q, AT.K, AT.V, (attn_body::bf16*)(ws + WS_HA), AT.KM, AT.GLUT}; attn_body::attn_phase<attn_body::StaticOrder>((char*)lds, AT2, S); GRID_BAR(); }
        if (PROBE_DUP == 113) { const attn_body::AttnTensors AT2{AT.Q, AT.K, AT.V, (attn_body::bf16*)(ws + WS_HA), AT.KM, AT.GLUT}; attn_body::attn_phase<attn_body::StaticOrder, 8, true>((char*)lds, AT2, S); GRID_BAR(); }
        attn_body::attn_phase<attn_body::StaticOrder>((char*)lds, AT, S);
        GRID_BAR();
    }
    { int t_ = threadIdx.x; asm volatile("" : "+v"(t_)); F.tid = t_; F.lane = t_ & 63; }
    if (IN(13)) {
        pg8::Gemm g{(const bf16*)(ws + WS_Q), (const bf16*)(ws + WS_WO), T, D, D}; pg8::StaticOrder S; S.init(T, D, F.G, (int)blockIdx.x);
        pg8::EpiResB<true> E{nullptr, hA, hA, D};
        pg8::gemm_phase<pg8::EpiResB<true>, pg8::StaticOrder, true, true>(F.lds, g, S, E);
        GRID_BAR();
    }
    PEER_PHASES(1, 14);
#undef PEER_PHASES
#undef IN
#undef GRID_BAR
}

extern "C" void kernel_launch(void* const* d_in, const int* in_sizes, int n_in, void* d_out, int out_size, void* d_ws, size_t ws_size, hipStream_t stream) {
    static int grid = 0;
    if (grid == 0) {
        if (n_in != 21 || in_sizes[0] != T * D || out_size != T * D || ws_size < WS_END) { fprintf(stderr, "kernel_launch: unexpected shapes (n_in %d, in0 %d, out %d, ws %zu); nothing launched\n", n_in, n_in > 0 ? in_sizes[0] : -1, out_size, ws_size); grid = -1; return; }
        int dev = 0, cus = 0, per_cu = 0;
        if (hipGetDevice(&dev) != hipSuccess || hipDeviceGetAttribute(&cus, hipDeviceAttributeMultiprocessorCount, dev) != hipSuccess) { grid = -1; return; }
        if (hipFuncSetAttribute((const void*)fwd, hipFuncAttributeMaxDynamicSharedMemorySize, LDS_BYTES) != hipSuccess) { fprintf(stderr, "kernel_launch: hipFuncSetAttribute failed\n"); grid = -1; return; }
        if (hipOccupancyMaxActiveBlocksPerMultiprocessor(&per_cu, (const void*)fwd, NTHREADS, LDS_BYTES) != hipSuccess || per_cu < 1) fprintf(stderr, "kernel_launch: occupancy query reports %d workgroups per CU\n", per_cu);
        (void)hipGetLastError();
        grid = cus;
    }
    if (grid < 0) return;
    if (hipMemsetAsync((char*)d_ws + WS_CTL, 0, CTL_ZERO_BYTES, stream) != hipSuccess) { fprintf(stderr, "kernel_launch: hipMemsetAsync failed\n"); return; }
    Args a{};
    for (int i = 0; i < 21; ++i) a.in[i] = (const float*)d_in[i];
    a.out = (float*)d_out; a.ws = (unsigned char*)d_ws;
#if MK_ONE_LAUNCH
    a.ph_lo = 0; a.ph_hi = NPH; a.li = 0;
    hipLaunchKernelGGL(fwd, dim3(grid), dim3(NTHREADS), LDS_BYTES, stream, a);
#else
    for (int p = 0; p < NPH; ++p) { a.ph_lo = p; a.ph_hi = p + 1; a.li = p; hipLaunchKernelGGL(fwd, dim3(grid), dim3(NTHREADS), LDS_BYTES, stream, a); }
#endif
    const hipError_t le = hipPeekAtLastError();
    if (le != hipSuccess) fprintf(stderr, "kernel_launch: launch failed: %s\n", hipGetErrorName(le));
}
```

```cpp
#include <hip/hip_runtime.h>
#include <cstdio>
#include <cstdint>
namespace pg8 {
#define PG8_LAS __attribute__((address_space(3)))
typedef unsigned short bf16_t;
typedef short bf16x8 __attribute__((ext_vector_type(8)));
typedef float f32x4 __attribute__((ext_vector_type(4)));
typedef unsigned u32x4 __attribute__((ext_vector_type(4)));
constexpr int BM = 256, BK = 64, HALF = 128, HTB = HALF * BK * 2  , STAGE_BYTES = 8 * HTB, NXCD = 8, WGM = 8;

__host__ __device__ __forceinline__ int lds_byte(int r, int c) { const int st = (r >> 4) * 2 + (c >> 5), rr = r & 15, cc = c & 31, ob = rr * 64 + cc * 2; return st * 1024 + (ob ^ (((ob >> 9) & 1) << 5)); }
__host__ __device__ __forceinline__ void stage_rc(int b, int& R, int& C) { const int st = b / 1024, sb = b % 1024, swz = sb ^ (((sb >> 9) & 1) << 5); R = (st >> 1) * 16 + swz / 64; C = (st & 1) * 32 + (swz % 64) / 2; }
__host__ __device__ __forceinline__ int perm32(int rho) { const int n = rho >> 4, i = rho & 15; return 8 * (i >> 2) + 4 * n + (i & 3); }

struct Unit { int pm, pn; };
struct Gemm { const bf16_t* A; const bf16_t* Bt; int M, N, K; };

struct StaticOrder {
    int nM, nN, nwg, G, c;
    __host__ __device__ void init(int M, int N, int G_, int c_) { nM = M / BM; nN = N / BM; nwg = nM * nN; G = G_; c = c_; }
    __host__ __device__ bool next(int i, Unit& u) const {
        const long L = (long)i * G + c; if (L >= nwg) return false;
        int wgid = (int)L; { const int q = nwg / NXCD, r = nwg % NXCD, xcd = wgid % NXCD, off = wgid / NXCD; wgid = (xcd < r ? xcd * (q + 1) : r * (q + 1) + (xcd - r) * q) + off; }
        const int nig = WGM * nN, gid = wgid / nig, fm = gid * WGM, gsz = (nM - fm) < WGM ? (nM - fm) : WGM;
        u.pm = fm + ((wgid % nig) % gsz); u.pn = (wgid % nig) / gsz; return true;
    }
    __device__ __forceinline__ void a_ready(const Unit&) const {}
    __device__ __forceinline__ void done(const Unit&) const {}
};

__device__ __forceinline__ unsigned cvt_pk_bf16(float lo, float hi) { unsigned r; asm volatile("v_cvt_pk_bf16_f32 %0, %1, %2" : "=v"(r) : "v"(lo), "v"(hi)); return r; }
typedef float f32x2 __attribute__((ext_vector_type(2)));
__device__ __forceinline__ f32x2 gelu_pk(f32x2 v) {
    const f32x2 av = __builtin_elementwise_abs(v), d = av * 0.2316418882f + 1.0f;
    f32x2 t; t.x = __builtin_amdgcn_rcpf(d.x); t.y = __builtin_amdgcn_rcpf(d.y);
    f32x2 q = t * 0.5307027145f + (-0.7265760135f); q = q * t + 0.7107068705f; q = q * t + (-0.142248368f); q = q * t + 0.127414796f; q = q * t;
    const f32x2 s = (v * v) * (-0.72134752044f);
    f32x2 e; e.x = __builtin_amdgcn_exp2f(s.x); e.y = __builtin_amdgcn_exp2f(s.y);
    const f32x2 m = v * (q * e), r = v - m;
    f32x2 o; o.x = v.x < 0.f ? m.x : r.x; o.y = v.y < 0.f ? m.y : r.y; return o;
}

template <int ACT  > struct EpiBf16 {
    static constexpr bool PERM = true, AFTER_DRAIN = false; static_assert(ACT == 0 || ACT == 1, "EpiBf16: ACT is 0 (none) or 1 (gelu_pk)");
    bf16_t* O; int ldc; const float* bias; int split_cols; size_t split_stride; float scale0;
    __device__ __forceinline__ void operator()(const f32x4 (&acc)[2][2][4][2], const Unit& u, int wr, int wc, int fr, int fq) const {
        const int row0 = u.pm * BM + wr * 64 + fr; int colt = u.pn * BM; bf16_t* base = O;
        float sc = 1.f; if (split_cols) { const int t = colt / split_cols; base += (size_t)t * split_stride; colt -= t * split_cols; if (t == 0) sc = scale0; }
        const int col0 = colt + wc * 32 + 8 * fq, bcol0 = u.pn * BM + wc * 32 + 8 * fq;
        f32x4 bv[2][2];
#pragma unroll
        for (int bj = 0; bj < 2; ++bj)
#pragma unroll
            for (int n = 0; n < 2; ++n) bv[bj][n] = bias ? *(const f32x4*)(bias + bcol0 + bj * HALF + 4 * n) : (f32x4){0.f, 0.f, 0.f, 0.f};
#pragma unroll
        for (int ai = 0; ai < 2; ++ai)
#pragma unroll
            for (int m = 0; m < 4; ++m) { bf16_t* rowp = base + (size_t)(row0 + ai * HALF + m * 16) * ldc + col0;
#pragma unroll
                for (int bj = 0; bj < 2; ++bj) { f32x4 v0 = acc[ai][bj][m][0] + bv[bj][0], v1 = acc[ai][bj][m][1] + bv[bj][1];
                    if (ACT == 1) { f32x2 a = gelu_pk((f32x2){v0[0], v0[1]}), b = gelu_pk((f32x2){v0[2], v0[3]}), c = gelu_pk((f32x2){v1[0], v1[1]}), d = gelu_pk((f32x2){v1[2], v1[3]});
                        v0 = (f32x4){a.x, a.y, b.x, b.y}; v1 = (f32x4){c.x, c.y, d.x, d.y}; }
                    v0 = v0 * sc; v1 = v1 * sc; u32x4 w; w.x = cvt_pk_bf16(v0[0], v0[1]); w.y = cvt_pk_bf16(v0[2], v0[3]); w.z = cvt_pk_bf16(v1[0], v1[1]); w.w = cvt_pk_bf16(v1[2], v1[3]);
                    *(u32x4*)(rowp + bj * HALF) = w; } }
    }
};
typedef int i32x4 __attribute__((ext_vector_type(4)));
__device__ __forceinline__ float sigmoid_f(float x) { return __builtin_amdgcn_rcpf(1.0f + __expf(-x)); }
__device__ __forceinline__ float gelu_tanh_f(float x) { const float t = 1.5957691216057308f * (x + 0.044715f * x * x * x); return x * sigmoid_f(t); }
struct EpiMixIn {
    static constexpr bool PERM = true, AFTER_DRAIN = false;
    bf16_t* aglu; bf16_t* ug; bf16_t* vg;
    __device__ __forceinline__ void operator()(const f32x4 (&acc)[2][2][4][2], const Unit& u, int wr, int wc, int fr, int fq) const {
        const int row0 = u.pm * BM + wr * 64 + fr;
        if (u.pn < 4) {
            const int col0 = u.pn * 128 + wc * 32 + 8 * fq;
#pragma unroll
            for (int ai = 0; ai < 2; ++ai)
#pragma unroll
                for (int m = 0; m < 4; ++m) {
                    const f32x4 v0 = acc[ai][0][m][0], v1 = acc[ai][0][m][1], g0 = acc[ai][1][m][0], g1 = acc[ai][1][m][1];
                    u32x4 w;
                    w.x = cvt_pk_bf16(v0[0] * sigmoid_f(g0[0]), v0[1] * sigmoid_f(g0[1])); w.y = cvt_pk_bf16(v0[2] * sigmoid_f(g0[2]), v0[3] * sigmoid_f(g0[3]));
                    w.z = cvt_pk_bf16(v1[0] * sigmoid_f(g1[0]), v1[1] * sigmoid_f(g1[1])); w.w = cvt_pk_bf16(v1[2] * sigmoid_f(g1[2]), v1[3] * sigmoid_f(g1[3]));
                    *(u32x4*)(aglu + (size_t)(row0 + ai * HALF + m * 16) * 512 + col0) = w;
                }
        } else {
            bf16_t* dst = (u.pn < 6) ? ug : vg; const int col0 = (u.pn & 1) * 256 + wc * 32 + 8 * fq;
#pragma unroll
            for (int ai = 0; ai < 2; ++ai)
#pragma unroll
                for (int m = 0; m < 4; ++m)
#pragma unroll
                    for (int bj = 0; bj < 2; ++bj) {
                        const f32x4 v0 = acc[ai][bj][m][0], v1 = acc[ai][bj][m][1];
                        u32x4 w;
                        w.x = cvt_pk_bf16(gelu_tanh_f(v0[0]), gelu_tanh_f(v0[1])); w.y = cvt_pk_bf16(gelu_tanh_f(v0[2]), gelu_tanh_f(v0[3]));
                        w.z = cvt_pk_bf16(gelu_tanh_f(v1[0]), gelu_tanh_f(v1[1])); w.w = cvt_pk_bf16(gelu_tanh_f(v1[2]), gelu_tanh_f(v1[3]));
                        *(u32x4*)(dst + (size_t)(row0 + ai * HALF + m * 16) * 512 + col0 + bj * HALF) = w;
                    }
        }
    }
};
struct EpiRes {
    static constexpr bool PERM = false, AFTER_DRAIN = false;
    const float* base; float* out; int ldc;
    __device__ __forceinline__ void operator()(const f32x4 (&acc)[2][2][4][2], const Unit& u, int wr, int wc, int fr, int fq) const {
        const int col0 = u.pn * BM + wc * 32 + 4 * fq;
#pragma unroll
        for (int ai = 0; ai < 2; ++ai)
#pragma unroll
            for (int m = 0; m < 4; ++m) { const size_t off = (size_t)(u.pm * BM + ai * HALF + wr * 64 + m * 16 + fr) * ldc + col0;
#pragma unroll
                for (int bj = 0; bj < 2; ++bj)
#pragma unroll
                    for (int n = 0; n < 2; ++n) { const f32x4 bs = *(const f32x4*)(base + off + bj * HALF + n * 16); *(f32x4*)(out + off + bj * HALF + n * 16) = bs + acc[ai][bj][m][n]; } }
    }
};

struct EpiQKV {
    static constexpr bool PERM = true, AFTER_DRAIN = false;
    bf16_t* Q; size_t split_stride; const float* ssq; float* kmf; float qscale, eps;
    __device__ __forceinline__ void operator()(const f32x4 (&acc)[2][2][4][2], const Unit& u, int wr, int wc, int fr, int fq) const {
        const int row0 = u.pm * BM + wr * 64 + fr; const int tsel = u.pn >> 2, colt = (u.pn & 3) * 256;
        bf16_t* base = Q + (size_t)tsel * split_stride; const int col0 = colt + wc * 32 + 8 * fq;
        const float sc = tsel == 0 ? qscale : 1.f;
        f32x4 cs[2][2];
#pragma unroll
        for (int bj = 0; bj < 2; ++bj) { cs[bj][0] = (f32x4){0.f, 0.f, 0.f, 0.f}; cs[bj][1] = (f32x4){0.f, 0.f, 0.f, 0.f}; }
#pragma unroll
        for (int ai = 0; ai < 2; ++ai)
#pragma unroll
            for (int m = 0; m < 4; ++m) { const int row = row0 + ai * HALF + m * 16; const float rs = rsqrtf(ssq[row] * (1.0f / 1024.0f) + eps) * sc;
#pragma unroll
                for (int bj = 0; bj < 2; ++bj) { const f32x4 v0 = acc[ai][bj][m][0] * rs, v1 = acc[ai][bj][m][1] * rs; cs[bj][0] += v0; cs[bj][1] += v1;
                    u32x4 w; w.x = cvt_pk_bf16(v0[0], v0[1]); w.y = cvt_pk_bf16(v0[2], v0[3]); w.z = cvt_pk_bf16(v1[0], v1[1]); w.w = cvt_pk_bf16(v1[2], v1[3]);
                    *(u32x4*)(base + (size_t)row * 1024 + col0 + bj * HALF) = w; } }
        if (tsel == 1) {
#pragma unroll
            for (int bj = 0; bj < 2; ++bj)
#pragma unroll
                for (int n = 0; n < 2; ++n)
#pragma unroll
                    for (int e = 0; e < 4; ++e) { float v = cs[bj][n][e];
                        v += __builtin_bit_cast(float, __builtin_amdgcn_update_dpp(0, __builtin_bit_cast(int, v), 0xB1, 0xf, 0xf, true)); v += __builtin_bit_cast(float, __builtin_amdgcn_update_dpp(0, __builtin_bit_cast(int, v), 0x4E, 0xf, 0xf, true));
                        v += __builtin_bit_cast(float, __builtin_amdgcn_update_dpp(0, __builtin_bit_cast(int, v), 0x141, 0xf, 0xf, true)); v += __builtin_bit_cast(float, __builtin_amdgcn_update_dpp(0, __builtin_bit_cast(int, v), 0x128, 0xf, 0xf, true));
                        if (fr == 0) atomicAdd(kmf + (size_t)u.pm * 1024 + col0 + bj * HALF + 4 * n + e, v * (1.0f / 256.0f)); }
        }
    }
};

template <class Inner> struct EpiI8 {
    static constexpr bool PERM = true, AFTER_DRAIN = false; static_assert(Inner::PERM, "EpiI8 wraps PERM epilogues");
    Inner E; const float* sa; const float* sb;
    __device__ __forceinline__ void operator()(const f32x4 (&acc)[2][2][4][2], const Unit& u, int wr, int wc, int fr, int fq) const {
        const int cb0 = u.pn * BM + wc * 32 + 8 * fq, row0 = u.pm * BM + wr * 64 + fr;
        f32x4 sbv[2][2];
#pragma unroll
        for (int bj = 0; bj < 2; ++bj)
#pragma unroll
            for (int n = 0; n < 2; ++n) sbv[bj][n] = *(const f32x4*)(sb + cb0 + bj * HALF + 4 * n);
        f32x4 cv[2][2][4][2];
#pragma unroll
        for (int ai = 0; ai < 2; ++ai)
#pragma unroll
            for (int m = 0; m < 4; ++m) { const float ra = sa[row0 + ai * HALF + m * 16];
#pragma unroll
                for (int bj = 0; bj < 2; ++bj)
#pragma unroll
                    for (int n = 0; n < 2; ++n) { const i32x4 iv = __builtin_bit_cast(i32x4, acc[ai][bj][m][n]);
                        cv[ai][bj][m][n] = (f32x4){(float)iv[0], (float)iv[1], (float)iv[2], (float)iv[3]} * ra * sbv[bj][n]; } }
        E(cv, u, wr, wc, fr, fq);
    }
};

template <bool BF> struct EpiResB {
    static constexpr bool PERM = false, AFTER_DRAIN = false;
    const float* basef; const bf16_t* baseb; bf16_t* outb; int ldc;
    __device__ __forceinline__ void operator()(const f32x4 (&acc)[2][2][4][2], const Unit& u, int wr, int wc, int fr, int fq) const {
        typedef unsigned u32x2 __attribute__((ext_vector_type(2)));
        const int col0 = u.pn * BM + wc * 32 + 4 * fq;
#pragma unroll
        for (int ai = 0; ai < 2; ++ai)
#pragma unroll
            for (int m = 0; m < 4; ++m) { const size_t off = (size_t)(u.pm * BM + ai * HALF + wr * 64 + m * 16 + fr) * ldc + col0;
#pragma unroll
                for (int bj = 0; bj < 2; ++bj)
#pragma unroll
                    for (int n = 0; n < 2; ++n) { const size_t o = off + bj * HALF + n * 16; f32x4 bs;
                        if (BF) { const u32x2 w = *(const u32x2*)(baseb + o); bs = (f32x4){__builtin_bit_cast(float, w.x << 16), __builtin_bit_cast(float, w.x & 0xffff0000u), __builtin_bit_cast(float, w.y << 16), __builtin_bit_cast(float, w.y & 0xffff0000u)}; }
                        else bs = *(const f32x4*)(basef + o);
                        const f32x4 v = bs + acc[ai][bj][m][n]; u32x2 wv; wv.x = cvt_pk_bf16(v[0], v[1]); wv.y = cvt_pk_bf16(v[2], v[3]); *(u32x2*)(outb + o) = wv; } }
    }
};

struct EpiQKVM {
    static constexpr bool PERM = true, AFTER_DRAIN = false;
    EpiBf16<0> B; float* kmp; int ntm;
    __device__ __forceinline__ void operator()(const f32x4 (&acc)[2][2][4][2], const Unit& u, int wr, int wc, int fr, int fq) const {
        B(acc, u, wr, wc, fr, fq);
        if (u.pn >= 4 && u.pn < 8) {
            float* dst = kmp + ((size_t)wr * ntm + u.pm) * 1024 + (u.pn - 4) * BM + wc * 32 + 8 * fq;
#pragma unroll
            for (int bj = 0; bj < 2; ++bj)
#pragma unroll
                for (int n = 0; n < 2; ++n) { f32x4 cs = (acc[0][bj][0][n] + acc[0][bj][1][n]) + (acc[0][bj][2][n] + acc[0][bj][3][n]) + ((acc[1][bj][0][n] + acc[1][bj][1][n]) + (acc[1][bj][2][n] + acc[1][bj][3][n]));
#pragma unroll
                    for (int e = 0; e < 4; ++e) { float v = cs[e];
                        v += __builtin_bit_cast(float, __builtin_amdgcn_update_dpp(0, __builtin_bit_cast(int, v), 0xB1, 0xf, 0xf, true)); v += __builtin_bit_cast(float, __builtin_amdgcn_update_dpp(0, __builtin_bit_cast(int, v), 0x4E, 0xf, 0xf, true));
                        v += __builtin_bit_cast(float, __builtin_amdgcn_update_dpp(0, __builtin_bit_cast(int, v), 0x141, 0xf, 0xf, true)); v += __builtin_bit_cast(float, __builtin_amdgcn_update_dpp(0, __builtin_bit_cast(int, v), 0x128, 0xf, 0xf, true));
                        cs[e] = v * (1.0f / 256.0f); }
                    if (fr == 0) *(f32x4*)(dst + bj * HALF + 4 * n) = cs; }
        }
    }
};

template <bool KM> struct EpiI8Bf16 {
    static constexpr bool PERM = true, AFTER_DRAIN = false;
    bf16_t* O; int ldc; int split_cols; size_t split_stride; float scale0; const float* sa; const float* sb; float* kmp; int ntm;
    __device__ __forceinline__ void operator()(const f32x4 (&acc)[2][2][4][2], const Unit& u, int wr, int wc, int fr, int fq) const {
        const int row0 = u.pm * BM + wr * 64 + fr; int colt = u.pn * BM, tsel = 0; bf16_t* base = O; float sc = 1.f;
        if (split_cols) { tsel = colt / split_cols; base += (size_t)tsel * split_stride; colt -= tsel * split_cols; if (tsel == 0) sc = scale0; }
        const int col0 = colt + wc * 32 + 8 * fq, cb0 = u.pn * BM + wc * 32 + 8 * fq;
        f32x4 sbv[2][2], cs[2][2];
#pragma unroll
        for (int bj = 0; bj < 2; ++bj)
#pragma unroll
            for (int n = 0; n < 2; ++n) { sbv[bj][n] = *(const f32x4*)(sb + cb0 + bj * HALF + 4 * n) * sc; cs[bj][n] = (f32x4){0.f, 0.f, 0.f, 0.f}; }
#pragma unroll
        for (int ai = 0; ai < 2; ++ai)
#pragma unroll
            for (int m = 0; m < 4; ++m) { const int row = row0 + ai * HALF + m * 16; const float ra = sa[row]; bf16_t* rowp = base + (size_t)row * ldc + col0;
#pragma unroll
                for (int bj = 0; bj < 2; ++bj) { const i32x4 i0 = __builtin_bit_cast(i32x4, acc[ai][bj][m][0]), i1 = __builtin_bit_cast(i32x4, acc[ai][bj][m][1]);
                    const f32x4 v0 = (f32x4){(float)i0[0], (float)i0[1], (float)i0[2], (float)i0[3]} * ra * sbv[bj][0], v1 = (f32x4){(float)i1[0], (float)i1[1], (float)i1[2], (float)i1[3]} * ra * sbv[bj][1];
                    if (KM) { cs[bj][0] += v0; cs[bj][1] += v1; }
                    u32x4 w; w.x = cvt_pk_bf16(v0[0], v0[1]); w.y = cvt_pk_bf16(v0[2], v0[3]); w.z = cvt_pk_bf16(v1[0], v1[1]); w.w = cvt_pk_bf16(v1[2], v1[3]);
                    *(u32x4*)(rowp + bj * HALF) = w; } }
        if (KM && tsel == 1) {
            float* dst = kmp + ((size_t)wr * ntm + u.pm) * 1024 + colt + wc * 32 + 8 * fq;
#pragma unroll
            for (int bj = 0; bj < 2; ++bj)
#pragma unroll
                for (int n = 0; n < 2; ++n) { f32x4 c = cs[bj][n];
#pragma unroll
                    for (int e = 0; e < 4; ++e) { float v = c[e];
                        v += __builtin_bit_cast(float, __builtin_amdgcn_update_dpp(0, __builtin_bit_cast(int, v), 0xB1, 0xf, 0xf, true)); v += __builtin_bit_cast(float, __builtin_amdgcn_update_dpp(0, __builtin_bit_cast(int, v), 0x4E, 0xf, 0xf, true));
                        v += __builtin_bit_cast(float, __builtin_amdgcn_update_dpp(0, __builtin_bit_cast(int, v), 0x141, 0xf, 0xf, true)); v += __builtin_bit_cast(float, __builtin_amdgcn_update_dpp(0, __builtin_bit_cast(int, v), 0x128, 0xf, 0xf, true));
                        c[e] = v * (1.0f / 256.0f); }
                    if (fr == 0) *(f32x4*)(dst + bj * HALF + 4 * n) = c; }
        }
    }
};
template <bool I8> __device__ __forceinline__ f32x4 mma_step(const bf16x8& b, const bf16x8& a, const f32x4& c) {
    if constexpr (I8) return __builtin_bit_cast(f32x4, __builtin_amdgcn_mfma_i32_16x16x64_i8(__builtin_bit_cast(i32x4, b), __builtin_bit_cast(i32x4, a), __builtin_bit_cast(i32x4, c), 0, 0, 0));
    else return __builtin_amdgcn_mfma_f32_16x16x32_bf16(b, a, c, 0, 0, 0);
}
template <class Epi, class Sched, bool ALIGN_EPI = false, bool SP2 = false, bool I8 = false>
__device__ __forceinline__ void gemm_phase(PG8_LAS unsigned char* lds, const Gemm g, const Sched& S, const Epi& E) {
    const int tid = threadIdx.x, wid = __builtin_amdgcn_readfirstlane(tid >> 6), lane = tid & 63, wr = wid >> 2, wc = wid & 3, fr = lane & 15, fq = lane >> 4;
    const int K = g.K, nt = K / BK;
    unsigned voffA[2], voffB[2];
#pragma unroll
    for (int i = 0; i < 2; ++i) { int R, C; stage_rc(tid * 16 + i * 8192, R, C); const int Rb = Epi::PERM ? ((R & ~31) + perm32(R & 31)) : R;
        voffA[i] = (unsigned)(R * K + C) * 2u; voffB[i] = (unsigned)(Rb * K + C) * 2u; }
    const size_t kstep = (size_t)(BK * 2);
    const size_t hstep = (size_t)HALF * K * 2;
    const size_t tstep = 2 * hstep;
    const unsigned ldsw = (unsigned)wid * 1024u;
    const int aoff = lds_byte(wr * 64 + fr, fq * 8), boff = lds_byte(wc * 32 + fr, fq * 8);
#define PG8_SA(b, h) (((b) * 2 + (h)) * HTB)
#define PG8_SB(b, h) ((4 + (b) * 2 + (h)) * HTB)
#define PG8_STAGE(bufoff, gbase, voff) do { _Pragma("unroll") for (int _i = 0; _i < 2; ++_i) \
        __builtin_amdgcn_global_load_lds((const unsigned*)((const char*)(gbase) + (voff)[_i]), (PG8_LAS unsigned*)(lds + (bufoff) + ldsw + _i * 8192), 16, 0, 0); } while (0)
#define PG8_LDA(dst, b, h) do { _Pragma("unroll") for (int m = 0; m < 4; ++m) _Pragma("unroll") for (int k = 0; k < 2; ++k) dst[m][k] = *(const PG8_LAS bf16x8*)(lds + PG8_SA(b, h) + aoff + m * 2048 + k * 1024); } while (0)
#define PG8_LDB(dst, b, h) do { _Pragma("unroll") for (int n = 0; n < 2; ++n) _Pragma("unroll") for (int k = 0; k < 2; ++k) dst[n][k] = *(const PG8_LAS bf16x8*)(lds + PG8_SB(b, h) + boff + n * 2048 + k * 1024); } while (0)
#define PG8_MMA(ai, bj, At, Bt) do { __builtin_amdgcn_s_setprio(1); _Pragma("unroll") for (int m = 0; m < 4; ++m) _Pragma("unroll") for (int n = 0; n < 2; ++n) _Pragma("unroll") for (int k = 0; k < 2; ++k) \
        acc[ai][bj][m][n] = mma_step<I8>(Bt[n][k], At[m][k], acc[ai][bj][m][n]); __builtin_amdgcn_s_setprio(0); } while (0)
#define PG8_WAIT_V(n) asm volatile("s_waitcnt vmcnt(" #n ")" ::: "memory")
#define PG8_WAIT_L(n) asm volatile("s_waitcnt lgkmcnt(" #n ")" ::: "memory")
#define PG8_BAR __builtin_amdgcn_s_barrier()
#define PG8_SCHED __builtin_amdgcn_sched_barrier(0)
    Unit cur, nxt; int ui = 0;
    if (!S.next(0, cur)) return;
    f32x4 acc[2][2][4][2];
#pragma unroll
    for (int a = 0; a < 2; ++a)
#pragma unroll
        for (int b = 0; b < 2; ++b)
#pragma unroll
            for (int m = 0; m < 4; ++m)
#pragma unroll
                for (int n = 0; n < 2; ++n) acc[a][b][m][n] = (f32x4){0.f, 0.f, 0.f, 0.f};
    bf16x8 At[4][2], B0[2][2], B1[2][2];
    const char* cA = (const char*)g.A + (size_t)cur.pm * tstep; const char* cB = (const char*)g.Bt + (size_t)cur.pn * tstep;
    S.a_ready(cur);
    if constexpr (SP2) {
        PG8_STAGE(PG8_SB(0, 0), cB, voffB); PG8_STAGE(PG8_SB(0, 1), cB + hstep, voffB); PG8_STAGE(PG8_SA(0, 0), cA, voffA); PG8_STAGE(PG8_SA(0, 1), cA + hstep, voffA);
        if (wr == 1) PG8_BAR;
        PG8_WAIT_V(2); PG8_BAR;
        PG8_STAGE(PG8_SB(1, 0), cB + kstep, voffB); PG8_STAGE(PG8_SA(1, 0), cA + kstep, voffA); PG8_STAGE(PG8_SB(1, 1), cB + hstep + kstep, voffB);
        PG8_WAIT_V(6); PG8_BAR;
    } else {
        PG8_STAGE(PG8_SB(0, 0), cB, voffB); PG8_STAGE(PG8_SA(0, 0), cA, voffA); PG8_STAGE(PG8_SB(0, 1), cB + hstep, voffB); PG8_STAGE(PG8_SA(0, 1), cA + hstep, voffA);
        if (wr == 1) PG8_BAR;
        PG8_WAIT_V(4); PG8_BAR;
        PG8_STAGE(PG8_SB(1, 0), cB + kstep, voffB); PG8_STAGE(PG8_SA(1, 0), cA + kstep, voffA); PG8_STAGE(PG8_SB(1, 1), cB + hstep + kstep, voffB);
        PG8_WAIT_V(6); PG8_BAR;
    }
    for (;;) {
        const bool has_next = S.next(ui + 1, nxt);
        const char* nA = has_next ? (const char*)g.A + (size_t)nxt.pm * tstep : cA; const char* nB = has_next ? (const char*)g.Bt + (size_t)nxt.pn * tstep : cB;
        for (int t = 0; t < nt; t += 2) {
            const bool last = (t == nt - 2);
            const char* a1 = cA + (size_t)(t + 1) * kstep;
            const char* a2 = last ? nA : cA + (size_t)(t + 2) * kstep; const char* b2 = last ? nB : cB + (size_t)(t + 2) * kstep;
            const char* a3 = a2 + kstep; const char* b3 = b2 + kstep;
            if (last && has_next) S.a_ready(nxt);
            if constexpr (SP2) {
            PG8_LDB(B0, 0, 0); PG8_LDB(B1, 0, 1); PG8_SCHED; PG8_LDA(At, 0, 0); PG8_STAGE(PG8_SA(1, 1), a1 + hstep, voffA);
            PG8_WAIT_V(8); PG8_WAIT_L(0); PG8_BAR; PG8_MMA(0, 0, At, B0); PG8_MMA(0, 1, At, B1); PG8_BAR; PG8_SCHED;
            PG8_LDA(At, 0, 1); PG8_STAGE(PG8_SB(0, 0), b2, voffB); PG8_STAGE(PG8_SB(0, 1), b2 + hstep, voffB); PG8_STAGE(PG8_SA(0, 0), a2, voffA);
            PG8_WAIT_V(8); PG8_WAIT_L(0); PG8_BAR; PG8_MMA(1, 0, At, B0); PG8_MMA(1, 1, At, B1); PG8_BAR; PG8_SCHED;
            PG8_LDB(B0, 1, 0); PG8_LDB(B1, 1, 1); PG8_SCHED; PG8_LDA(At, 1, 0); PG8_STAGE(PG8_SA(0, 1), a2 + hstep, voffA);
            PG8_WAIT_V(8); PG8_WAIT_L(0); PG8_BAR; PG8_MMA(0, 0, At, B0); PG8_MMA(0, 1, At, B1); PG8_BAR; PG8_SCHED;
            PG8_LDA(At, 1, 1); PG8_STAGE(PG8_SB(1, 0), b3, voffB); PG8_STAGE(PG8_SB(1, 1), b3 + hstep, voffB); PG8_STAGE(PG8_SA(1, 0), a3, voffA);
            PG8_WAIT_V(8); PG8_WAIT_L(0); PG8_BAR; PG8_MMA(1, 0, At, B0); PG8_MMA(1, 1, At, B1); PG8_BAR; PG8_SCHED;
            } else {
            PG8_LDB(B0, 0, 0); PG8_SCHED; PG8_LDA(At, 0, 0); PG8_STAGE(PG8_SA(1, 1), a1 + hstep, voffA);
            PG8_WAIT_L(8); PG8_BAR; PG8_WAIT_L(0); PG8_MMA(0, 0, At, B0); PG8_BAR; PG8_SCHED;
            PG8_LDB(B1, 0, 1); PG8_STAGE(PG8_SB(0, 0), b2, voffB);
            PG8_BAR; PG8_WAIT_L(0); PG8_MMA(0, 1, At, B1); PG8_BAR;
            PG8_LDA(At, 0, 1); PG8_STAGE(PG8_SA(0, 0), a2, voffA);
            PG8_BAR; PG8_WAIT_L(0); PG8_MMA(1, 0, At, B0); PG8_BAR; PG8_SCHED;
            PG8_STAGE(PG8_SB(0, 1), b2 + hstep, voffB);
            PG8_WAIT_V(6); PG8_BAR; PG8_MMA(1, 1, At, B1); PG8_BAR;
            PG8_LDB(B0, 1, 0); PG8_SCHED; PG8_LDA(At, 1, 0); PG8_STAGE(PG8_SA(0, 1), a2 + hstep, voffA);
            PG8_WAIT_L(8); PG8_BAR; PG8_WAIT_L(0); PG8_MMA(0, 0, At, B0); PG8_BAR; PG8_SCHED;
            PG8_LDB(B1, 1, 1); PG8_STAGE(PG8_SB(1, 0), b3, voffB);
            PG8_BAR; PG8_WAIT_L(0); PG8_MMA(0, 1, At, B1); PG8_BAR;
            PG8_LDA(At, 1, 1); PG8_STAGE(PG8_SA(1, 0), a3, voffA);
            PG8_BAR; PG8_WAIT_L(0); PG8_MMA(1, 0, At, B0); PG8_BAR; PG8_SCHED;
            PG8_STAGE(PG8_SB(1, 1), b3 + hstep, voffB);
            PG8_WAIT_V(6); PG8_BAR; PG8_MMA(1, 1, At, B1); PG8_BAR;
            }
        }
        if constexpr (ALIGN_EPI) { if (wr == 0) PG8_BAR; }
        if constexpr (!Epi::AFTER_DRAIN) { E(acc, cur, wr, wc, fr, fq); S.done(cur); }
        if (!has_next) break;
#pragma unroll
        for (int a = 0; a < 2; ++a)
#pragma unroll
            for (int b = 0; b < 2; ++b)
#pragma unroll
                for (int m = 0; m < 4; ++m)
#pragma unroll
                    for (int n = 0; n < 2; ++n) acc[a][b][m][n] = (f32x4){0.f, 0.f, 0.f, 0.f};
        cur = nxt; cA = nA; cB = nB; ++ui;
        if constexpr (ALIGN_EPI) { if (wr == 1) PG8_BAR; }
    }
    PG8_WAIT_V(0);
    if constexpr (!ALIGN_EPI) { if (wr == 0) PG8_BAR; }
    PG8_BAR;
    if constexpr (Epi::AFTER_DRAIN) { E.fused(acc, cur, wr, wc, fr, fq, lds, wid, lane); S.done(cur); }
#undef PG8_SA
#undef PG8_SB
#undef PG8_STAGE
#undef PG8_LDA
#undef PG8_LDB
#undef PG8_MMA
#undef PG8_WAIT_V
#undef PG8_WAIT_L
#undef PG8_BAR
#undef PG8_SCHED
}
}
#include <hip/hip_bf16.h>
#include <cmath>
namespace attn_body {
using bf16=__hip_bfloat16;
using bf16x8=__attribute__((ext_vector_type(8)))short;
using s16x4=__attribute__((ext_vector_type(4)))short;
using f32x16=__attribute__((ext_vector_type(16)))float;
using u32x4=__attribute__((ext_vector_type(4)))unsigned;
using f32x4_t=__attribute__((ext_vector_type(4)))float;
constexpr int BATCH=8,NHEAD=16,SEQ=4096,D=64,DM=NHEAD*D;
constexpr int NW=8,QBLK=32,QB=QBLK*NW,KVBLK=64,NQB=SEQ/QB;
constexpr int ATTN_PITCH=DM, ATTN_UNIT_ROWS=QB;
__device__ __forceinline__ int crow(int r,int hi){return (r&3)+8*(r>>2)+4*hi;}
#define SBAR() __builtin_amdgcn_sched_barrier(0)
__device__ __forceinline__ void cmask(f32x16&p0,f32x16&p1,int jb,int qrel,int hi){
  const float NEG=-INFINITY; int kb=64*jb+4*hi;
  #pragma unroll
  for(int r=0;r<16;++r){int kv=kb+(r&3)+8*(r>>2); if(kv>qrel)p0[r]=NEG; if(kv+32>qrel)p1[r]=NEG;}
}

constexpr int NSLOT=3, SLOTB=8192;
constexpr int LDS_K=0, LDS_V=NSLOT*SLOTB, LDS_WS=2*NSLOT*SLOTB, LDS_OST=LDS_WS+NW*64*4, LDS_LUTB=LDS_OST+NW*4096, LUTL_OFF=256, LUTL_N=SEQ+LUTL_OFF, LUTC_N=2048, LUTC_STRIDE=LUTC_N*4+64, LDS_LUTC=LDS_LUTB+LUTL_N*4+64, LDS_BYTES=LDS_LUTC+3*LUTC_STRIDE;
constexpr float C2=0.125f*1.4426950408889634f; constexpr int GLUT_OFF=256, GLUT_N=SEQ+GLUT_OFF;
__device__ __forceinline__ void glds16(const void*gsrc,unsigned lds_dst){unsigned keep;
  asm volatile("s_mov_b32 %0, m0\n\ts_mov_b32 m0, %2\n\ts_nop 0\n\tglobal_load_lds_dwordx4 %1, off\n\ts_mov_b32 m0, %0":"=&s"(keep):"v"(gsrc),"s"(lds_dst):"memory");}
__device__ __forceinline__ float max3f(float a,float b,float c){float r;asm("v_max3_f32 %0, %1, %2, %3":"=v"(r):"v"(a),"v"(b),"v"(c));return r;}
__device__ __forceinline__ float max2f(float a,float b){float r;asm("v_max_f32_e32 %0, %1, %2":"=v"(r):"v"(a),"v"(b));return r;}
__device__ __forceinline__ float fadd_s(float a,float b){float r;asm("v_add_f32_e32 %0, %1, %2":"=v"(r):"v"(a),"v"(b));return r;}
__device__ __forceinline__ float fsub_s(float a,float b){float r;asm("v_sub_f32_e32 %0, %1, %2":"=v"(r):"v"(a),"v"(b));return r;}
typedef float f32x2_t __attribute__((ext_vector_type(2))); typedef __bf16 bf16x2_t __attribute__((ext_vector_type(2)));
__device__ __forceinline__ unsigned cvtpk_s(float lo,float hi){f32x2_t v={lo,hi};bf16x2_t b=__builtin_convertvector(v,bf16x2_t);return __builtin_bit_cast(unsigned,b);}
#define WAIT_BAR(N) asm volatile("s_waitcnt vmcnt(" #N ") lgkmcnt(0)\n\ts_barrier":::"memory")

__device__ __forceinline__ void qkt(f32x16&p0,f32x16&p1,const char*Kslot,const bf16x8*qr,int r32,int hi){
  const char*kb=Kslot+hi*1024+r32*16;
  #pragma unroll
  for(int d0=0;d0<4;++d0){
    const bf16x8 b0=*reinterpret_cast<const bf16x8*>(kb+d0*2048);
    const bf16x8 b1=*reinterpret_cast<const bf16x8*>(kb+d0*2048+512);
    {p0=__builtin_amdgcn_mfma_f32_32x32x16_bf16(b0,qr[d0],p0,0,0,0);p1=__builtin_amdgcn_mfma_f32_32x32x16_bf16(b1,qr[d0],p1,0,0,0);}}
}
typedef __attribute__((address_space(3))) const char* lds_cptr; typedef __attribute__((address_space(3))) float* lds_fptr;
typedef short v4i16_t __attribute__((ext_vector_type(4)));
__device__ __forceinline__ void kload8(bf16x8*kf,lds_cptr kp){
  kf[0]=*(const __attribute__((address_space(3))) bf16x8*)(kp);      kf[1]=*(const __attribute__((address_space(3))) bf16x8*)(kp+512);
  kf[2]=*(const __attribute__((address_space(3))) bf16x8*)(kp+2048); kf[3]=*(const __attribute__((address_space(3))) bf16x8*)(kp+2560);
  kf[4]=*(const __attribute__((address_space(3))) bf16x8*)(kp+4096); kf[5]=*(const __attribute__((address_space(3))) bf16x8*)(kp+4608);
  kf[6]=*(const __attribute__((address_space(3))) bf16x8*)(kp+6144); kf[7]=*(const __attribute__((address_space(3))) bf16x8*)(kp+6656);
}
__device__ __forceinline__ void kload2(bf16x8*kf,lds_cptr kp,int j){ kf[2*j]=*(const __attribute__((address_space(3))) bf16x8*)(kp+j*2048); kf[2*j+1]=*(const __attribute__((address_space(3))) bf16x8*)(kp+j*2048+512); }
__device__ __forceinline__ s16x4 vtr(lds_cptr p){ return __builtin_bit_cast(s16x4,__builtin_amdgcn_ds_read_tr16_b64_v4i16((__attribute__((address_space(3))) v4i16_t*)p)); }
__device__ __forceinline__ float rowmax(const f32x16&p0,const f32x16&p1){
  float a=max3f(p0[0],p0[1],p1[0]),b=max3f(p0[2],p0[3],p1[1]);a=max3f(a,p1[2],p1[3]);
  #pragma unroll
  for(int r=4;r<16;r+=4){a=max3f(a,p0[r],p0[r+1]);b=max3f(b,p0[r+2],p0[r+3]);a=max3f(a,p1[r],p1[r+1]);b=max3f(b,p1[r+2],p1[r+3]);}
  const float m=max2f(a,b);
  auto rr=__builtin_amdgcn_permlane32_swap(__float_as_uint(m),__float_as_uint(m),false,false);
  return max2f(__uint_as_float(rr[0]),__uint_as_float(rr[1]));
}
__device__ __forceinline__ void pv(f32x16*o,int vb,bf16x8 pa0,bf16x8 pa1,bf16x8 pa2,bf16x8 pa3){
  #pragma unroll
  for(int d0=0;d0<2;++d0){s16x4 lo[4],hi[4];
    #pragma unroll
    for(int ks=0;ks<4;++ks){
      asm volatile("ds_read_b64_tr_b16 %0,%1 offset:%c2":"=&v"(lo[ks]):"v"(vb),"i"(d0*4096+ks*1024):"memory");
      asm volatile("ds_read_b64_tr_b16 %0,%1 offset:%c2":"=&v"(hi[ks]):"v"(vb),"i"(d0*4096+ks*1024+512):"memory");}
    asm volatile("s_waitcnt lgkmcnt(0)":::"memory");SBAR();
    #define PK(k) (bf16x8){lo[k][0],lo[k][1],lo[k][2],lo[k][3],hi[k][0],hi[k][1],hi[k][2],hi[k][3]}
    o[d0]=__builtin_amdgcn_mfma_f32_32x32x16_bf16(pa0,PK(0),o[d0],0,0,0);
    o[d0]=__builtin_amdgcn_mfma_f32_32x32x16_bf16(pa1,PK(1),o[d0],0,0,0);
    o[d0]=__builtin_amdgcn_mfma_f32_32x32x16_bf16(pa2,PK(2),o[d0],0,0,0);
    o[d0]=__builtin_amdgcn_mfma_f32_32x32x16_bf16(pa3,PK(3),o[d0],0,0,0);
    #undef PK
  }
}

#ifndef ATTN_STORE16
#define ATTN_STORE16(p,v) (*(u32x4*)(p)=(v))
#endif
template<int THRL,int PLAIN=0> __device__ __forceinline__ void attn_unit(int b,int h,int qb,const bf16*Q,const bf16*K,const bf16*V,bf16*O,const float*KM,const float*GLUT,char*shm,bool newhead){
  int tid_=threadIdx.x; asm volatile("":"+v"(tid_));
  const int tid=tid_,lane=tid&63,r32=lane&31,hi=lane>>5; const int wid=__builtin_amdgcn_readfirstlane(tid>>6);
  const long rowbase=(long)b*SEQ; const int q0=qb*QB;
  const bf16*Qw=Q+(rowbase+q0+wid*QBLK)*DM+h*D;
  const bf16*Kh=K+rowbase*DM+h*D,*Vh=V+rowbase*DM+h*D;
  const unsigned lds0=(unsigned)(uintptr_t)shm; const lds_cptr shm3=(lds_cptr)shm;
  float*wsf=(float*)(shm+LDS_WS)+wid*64;
  const bf16*ksrc=Kh+(long)lane*DM+wid*8;
  const bf16*vsrc=Vh+(long)(16*(wid&3)+(lane>>2))*DM+(wid>>2)*32+(lane&3)*8;
  const unsigned kdst=lds0+LDS_K+wid*1024, vdst=lds0+LDS_V+wid*1024;
  #define DMA_K(t,slot) glds16(ksrc+(long)(t)*KVBLK*DM,(unsigned)__builtin_amdgcn_readfirstlane(kdst+(slot)))
  #define DMA_V(t,slot) glds16(vsrc+(long)(t)*KVBLK*DM,(unsigned)__builtin_amdgcn_readfirstlane(vdst+(slot)))
  const int vb0=(int)(lds0+LDS_V)+((lane>>4)&1)*32+(lane&3)*8+(4*hi+((lane&15)>>2))*64;
  const char*Kbase=shm+LDS_K; bf16x8 kf[8];
  const lds_cptr kp0=shm3+LDS_K+hi*1024+r32*16; const lds_cptr vp0=shm3+LDS_V+((lane>>4)&1)*32+(lane&3)*8+(4*hi+((lane&15)>>2))*64;
  const int NT=(q0+QB)/KVBLK;
  if(newhead){ lds_fptr lutw=(lds_fptr)(shm3+LDS_LUTB); const float*gl=GLUT+(long)h*GLUT_N+(GLUT_OFF-LUTL_OFF);
    for(int i=tid;i<LUTL_N;i+=NW*64){ const int n=i-LUTL_OFF>0?i-LUTL_OFF:0; int bk=n;
        if(n>=16){ bk=16+(n>=22)+(n>=30)+(n>=40)+(n>=54)+(n>=73)+(n>=99)+(n>=134)+(n>=182)+(n>=246)+(n>=332)+(n>=450)+(n>=609)+(n>=825)+(n>=1117)+(n>=1513); }
        const float w_=__uint_as_float((__float_as_uint(gl[i]*1.4426950408889634f)&~31u)|(unsigned)bk); lutw[i]=w_;
        #pragma unroll
        for(int c_=1;c_<4;++c_){ const int ic_=i-c_; if(ic_>=0&&ic_<LUTC_N) ((lds_fptr)(shm3+LDS_LUTC+(c_-1)*LUTC_STRIDE))[ic_]=w_; } } }
  DMA_K(0,0);DMA_V(0,0);DMA_K(1,SLOTB);
  bf16x8 qr[4];
  #pragma unroll
  for(int d0=0;d0<4;++d0)qr[d0]=*reinterpret_cast<const bf16x8*>(&Qw[(long)r32*DM+d0*16+hi*8]);
  unsigned selmask=0u;
  if(qb>0){ f32x16 g=f32x16{};
    #pragma unroll
    for(int d0=0;d0<4;++d0){ const float*kp_=KM+((long)b*16+(r32&15))*DM+h*D+d0*16+hi*8; const f32x4_t ka_=*reinterpret_cast<const f32x4_t*>(kp_)+*reinterpret_cast<const f32x4_t*>(kp_+BATCH*16*DM),kb_=*reinterpret_cast<const f32x4_t*>(kp_+4)+*reinterpret_cast<const f32x4_t*>(kp_+4+BATCH*16*DM);     const u32x4 kw_={cvtpk_s(ka_[0],ka_[1]),cvtpk_s(ka_[2],ka_[3]),cvtpk_s(kb_[0],kb_[1]),cvtpk_s(kb_[2],kb_[3])}; const bf16x8 kmf=__builtin_bit_cast(bf16x8,kw_); g=__builtin_amdgcn_mfma_f32_32x32x16_bf16(kmf,qr[d0],g,0,0,0); }
    float G[16];
    #pragma unroll
    for(int i=0;i<4;++i){ const float o0=__shfl_xor(g[i],32),o1=__shfl_xor(g[4+i],32); G[i]=hi?o0:g[i]; G[4+i]=hi?g[i]:o0; G[8+i]=hi?o1:g[4+i]; G[12+i]=hi?g[4+i]:o1; }
    float m1_=-INFINITY,m2_=-INFINITY,m3_=-INFINITY;
    #pragma unroll
    for(int i=0;i<15;++i){ const float t0_=(i<qb)?G[i]:-INFINITY; G[i]=t0_; const float t1_=__builtin_fminf(m1_,t0_); m1_=__builtin_fmaxf(m1_,t0_); const float t2_=__builtin_fminf(m2_,t1_); m2_=__builtin_fmaxf(m2_,t1_); m3_=__builtin_fmaxf(m3_,t2_); }
    unsigned gt_=0u,ge_=0u;
    #pragma unroll
    for(int j=14;j>=0;--j){ gt_=gt_+gt_+(unsigned)(G[j]>m3_); ge_=ge_+ge_+(unsigned)(G[j]>=m3_); }
    { const unsigned eq_=ge_^gt_; const int need_=3-__builtin_popcount(gt_);
      const unsigned e1_=eq_&(0u-eq_), r1_=eq_^e1_, e2_=r1_&(0u-r1_), r2_=r1_^e2_, e3_=r2_&(0u-r2_);
      selmask=(gt_|e1_|(need_>=2?e2_:0u)|(need_>=3?e3_:0u))&((1u<<qb)-1u); } }
  const lds_fptr lutu=(lds_fptr)(shm3+LDS_LUTB)+(LUTL_OFF+q0+wid*QBLK);
  typedef __attribute__((address_space(3))) const f32x4_t* lds_f4ptr;
  const int lc_=(r32+1)&3;
  const lds_fptr lutq4=(lds_fptr)(shm3+(lc_==0?LDS_LUTB:LDS_LUTC+(lc_-1)*LUTC_STRIDE))+(LUTL_OFF-3+q0+wid*QBLK+r32-4*hi-lc_);
  const lds_fptr lutq=(lds_fptr)(shm3+LDS_LUTB)+(LUTL_OFF-59+q0+wid*QBLK+r32-4*hi);
  float mhat=0.f,l_reg=0.f;f32x16 o[2];o[0]=f32x16{};o[1]=f32x16{};
  const int qrel=wid*QBLK+r32;
  #define CMASK(P0,P1,t) do{int jb_=(t)-(NT-4); if(jb_>=0)cmask(P0,P1,jb_,qrel,hi);}while(0)
  #define BIAS(P0,P1,t) do{ if(PLAIN==1){ _Pragma("unroll") for(int r_=0;r_<16;++r_){ P0[r_]=-mhat; P1[r_]=-mhat; } SBAR(); } else { \
      const bool keep_=((t)>=NT-4)||((selmask>>((t)>>2))&1u); const float mh_=keep_?mhat:INFINITY; \
      const lds_fptr lu_=lutu-64*(t); const unsigned umax_=__builtin_amdgcn_readfirstlane(__float_as_uint(lu_[31])), umin_=__builtin_amdgcn_readfirstlane(__float_as_uint(lu_[-63])); \
      if(PLAIN!=3&&(PLAIN==2||((umax_^umin_)&31u)==0u)){ const float cv_=__uint_as_float(umax_)-mh_; _Pragma("unroll") for(int r_=0;r_<16;++r_){ P0[r_]=cv_; P1[r_]=cv_; } } \
      else { const lds_fptr lp_=lutq4-64*(t); _Pragma("unroll") for(int g_=0;g_<4;++g_){ \
        const f32x4_t b0_=*(lds_f4ptr)(lp_-8*g_), b1_=*(lds_f4ptr)(lp_-8*g_-32); \
        _Pragma("unroll") for(int k_=0;k_<4;++k_){ P0[4*g_+k_]=b0_[3-k_]-mh_; P1[4*g_+k_]=b1_[3-k_]-mh_; } } } SBAR(); } }while(0)
  #define MMASK(P0,P1,t) do{}while(0)
  bool resc=false;
  #define START(P0,P1) do{ const float rm=rowmax(P0,P1); resc=false; \
    { const float dl=max2f(rm,-64.f); mhat=fadd_s(mhat,dl); \
      _Pragma("unroll") for(int r=0;r<16;++r){P0[r]=fsub_s(P0[r],dl);P1[r]=fsub_s(P1[r],dl);} \
      } \
    _Pragma("unroll") for(int r=0;r<16;++r)P0[r]=__builtin_amdgcn_exp2f(P0[r]); }while(0)
  #define RESC() do{ if(resc){ asm volatile("s_waitcnt lgkmcnt(0)":::"memory"); \
      _Pragma("unroll") for(int d_=0;d_<2;++d_) _Pragma("unroll") for(int r=0;r<16;++r)o[d_][r]*=wsf[crow(r,hi)]; } }while(0)
  f32x16 pA0,pA1,pB0,pB1;
  int sl_prev=0,sl_cur=0,sl_next=SLOTB;
  #define ROT() do{sl_prev=sl_cur;sl_cur=sl_next;sl_next=(sl_next==(NSLOT-1)*SLOTB)?0:sl_next+SLOTB;}while(0)
  DMA_K(2,2*SLOTB);
  WAIT_BAR(3);
  BIAS(pA0,pA1,0);qkt(pA0,pA1,Kbase,qr,r32,hi);asm volatile("s_nop 15\n\ts_nop 7":"+v"(pA0),"+v"(pA1));if(NT>4){MMASK(pA0,pA1,0);}CMASK(pA0,pA1,0);
  START(pA0,pA1);
  _Pragma("unroll") for(int r=0;r<16;++r)pA1[r]=__builtin_amdgcn_exp2f(pA1[r]);
  WAIT_BAR(0);
  DMA_K(3,0);DMA_V(1,SLOTB);
  ROT();
  kload8(kf,kp0+sl_cur);
  WAIT_BAR(2);
  s16x4 vlo[8],vhi[8]; u32x4 pw0,pw1,pw2,pw3;
  #define PKW(P,B) cvtpk_s(P[B],P[B+1])
  #define PAF(k) __builtin_bit_cast(bf16x8,pw##k)
  #define VFR(i) (bf16x8){vlo[i][0],vlo[i][1],vlo[i][2],vlo[i][3],vhi[i][0],vhi[i][1],vhi[i][2],vhi[i][3]}
  #define PIN(x) asm volatile("":"+v"(x))
  #define MX3(a,b,c) __builtin_fmaxf(__builtin_fmaxf((a),(b)),(c))
  #define GAPA(MF,A0,A1,A2,A3,W0,W1,PW) do{ MF; sacc+=A0; sacc+=A1; sacc+=A2; sacc+=A3; PIN(sacc); W0; W1; PIN(PW); SBAR(); }while(0)
  #define EX(v) __builtin_amdgcn_exp2f(v)
  #define GAPB(MF,X,B) do{ MF; X[B]=EX(X[B]); X[B+1]=EX(X[B+1]); X[B+2]=EX(X[B+2]); X[B+3]=EX(X[B+3]); PIN(X); SBAR(); }while(0)
  #define VRD(i) do{ vlo[i]=vtr(vp_+(((i)>>2)*4096+((i)&3)*1024)); vhi[i]=vtr(vp_+(((i)>>2)*4096+((i)&3)*1024+512)); }while(0)
  #define KRD(G,j) do{ if(G){ kload2(kf,kp0+sl_next,j); SBAR(); } }while(0)
  #define STEP(C0,C1,P0,P1,t,GK,GV,GL) do{ SBAR(); BIAS(C0,C1,t); \
    const lds_cptr vp_=vp0+sl_prev; \
    VRD(0); SBAR(); float sacc=(P0[0]+P0[1]); \
    GAPA(C0=__builtin_amdgcn_mfma_f32_32x32x16_bf16(kf[0],qr[0],C0,0,0,0), P0[2],P0[3],P0[4],P0[5],     pw0[0]=PKW(P0,0), pw0[1]=PKW(P0,2), pw0); \
    VRD(4); SBAR(); GAPA(C1=__builtin_amdgcn_mfma_f32_32x32x16_bf16(kf[1],qr[0],C1,0,0,0), P0[6],P0[7],P0[8],P0[9],     pw0[2]=PKW(P0,4), pw0[3]=PKW(P0,6), pw0); \
    VRD(1); SBAR(); GAPA(C0=__builtin_amdgcn_mfma_f32_32x32x16_bf16(kf[2],qr[1],C0,0,0,0),   P0[10],P0[11],P0[12],P0[13], pw1[0]=PKW(P0,8), pw1[1]=PKW(P0,10), pw1); \
    VRD(5); SBAR(); GAPA(C1=__builtin_amdgcn_mfma_f32_32x32x16_bf16(kf[3],qr[1],C1,0,0,0),   P0[14],P0[15],P1[0],P1[1],   pw1[2]=PKW(P0,12),pw1[3]=PKW(P0,14), pw1); \
    VRD(2); SBAR(); GAPA(C0=__builtin_amdgcn_mfma_f32_32x32x16_bf16(kf[4],qr[2],C0,0,0,0),   P1[2],P1[3],P1[4],P1[5],     pw2[0]=PKW(P1,0), pw2[1]=PKW(P1,2), pw2); \
    VRD(6); SBAR(); GAPA(C1=__builtin_amdgcn_mfma_f32_32x32x16_bf16(kf[5],qr[2],C1,0,0,0),   P1[6],P1[7],P1[8],P1[9],     pw2[2]=PKW(P1,4), pw2[3]=PKW(P1,6), pw2); \
    VRD(3); SBAR(); GAPA(C0=__builtin_amdgcn_mfma_f32_32x32x16_bf16(kf[6],qr[3],C0,0,0,0),   P1[10],P1[11],P1[12],P1[13], pw3[0]=PKW(P1,8), pw3[1]=PKW(P1,10), pw3); \
    VRD(7); SBAR(); GAPA(C1=__builtin_amdgcn_mfma_f32_32x32x16_bf16(kf[7],qr[3],C1,0,0,0),   P1[14],P1[15],0.f,0.f,       pw3[2]=PKW(P1,12),pw3[3]=PKW(P1,14), pw3); \
    l_reg+=sacc; \
    if(GK){DMA_K((t)+3,sl_cur);} if(GV){DMA_V((t)+1,sl_next);} \
    MMASK(C0,C1,t); CMASK(C0,C1,t); \
    { float a=MX3(C0[0],C0[1],C1[0]),b=MX3(C0[2],C0[3],C1[1]); a=MX3(a,C1[2],C1[3]); \
      _Pragma("unroll") for(int r=4;r<16;r+=4){a=MX3(a,C0[r],C0[r+1]);b=MX3(b,C0[r+2],C0[r+3]);a=MX3(a,C1[r],C1[r+1]);b=MX3(b,C1[r+2],C1[r+3]);} \
      float rm=__builtin_fmaxf(a,b); { auto rr=__builtin_amdgcn_permlane32_swap(__float_as_uint(rm),__float_as_uint(rm),false,false); rm=__builtin_fmaxf(__uint_as_float(rr[0]),__uint_as_float(rr[1])); } \
      resc=false; \
      if(__builtin_expect(__any(rm>(float)THRL),0)){ const float dl=__builtin_fmaxf(rm,0.f); mhat+=dl; \
        _Pragma("unroll") for(int r=0;r<16;++r){C0[r]-=dl;C1[r]-=dl;} \
        const float f=__builtin_amdgcn_exp2f(-dl); l_reg*=f; if(hi==0)wsf[r32]=f; resc=true; } } \
    SBAR(); \
    GAPB(o[0]=__builtin_amdgcn_mfma_f32_32x32x16_bf16(PAF(0),VFR(0),o[0],0,0,0), C0,0); \
    GAPB(o[1]=__builtin_amdgcn_mfma_f32_32x32x16_bf16(PAF(0),VFR(4),o[1],0,0,0), C0,4); \
    KRD(GL,0); GAPB(o[0]=__builtin_amdgcn_mfma_f32_32x32x16_bf16(PAF(1),VFR(1),o[0],0,0,0), C0,8); \
    KRD(GL,1); GAPB(o[1]=__builtin_amdgcn_mfma_f32_32x32x16_bf16(PAF(1),VFR(5),o[1],0,0,0), C0,12); \
    KRD(GL,2); GAPB(o[0]=__builtin_amdgcn_mfma_f32_32x32x16_bf16(PAF(2),VFR(2),o[0],0,0,0), C1,0); \
    KRD(GL,3); GAPB(o[1]=__builtin_amdgcn_mfma_f32_32x32x16_bf16(PAF(2),VFR(6),o[1],0,0,0), C1,4); \
    GAPB(o[0]=__builtin_amdgcn_mfma_f32_32x32x16_bf16(PAF(3),VFR(3),o[0],0,0,0), C1,8); \
    GAPB(o[1]=__builtin_amdgcn_mfma_f32_32x32x16_bf16(PAF(3),VFR(7),o[1],0,0,0), C1,12); \
    }while(0)
  int t=1;
  #undef CMASK
  #define CMASK(P0,P1,t) do{}while(0)
  for(;t+5<NT;t+=2){
    STEP(pB0,pB1,pA0,pA1,t,true,true,true);     WAIT_BAR(2); RESC(); ROT();
    STEP(pA0,pA1,pB0,pB1,t+1,true,true,true);   WAIT_BAR(2); RESC(); ROT();
  }
  #undef CMASK
  #define CMASK(P0,P1,t) do{int jb_=(t)-(NT-4); if(jb_>=0)cmask(P0,P1,jb_,qrel,hi);}while(0)
  #define ENDW(tt) do{ if((tt)+3<NT){WAIT_BAR(2);} else if((tt)+2<NT){WAIT_BAR(1);} else {WAIT_BAR(0);} }while(0)
  for(;t+1<NT;t+=2){
    STEP(pB0,pB1,pA0,pA1,t,(t+3<NT),(t+1<NT),(t+1<NT));       ENDW(t);   RESC(); ROT();
    STEP(pA0,pA1,pB0,pB1,t+1,(t+4<NT),(t+2<NT),(t+2<NT));     ENDW(t+1); RESC(); ROT();
  }
  STEP(pB0,pB1,pA0,pA1,NT-1,false,false,false); RESC();
  { float sacc=pB0[0]+pB0[1]; _Pragma("unroll") for(int r=2;r<16;++r)sacc+=pB0[r]; _Pragma("unroll") for(int r=0;r<16;++r)sacc+=pB1[r]; l_reg+=sacc;
    pw0=(u32x4){PKW(pB0,0),PKW(pB0,2),PKW(pB0,4),PKW(pB0,6)};pw1=(u32x4){PKW(pB0,8),PKW(pB0,10),PKW(pB0,12),PKW(pB0,14)};pw2=(u32x4){PKW(pB1,0),PKW(pB1,2),PKW(pB1,4),PKW(pB1,6)};pw3=(u32x4){PKW(pB1,8),PKW(pB1,10),PKW(pB1,12),PKW(pB1,14)};
    SBAR(); pv(o,vb0+sl_cur,PAF(0),PAF(1),PAF(2),PAF(3)); }
  #undef PKW
  #undef PAF
  #undef VFR
  #undef PIN
  #undef MX3
  #undef GAPA
  #undef GAPB
  #undef EX
  #undef VRD
  #undef KRD
  #undef STEP
  #undef ENDW
  {auto rr=__builtin_amdgcn_permlane32_swap(__float_as_uint(l_reg),__float_as_uint(l_reg),false,false);l_reg=__uint_as_float(rr[0])+__uint_as_float(rr[1]);}
  if(hi==0)wsf[32+r32]=l_reg;asm volatile("s_waitcnt lgkmcnt(0)":::"memory");
  float rli[16];
  #pragma unroll
  for(int r=0;r<16;++r)rli[r]=__builtin_amdgcn_rcpf(wsf[32+crow(r,hi)]);
  bf16*Ow=O+(rowbase+q0+wid*QBLK)*DM+h*D;
  { bf16*stg=(bf16*)(shm+LDS_OST)+wid*2048;
    #pragma unroll
    for(int r=0;r<16;++r){const int orow=crow(r,hi);
      #pragma unroll
      for(int d0=0;d0<2;++d0)stg[orow*64+d0*32+r32]=__float2bfloat16(o[d0][r]*rli[r]);}
    asm volatile("s_waitcnt lgkmcnt(0)":::"memory");
    #pragma unroll
    for(int i=0;i<4;++i){const int row=i*8+(lane>>3),ch=lane&7; const u32x4 v=*(const u32x4*)(stg+row*64+ch*8); ATTN_STORE16(Ow+(long)row*DM+ch*8,v);} }
  asm volatile("s_waitcnt lgkmcnt(0)\n\ts_barrier":::"memory");
  #undef DMA_K
  #undef DMA_V
  #undef CMASK
  #undef BIAS
  #undef MMASK
  #undef START
  #undef RESC
  #undef ROT
}
constexpr int ATTN_LDS_BYTES=LDS_BYTES;
struct AttnTensors { const bf16* Q; const bf16* K; const bf16* V; bf16* O; const float* KM; const float* GLUT; };
struct AttnUnit { int bh; int qb; };
struct StaticOrder {
  int vcu,G;
  __device__ __forceinline__ explicit StaticOrder(int grid,int block):vcu((grid%8==0)?(block%8)*(grid/8)+block/8:block),G(grid){}
  __device__ __forceinline__ bool next(int i,AttnUnit&u)const{
    if(G==256){ if(i>=8)return false; const int s=vcu&1; u.bh=vcu>>1; const int k=i>>1; u.qb=(i&1)?(4*k+3-s):(4*k+s); return true; }
    const int L=i*G+vcu; if(L>=BATCH*NHEAD*NQB)return false; u.bh=L/NQB; u.qb=L%NQB; return true; }
  __device__ __forceinline__ void a_ready(const AttnUnit&)const{}
  __device__ __forceinline__ void done(const AttnUnit&)const{}
};
template<class Sched,int THRL=8,int PLAIN=0> __device__ __forceinline__ void attn_phase(char*lds,const AttnTensors&T,const Sched&S){
  AttnUnit u;
  int lasth=-1;
  for(int i=0;S.next(i,u);++i){ S.a_ready(u); const int hh=u.bh%NHEAD; attn_unit<THRL,PLAIN>(u.bh/NHEAD,hh,u.qb,T.Q,T.K,T.V,T.O,T.KM,T.GLUT,lds,hh!=lasth); lasth=hh; S.done(u); }
}
#undef SBAR
#undef WAIT_BAR
}
constexpr int NWAVES = 8, NTHREADS = 512;
constexpr int BATCH = 8, SEQ = 4096, D = 1024, T = BATCH * SEQ;
constexpr int A_CH = 512, CONV_W = 31, B_HEADS = 8, B_CH = 512, SGU_CHUNK = 128, MIX_IN = 2048;
constexpr int MH = 16, MHD = 64, MBLK = 256, NBLK = SEQ / MBLK, MTOPK = 3;
constexpr int PH = 8, PNK = 128, PNE = PNK * PNK, PDK = 256, PTOPK = 16, PSEL = PH * PTOPK;
constexpr float EPS = 1e-6f;
constexpr int LUT_OFF = 256, LUT_N = SEQ + LUT_OFF;

constexpr size_t MiB = 1u << 20;
constexpr size_t WS_CTL = 0, CTL_ZERO_BYTES = 1 * MiB;
constexpr size_t WS_WIN = 1 * MiB, WS_WOUT = 5 * MiB, WS_WQKV = 7 * MiB, WS_WO = 13 * MiB, WS_WQ = 15 * MiB  , WS_SK = 23 * MiB  ;
constexpr size_t WS_WSC = 24 * MiB + 896 * 1024  ;
constexpr size_t WS_SGW = 24 * MiB  , WS_LUT = 24 * MiB + 512 * 1024  , WS_KMEAN = 25 * MiB  , WS_SSQ = 25 * MiB + 512 * 1024  ;
constexpr size_t WS_PU = 32 * MiB  , WS_PV = 64 * MiB  , WS_PSU = 96 * MiB  , WS_PSV = 96 * MiB + 256 * 1024;
constexpr size_t WS_HN = 128 * MiB;
constexpr size_t WS_HA = 160 * MiB;
constexpr size_t WS_R4 = 224 * MiB;
constexpr size_t WS_AGLU = WS_R4, WS_UG = WS_R4 + 32 * MiB, WS_VG = WS_R4 + 64 * MiB, WS_CAT = WS_R4 + 96 * MiB;
constexpr size_t WS_Q = WS_R4, WS_K = WS_R4 + 64 * MiB, WS_V = WS_R4 + 128 * MiB;
constexpr size_t WS_QP = WS_R4;
constexpr size_t WS_PART = WS_R4;
constexpr size_t WS_CB = WS_R4 + 160 * MiB;
constexpr size_t WS_IDX = 416 * MiB, WS_GATE = 432 * MiB, WS_HQ = 448 * MiB  , WS_HQS = 480 * MiB  , WS_SUK = 481 * MiB  , WS_END = 497 * MiB;
constexpr int CW_TMO = 0, CW_BAR = 4096, CW_CMAX = 65536  ;

constexpr int RING_BYTES = 131072, LDSCTL_OFF = RING_BYTES, MISC_OFF = LDSCTL_OFF + 320, LDS_BYTES = 147456;

#define GAS __attribute__((address_space(1)))
#define LAS __attribute__((address_space(3)))
typedef unsigned short bf16;
typedef unsigned v4u __attribute__((ext_vector_type(4)));
typedef unsigned v2u __attribute__((ext_vector_type(2)));
typedef float f32x4 __attribute__((ext_vector_type(4)));
typedef float f32x2 __attribute__((ext_vector_type(2)));
typedef short bf16x8 __attribute__((ext_vector_type(8)));
typedef GAS unsigned gu32;
typedef GAS unsigned long long gu64;
#define RLX_AGENT __ATOMIC_RELAXED, __HIP_MEMORY_SCOPE_AGENT
#define LDS_WAIT() asm volatile("s_waitcnt lgkmcnt(0)" ::: "memory")
#define VM_WAIT() asm volatile("s_waitcnt vmcnt(0)" ::: "memory")
__device__ __forceinline__ unsigned f2bf(float f) { unsigned u = __builtin_bit_cast(unsigned, f); return (u + 0x7fffu + ((u >> 16) & 1u)) >> 16; }
__device__ __forceinline__ unsigned pk2(float lo, float hi) { return f2bf(lo) | (f2bf(hi) << 16); }
__device__ __forceinline__ float bf_lo(unsigned w) { return __builtin_bit_cast(float, w << 16); }
__device__ __forceinline__ float bf_hi(unsigned w) { return __builtin_bit_cast(float, w & 0xffff0000u); }
__device__ __forceinline__ float bf2f(bf16 h) { return __builtin_bit_cast(float, (unsigned)h << 16); }

__device__ __forceinline__ float gelu_tanh(float x) { const float t = 1.5957691216057308f * (x + 0.044715f * x * x * x); return x / (1.0f + __expf(-t)); }
template <int CTRL> __device__ __forceinline__ int dpp_i(int x) { return __builtin_amdgcn_update_dpp(0, x, CTRL, 0xf, 0xf, true); }
template <int CTRL> __device__ __forceinline__ float dpp_f(float x) { return __builtin_bit_cast(float, __builtin_amdgcn_update_dpp(0, __builtin_bit_cast(int, x), CTRL, 0xf, 0xf, true)); }
constexpr int DPP_XOR1 = 0xB1, DPP_XOR2 = 0x4E, DPP_HMIRROR = 0x141, DPP_ROR8 = 0x128;
__device__ __forceinline__ float wave_sum(float v) {
    v += dpp_f<DPP_XOR1>(v); v += dpp_f<DPP_XOR2>(v); v += dpp_f<DPP_HMIRROR>(v); v += dpp_f<DPP_ROR8>(v);
    { const unsigned u = __builtin_bit_cast(unsigned, v); const auto r = __builtin_amdgcn_permlane16_swap(u, u, false, false); v = __builtin_bit_cast(float, (unsigned)r[0]) + __builtin_bit_cast(float, (unsigned)r[1]); }
    { const unsigned u = __builtin_bit_cast(unsigned, v); const auto r = __builtin_amdgcn_permlane32_swap(u, u, false, false); v = __builtin_bit_cast(float, (unsigned)r[0]) + __builtin_bit_cast(float, (unsigned)r[1]); }
    return v;
}
__device__ __forceinline__ float wave_max(float m) {
    m = fmaxf(m, dpp_f<DPP_XOR1>(m)); m = fmaxf(m, dpp_f<DPP_XOR2>(m)); m = fmaxf(m, dpp_f<DPP_HMIRROR>(m)); m = fmaxf(m, dpp_f<DPP_ROR8>(m));
    { const unsigned u = __builtin_bit_cast(unsigned, m); const auto r = __builtin_amdgcn_permlane16_swap(u, u, false, false); m = fmaxf(__builtin_bit_cast(float, (unsigned)r[0]), __builtin_bit_cast(float, (unsigned)r[1])); }
    { const unsigned u = __builtin_bit_cast(unsigned, m); const auto r = __builtin_amdgcn_permlane32_swap(u, u, false, false); m = fmaxf(__builtin_bit_cast(float, (unsigned)r[0]), __builtin_bit_cast(float, (unsigned)r[1])); }
    return m;
}
#define XB_TMO      128
#define XB_XCNT(j)  (256  + 64 * (j))
#define XB_XSUB(j)  (1280 + 64 * (j))
#define XB_XGEN(j)  (2304 + 64 * (j))
#define XB_TOP      3328
#define XB_TOPGEN   3392
#define XCD_BAR_WORDS 3456
#define XB_SPIN_CAP (1u << 18)

__device__ __forceinline__ unsigned xb_ld(unsigned* p)              { return __hip_atomic_load(p, __ATOMIC_RELAXED, __HIP_MEMORY_SCOPE_AGENT); }
__device__ __forceinline__ unsigned xb_add(unsigned* p, unsigned v) { return __hip_atomic_fetch_add(p, v, __ATOMIC_RELAXED, __HIP_MEMORY_SCOPE_AGENT); }
__device__ __forceinline__ unsigned xb_xcc_id() { return (unsigned)__builtin_amdgcn_s_getreg((3 << 11) | 20) & 0xFu; }
#define XB_SPIN(cond, bar) do { unsigned _sp = 0; while (cond) { __builtin_amdgcn_s_sleep(1); \
    if ((++_sp & 255u) == 0u) { if (xb_ld(&(bar)[XB_TMO])) break; if (_sp > XB_SPIN_CAP) { atomicAdd(&(bar)[XB_TMO], 1u); break; } } } } while (0)

struct XcdBarrier {
    unsigned* bar; unsigned x;
    volatile LAS unsigned* st;
};

__device__ __forceinline__ XcdBarrier xcd_barrier_post(unsigned* bar, volatile LAS unsigned* st) {
    XcdBarrier b; b.bar = bar; b.x = xb_xcc_id(); b.st = st;
    if (threadIdx.x == 0) (void)xb_add(&bar[XB_XCNT(b.x)], 1u);
    return b;
}
__device__ __forceinline__ void xcd_barrier_complete(unsigned* bar, unsigned x, unsigned& nloc, unsigned& nx) {
    const unsigned G = gridDim.x * gridDim.y * gridDim.z;
    unsigned sum, cnt, mine, sp = 0u;
    for (;;) {
        sum = 0u; cnt = 0u; mine = 0u;
#pragma unroll
        for (unsigned j = 0; j < 16; ++j) { const unsigned c = xb_ld(&bar[XB_XCNT(j)]); sum += c; cnt += (c > 0u) ? 1u : 0u; mine = (j == x) ? c : mine; }
        if (sum == G) break;
        __builtin_amdgcn_s_sleep(1);
        if ((++sp & 255u) == 0u) { if (xb_ld(&bar[XB_TMO])) break; if (sp > XB_SPIN_CAP) { atomicAdd(&bar[XB_TMO], 1u); break; } }
    }
    nloc = mine > 0u ? mine : 1u; nx = cnt > 0u ? cnt : 1u;
}

__device__ __forceinline__ void xcd_barrier(const XcdBarrier& b) {
    asm volatile("s_waitcnt vmcnt(0)" ::: "memory");
    __syncthreads();
    if (threadIdx.x == 0) {
        unsigned* bar = b.bar;
        __builtin_amdgcn_s_waitcnt(0);
        unsigned nloc = b.st[0], nx = b.st[1];
        if (nloc == 0u) { xcd_barrier_complete(bar, b.x, nloc, nx); b.st[0] = nloc; b.st[1] = nx; }
        const unsigned old = xb_add(&bar[XB_XSUB(b.x)], 1u);
        const unsigned gen = old / nloc;
        if (old + 1u == (gen + 1u) * nloc) {
            __builtin_amdgcn_fence(__ATOMIC_RELEASE, "agent");
            asm volatile("s_waitcnt vmcnt(0)" ::: "memory");
            const unsigned og = xb_add(&bar[XB_TOP], 1u);
            const unsigned tg = og / nx;
            if (og + 1u == (tg + 1u) * nx) xb_add(&bar[XB_TOPGEN], 1u);
            else XB_SPIN(xb_ld(&bar[XB_TOPGEN]) == tg, bar);
            __builtin_amdgcn_fence(__ATOMIC_ACQUIRE, "agent");
            xb_add(&bar[XB_XGEN(b.x)], 1u);
            asm volatile("s_waitcnt vmcnt(0)" ::: "memory");
        } else {
            XB_SPIN(xb_ld(&bar[XB_XGEN(b.x)]) == gen, bar);
            __builtin_amdgcn_fence(__ATOMIC_ACQUIRE, "agent");
            asm volatile("s_waitcnt vmcnt(0)" ::: "memory");
        }
    }
    __syncthreads();
}
struct Args { const float* in[21]; float* out; unsigned char* ws; int ph_lo, ph_hi, li, pad; };
struct Frame {
    LAS unsigned char* lds;
    volatile LAS unsigned* MISC;
    gu32* ctl;
    int tid, lane, wave, vcu, G;
    int xi, xr, xn, nx;
};
enum { I_X = 0, I_WIN, I_CONVW, I_CONVB, I_CLNG, I_CLNB, I_SLNG, I_SLNB, I_SGUW, I_SGUB, I_WOUT, I_WQKV, I_WO, I_RELB, I_PWQ, I_PSK, I_PU, I_PV, I_GMIX, I_GFFN, I_GFIN };

template <int MODE>
__device__ __forceinline__ void p0_transpose_item(const float* W, int K, int N, bf16* WT, LAS float* scr, int item, int lane) {
    const int nblk = N / 32, kb = item / nblk, nb = item % nblk, k0 = 64 * kb, n0 = 32 * nb;
    int d0 = n0;
    if (MODE == 1) { const int seg = n0 >> 9, c = n0 & 511; d0 = (seg == 0) ? ((c >> 7) * 256 + (c & 127)) : (seg == 1) ? ((c >> 7) * 256 + 128 + (c & 127)) : n0; }
#pragma unroll 8
    for (int i = 0; i < 32; ++i) { const int kk = 2 * i + (lane >> 5); scr[kk * 33 + (lane & 31)] = W[(size_t)(k0 + kk) * N + n0 + (lane & 31)]; }
    LDS_WAIT(); asm volatile("" ::: "memory");
    const int c = lane & 7;
#pragma unroll
    for (int j = 0; j < 4; ++j) { const int n = (lane >> 3) + 8 * j; const LAS float* s = scr + (8 * c) * 33 + n;
        v4u o; o.x = pk2(s[0 * 33], s[1 * 33]); o.y = pk2(s[2 * 33], s[3 * 33]); o.z = pk2(s[4 * 33], s[5 * 33]); o.w = pk2(s[6 * 33], s[7 * 33]);
        *(GAS v4u*)(WT + (size_t)(d0 + n) * K + k0 + 8 * c) = o; }
    LDS_WAIT(); asm volatile("" ::: "memory");
}
template <int MODE> __device__ __forceinline__ int wq8_dst(int n0) { if (MODE == 1) { const int seg = n0 >> 9, c = n0 & 511; return (seg == 0) ? ((c >> 7) * 256 + (c & 127)) : (seg == 1) ? ((c >> 7) * 256 + 128 + (c & 127)) : n0; } return n0; }
template <int MODE>
__device__ __forceinline__ void p0_colmax_item(const float* W, int N, unsigned* cmax, int item, int lane) {
    const int nblk = N / 32, kb = item / nblk, nb = item % nblk, k0 = 64 * kb, n0 = 32 * nb, d0 = wq8_dst<MODE>(n0);
    float m = 0.f;
#pragma unroll 8
    for (int i = 0; i < 32; ++i) m = fmaxf(m, fabsf(W[(size_t)(k0 + 2 * i + (lane >> 5)) * N + n0 + (lane & 31)]));
    m = fmaxf(m, __shfl_xor(m, 32));
    if (lane < 32) atomicMax(cmax + d0 + lane, __builtin_bit_cast(unsigned, m));
}
template <int MODE>
__device__ __forceinline__ void p0_wq8_item(const float* W, int N, unsigned char* WT, const unsigned* cmax, float* sc, LAS float* scr, int item, int lane) {
    const int nblk = N / 32, kb = item / nblk, nb = item % nblk, k0 = 64 * kb, n0 = 32 * nb, d0 = wq8_dst<MODE>(n0);
    const float m = __builtin_bit_cast(float, cmax[d0 + (lane & 31)]), inv = m > 0.f ? 127.f / m : 0.f;
    if (kb == 0 && lane < 32) sc[d0 + lane] = m * (1.f / 127.f);
#pragma unroll 8
    for (int i = 0; i < 32; ++i) { const int kk = 2 * i + (lane >> 5); scr[kk * 33 + (lane & 31)] = W[(size_t)(k0 + kk) * N + n0 + (lane & 31)] * inv; }
    LDS_WAIT(); asm volatile("" ::: "memory");
    const int c = lane & 7;
#pragma unroll
    for (int j = 0; j < 4; ++j) { const int n = (lane >> 3) + 8 * j; const LAS float* sp = scr + (8 * c) * 33 + n;
        int q[8];
#pragma unroll
        for (int i = 0; i < 8; ++i) q[i] = (int)rintf(sp[i * 33]);
        v2u o; o.x = (unsigned)(q[0] & 255) | ((unsigned)(q[1] & 255) << 8) | ((unsigned)(q[2] & 255) << 16) | ((unsigned)(q[3] & 255) << 24); o.y = (unsigned)(q[4] & 255) | ((unsigned)(q[5] & 255) << 8) | ((unsigned)(q[6] & 255) << 16) | ((unsigned)(q[7] & 255) << 24);
        *(GAS v2u*)(WT + (size_t)(d0 + n) * D + k0 + 8 * c) = o; }
    LDS_WAIT(); asm volatile("" ::: "memory");
}
__device__ __forceinline__ void rms_row_to_bf16(const float* xrow, const float* g, bf16* orow, int lane) {
    const GAS f32x4* xr = (const GAS f32x4*)xrow + lane;
    f32x4 v[4]; float s = 0.f;
#pragma unroll
    for (int j = 0; j < 4; ++j) { v[j] = xr[64 * j]; s += (v[j].x * v[j].x + v[j].y * v[j].y) + (v[j].z * v[j].z + v[j].w * v[j].w); }
    const float r = rsqrtf(wave_sum(s) * (1.f / D) + EPS);
    GAS v2u* o8 = (GAS v2u*)orow + lane;
#pragma unroll
    for (int j = 0; j < 4; ++j) { const f32x4 gg = ((const GAS f32x4*)g)[lane + 64 * j]; v2u o; o.x = pk2(v[j].x * r * gg.x, v[j].y * r * gg.y); o.y = pk2(v[j].z * r * gg.z, v[j].w * r * gg.w); o8[64 * j] = o; }
}
__device__ __forceinline__ int t5_bucket(int d) {
    const int n = d > 0 ? d : 0;
    if (n < 16) return n;
    int b = 16;
    b += (n >= 22); b += (n >= 30); b += (n >= 40); b += (n >= 54); b += (n >= 73); b += (n >= 99); b += (n >= 134); b += (n >= 182);
    b += (n >= 246); b += (n >= 332); b += (n >= 450); b += (n >= 609); b += (n >= 825); b += (n >= 1117); b += (n >= 1513);
    return b;
}
__device__ __forceinline__ void cvt8(const float* src, bf16* dst, size_t i8) {
    const f32x4 a = ((const GAS f32x4*)src)[2 * i8], b = ((const GAS f32x4*)src)[2 * i8 + 1];
    v4u o; o.x = pk2(a.x, a.y); o.y = pk2(a.z, a.w); o.z = pk2(b.x, b.y); o.w = pk2(b.z, b.w);
    ((GAS v4u*)dst)[i8] = o;
}
template <bool SRCB, bool NIB = true> __device__ __forceinline__ void p_rms(const Args& A, Frame& F, const void* srcv, const float* g) {
    const float* src = (const float*)srcv; const bf16* srcb = (const bf16*)srcv;
    const int gw = F.vcu * NWAVES + F.wave, NGW = F.G * NWAVES, lane = F.lane;
    f32x4 nv[4];
    auto ldrow = [&](int row, f32x4 (&o)[4]) {
        if (SRCB) { const v4u a = *(const GAS v4u*)(srcb + (size_t)row * D + lane * 16), b = *(const GAS v4u*)(srcb + (size_t)row * D + lane * 16 + 8);
            o[0] = (f32x4){bf_lo(a.x), bf_hi(a.x), bf_lo(a.y), bf_hi(a.y)}; o[1] = (f32x4){bf_lo(a.z), bf_hi(a.z), bf_lo(a.w), bf_hi(a.w)}; o[2] = (f32x4){bf_lo(b.x), bf_hi(b.x), bf_lo(b.y), bf_hi(b.y)}; o[3] = (f32x4){bf_lo(b.z), bf_hi(b.z), bf_lo(b.w), bf_hi(b.w)}; }
        else {
#pragma unroll
            for (int j = 0; j < 4; ++j) o[j] = *(const GAS f32x4*)(src + (size_t)row * D + lane * 16 + 4 * j); } };
    if (gw < T) ldrow(gw, nv);
    f32x4 gg[4];
#pragma unroll
    for (int j = 0; j < 4; ++j) gg[j] = *(const GAS f32x4*)(g + lane * 16 + 4 * j);
    for (int m = gw; m < T; m += NGW) {
        f32x4 v[4]; float s = 0.f;
#pragma unroll
        for (int j = 0; j < 4; ++j) v[j] = nv[j];
        { const int mn = (m + NGW < T) ? m + NGW : m; ldrow(mn, nv); }
#pragma unroll
        for (int j = 0; j < 4; ++j) s += (v[j].x * v[j].x + v[j].y * v[j].y) + (v[j].z * v[j].z + v[j].w * v[j].w);
        const float r = rsqrtf(wave_sum(s) * (1.f / D) + EPS); float mx = 0.f;
#pragma unroll
        for (int j = 0; j < 4; ++j) { v[j] = v[j] * r * gg[j]; mx = fmaxf(mx, fmaxf(fmaxf(fabsf(v[j].x), fabsf(v[j].y)), fmaxf(fabsf(v[j].z), fabsf(v[j].w)))); }
        mx = wave_max(mx);
        constexpr float QL = NIB ? 119.f : 127.f;
        const float inv = mx > 0.f ? QL / mx : 0.f;
        v4u oq; unsigned* qp = (unsigned*)&oq;
#pragma unroll
        for (int j = 0; j < 4; ++j) { const int a = (int)rintf(v[j].x * inv), b = (int)rintf(v[j].y * inv), c = (int)rintf(v[j].z * inv), d = (int)rintf(v[j].w * inv);
            qp[j] = (unsigned)(a & 255) | ((unsigned)(b & 255) << 8) | ((unsigned)(c & 255) << 16) | ((unsigned)(d & 255) << 24); }
        *(GAS v4u*)(A.ws + WS_HQ + (size_t)m * D + lane * 16) = oq;
        if (lane == 0) ((float*)(A.ws + WS_HQS))[m] = mx * (1.f / QL);
    }
}

template <int ONLY = 0> __device__ __forceinline__ void p0_prologue(const Args& A, Frame& F) {
    unsigned char* ws = A.ws;
    LAS float* scr = (LAS float*)(F.lds + F.wave * 16384);
    const int gw = F.vcu * NWAVES + F.wave, NGW = F.G * NWAVES;
    constexpr int I_OUT = 16 * 32, I_O = 16 * 32, J_IN = 16 * (MIX_IN / 32), J_WQ = 16 * (2048 / 32), J_QKV = 16 * (3 * D / 32);
    constexpr int NITEMS = I_OUT + I_O + J_IN + 2 * J_WQ + J_QKV;
    unsigned* cmax = (unsigned*)(ws + WS_CTL) + CW_CMAX;
    if (ONLY == 0 || ONLY == 1)
    for (int it = gw; it < NITEMS; it += NGW) {
        int r = it;
        if (r < I_OUT) { p0_transpose_item<0>(A.in[I_WOUT], D, D, (bf16*)(ws + WS_WOUT), scr, r, F.lane); continue; } r -= I_OUT;
        if (r < I_O) { p0_transpose_item<0>(A.in[I_WO], D, D, (bf16*)(ws + WS_WO), scr, r, F.lane); continue; } r -= I_O;
        if (r < J_IN) { p0_colmax_item<1>(A.in[I_WIN], MIX_IN, cmax, r, F.lane); continue; } r -= J_IN;
        if (r < J_WQ) { p0_colmax_item<0>(A.in[I_PWQ], 2048, cmax + 2048, r, F.lane); continue; } r -= J_WQ;
        if (r < J_WQ) { p0_colmax_item<0>(A.in[I_PWQ] + (size_t)D * 2048, 2048, cmax + 4096, r, F.lane); continue; } r -= J_WQ;
        p0_colmax_item<0>(A.in[I_WQKV], 3 * D, cmax + 6144, r, F.lane);
    }
    const size_t gt = (size_t)blockIdx.x * NTHREADS + F.tid, NT = (size_t)F.G * NTHREADS;
    constexpr size_t N8_SK = (size_t)2 * PH * 2 * PNK * 128 / 8;
    f32x4 nv[4];
    if ((ONLY == 0 || ONLY == 2) && gw < 4 * PNE) { const float* src0 = (gw >= 2 * PNE ? A.in[I_PV] + (size_t)(gw - 2 * PNE) * D : A.in[I_PU] + (size_t)gw * D) + F.lane * 16;
#pragma unroll
        for (int j = 0; j < 4; ++j) nv[j] = *(const GAS f32x4*)(src0 + 4 * j); }
    if (ONLY == 0 || ONLY == 2)
    for (int row = gw; row < 4 * PNE; row += NGW) {
        const bool isv = row >= 2 * PNE; const int r = isv ? row - 2 * PNE : row;
        f32x4 v[4]; float m = 0.f;
#pragma unroll
        for (int j = 0; j < 4; ++j) v[j] = nv[j];
        { const int rn = (row + NGW < 4 * PNE) ? row + NGW : row;
          const float* srcn = (rn >= 2 * PNE ? A.in[I_PV] + (size_t)(rn - 2 * PNE) * D : A.in[I_PU] + (size_t)rn * D) + F.lane * 16;
#pragma unroll
          for (int j = 0; j < 4; ++j) nv[j] = *(const GAS f32x4*)(srcn + 4 * j); }
#pragma unroll
        for (int j = 0; j < 4; ++j) m = fmaxf(m, fmaxf(fmaxf(fabsf(v[j].x), fabsf(v[j].y)), fmaxf(fabsf(v[j].z), fabsf(v[j].w))));
        m = wave_max(m);
        float ss = 0.f;
#pragma unroll
        for (int j = 0; j < 4; ++j) ss += (v[j].x * v[j].x + v[j].y * v[j].y) + (v[j].z * v[j].z + v[j].w * v[j].w);
        ss = wave_sum(ss);
        {
            const float clip = fminf(m, 2.5f * sqrtf(ss * (1.f / D)));
            const float inv = clip > 0.f ? 7.f / clip : 0.f;
            v2u o2; unsigned* op = (unsigned*)&o2;
#pragma unroll
            for (int w = 0; w < 2; ++w) { unsigned ow = 0;
#pragma unroll
                for (int bb = 0; bb < 4; ++bb) { const int l = (int)fminf(fmaxf(rintf(v[2 * w][bb] * inv), -7.f), 7.f), h = (int)fminf(fmaxf(rintf(v[2 * w + 1][bb] * inv), -7.f), 7.f);
                    ow |= (unsigned)(((isv ? l + 8 : l) & 15) | ((h & 15) << 4)) << (8 * bb); }
                op[w] = ow; }
            *(GAS v2u*)(ws + (isv ? WS_PV : WS_PU) + (size_t)(r / PNE) * PNE * 512 + (size_t)(F.lane >> 4) * PNE * 128 + (size_t)(r % PNE) * 128 + (F.lane & 15) * 8) = o2;
            if (F.lane == 0) ((float*)(ws + (isv ? WS_PSV : WS_PSU)))[r] = clip * (1.f / 7.f);
        }
    }
    if (ONLY == 0 || ONLY == 3) {
    for (size_t i = gt; i < N8_SK; i += NT) cvt8(A.in[I_PSK], (bf16*)(ws + WS_SK), i);
    for (size_t i = gt; i < (size_t)B_HEADS * 128 * 128; i += NT) { const int s = (int)(i & 127), t = (int)((i >> 7) & 127); ((bf16*)(ws + WS_SGW))[i] = (bf16)f2bf(s <= t ? A.in[I_SGUW][i] : 0.f); }
    for (size_t i = gt; i < (size_t)MH * LUT_N; i += NT) { const int h = (int)(i / LUT_N), d = (int)(i % LUT_N) - LUT_OFF; ((float*)(ws + WS_LUT))[i] = A.in[I_RELB][t5_bucket(d) * MH + h]; }
    for (size_t i = gt; i < (size_t)(BATCH * NBLK * D + T); i += NT) ((float*)(ws + WS_KMEAN))[i] = 0.f;
    }
    if (ONLY == 0 || ONLY == 4) p_rms<false, false>(A, F, A.in[I_X], A.in[I_GMIX]);
}
__device__ __forceinline__ void p0_weights8(const Args& A, Frame& F) {
    unsigned char* ws = A.ws;
    LAS float* scr = (LAS float*)(F.lds + F.wave * 16384);
    const int gw = F.vcu * NWAVES + F.wave, NGW = F.G * NWAVES;
    constexpr int J_IN = 16 * (MIX_IN / 32), J_WQ = 16 * (2048 / 32), J_QKV = 16 * (3 * D / 32);
    const unsigned* cmax = (const unsigned*)(ws + WS_CTL) + CW_CMAX; float* wsc = (float*)(ws + WS_WSC);
    for (int it = gw; it < J_IN + 2 * J_WQ + J_QKV; it += NGW) {
        int r = it;
        if (r < J_IN) { p0_wq8_item<1>(A.in[I_WIN], MIX_IN, ws + WS_WIN, cmax, wsc, scr, r, F.lane); continue; } r -= J_IN;
        if (r < J_WQ) { p0_wq8_item<0>(A.in[I_PWQ], 2048, ws + WS_WQ, cmax + 2048, wsc + 2048, scr, r, F.lane); continue; } r -= J_WQ;
        if (r < J_WQ) { p0_wq8_item<0>(A.in[I_PWQ] + (size_t)D * 2048, 2048, ws + WS_WQ + (size_t)2048 * D, cmax + 4096, wsc + 4096, scr, r, F.lane); continue; } r -= J_WQ;
        p0_wq8_item<0>(A.in[I_WQKV], 3 * D, ws + WS_WQKV, cmax + 6144, wsc + 6144, scr, r, F.lane);
    }
}

__device__ __forceinline__ void p9_kmean(const Args& A, Frame& F) {
    const bf16* K = (const bf16*)(A.ws + WS_K); float* km = (float*)(A.ws + WS_KMEAN);
    const size_t gt = (size_t)blockIdx.x * NTHREADS + F.tid, NT = (size_t)F.G * NTHREADS;
    for (size_t i = gt; i < (size_t)BATCH * NBLK * D; i += NT) {
        const int col = (int)(i & 1023); const size_t bb = i >> 10; float s = 0.f;
        for (int r = 0; r < MBLK; ++r) s += bf2f(K[(bb * MBLK + r) * D + col]);
        km[i] = s * (1.f / MBLK);
    }
}

typedef float f32x16_t __attribute__((ext_vector_type(16)));
#define PK_CE(a, i, j) { const float hi_ = __builtin_fmaxf(a[i], a[j]), lo_ = __builtin_fminf(a[i], a[j]); a[i] = hi_; a[j] = lo_; }
__device__ __forceinline__ void pk_sort16(float (&a)[16]) {
#pragma unroll
    for (int p = 1; p < 16; p <<= 1)
#pragma unroll
        for (int k = p; k >= 1; k >>= 1)
#pragma unroll
            for (int j = k % p; j + k < 16; j += 2 * k)
#pragma unroll
                for (int i = 0; i < k; ++i)
                    if (i + j + k < 16 && (i + j) / (2 * p) == (i + j + k) / (2 * p)) PK_CE(a, i + j, i + j + k);
}
__device__ __forceinline__ void pk_bitonic16(float (&a)[16]) {
#pragma unroll
    for (int s = 8; s >= 1; s >>= 1)
#pragma unroll
        for (int i = 0; i < 16; ++i) if ((i & s) == 0) PK_CE(a, i, i + s);
}
__device__ __forceinline__ void pk_merge_top16(float (&a)[16], const float (&b)[16]) {
#pragma unroll
    for (int i = 0; i < 16; ++i) a[i] = __builtin_fmaxf(a[i], b[15 - i]);
    pk_bitonic16(a);
}
__device__ __forceinline__ float pk_key(float v, unsigned clr, unsigned id) { return __builtin_bit_cast(float, (__builtin_bit_cast(unsigned, v) & clr) | id); }
template <int MODE = 0> __device__ __forceinline__ void p6_route(const Args& A, Frame& F, int layer) {
    unsigned char* ws = A.ws;
    const bf16* qp = (const bf16*)(ws + WS_QP); const bf16* skb = (const bf16*)(ws + WS_SK) + (size_t)layer * PH * 2 * PNK * 128;
    int* idx = (int*)(ws + WS_IDX); float* gate = (float*)(ws + WS_GATE); float* suk = (float*)(ws + WS_SUK);
    LAS unsigned char* skl = F.lds;
    LAS unsigned char* tab = F.lds + 65536 + F.tid * 32;
    const int lane = F.lane, r32 = lane & 31, hi = lane >> 5;
    int cur_h = -1;
    bf16x8 qn[16];
    if (F.vcu < (T / 256) * PH) { const bf16* q0p = qp + (size_t)((F.vcu >> 3) * 256 + F.wave * 32 + r32) * 2048 + (F.vcu & 7) * 256 + hi * 8;
#pragma unroll
        for (int i = 0; i < 16; ++i) qn[i] = *(const bf16x8*)(q0p + 16 * i); }
    for (int u = F.vcu; u < (T / 256) * PH; u += F.G) {
        const int h = u & 7, tile = u >> 3;
        bf16x8 qc[16];
#pragma unroll
        for (int i = 0; i < 16; ++i) qc[i] = qn[i];
        { const int un = (u + F.G < (T / 256) * PH) ? u + F.G : u;
          const bf16* qnp = qp + (size_t)((un >> 3) * 256 + F.wave * 32 + r32) * 2048 + (un & 7) * 256 + hi * 8;
#pragma unroll
          for (int i = 0; i < 16; ++i) qn[i] = *(const bf16x8*)(qnp + 16 * i); }
        if (h != cur_h) {
            __syncthreads();
#pragma unroll
            for (int c = 0; c < 8; ++c) { const int id = F.tid + 512 * c, row = id >> 4, ch = id & 15;
                *(LAS v4u*)(skl + row * 256 + ((ch ^ (row & 15)) << 4)) = *(const v4u*)(skb + ((size_t)h * 256 + row) * 128 + ch * 8); }
            __syncthreads(); cur_h = h;
        }
        const int tok = tile * 256 + F.wave * 32 + r32;
        float top0[16], top1[16];
#pragma unroll
        for (int p = 0; p < 2; ++p) {
            bf16x8 qf[8];
#pragma unroll
            for (int ks = 0; ks < 8; ++ks) qf[ks] = qc[p * 8 + ks];
#pragma unroll
            for (int kt = 0; kt < 4; ++kt) {
                f32x16_t acc = {};
#pragma unroll
                for (int ks = 0; ks < 8; ++ks) { const bf16x8 a = *(const LAS bf16x8*)(skl + p * 32768 + (32 * kt + r32) * 256 + (((2 * ks + hi) ^ (r32 & 15)) << 4)); acc = __builtin_amdgcn_mfma_f32_32x32x16_bf16(a, qf[ks], acc, 0, 0, 0); }
                float g[16];
#pragma unroll
                for (int r = 0; r < 16; ++r) g[r] = pk_key(acc[r], 0xffffff80u, (unsigned)(32 * kt + (r & 3) + 8 * (r >> 2)));
                if (MODE != 1) pk_sort16(g);
                if (p == 0) { if (kt == 0) {
#pragma unroll
                        for (int i = 0; i < 16; ++i) top0[i] = g[i]; } else if (MODE != 1) pk_merge_top16(top0, g); else top0[kt] += g[kt]; }
                else { if (kt == 0) {
#pragma unroll
                        for (int i = 0; i < 16; ++i) top1[i] = g[i]; } else if (MODE != 1) pk_merge_top16(top1, g); else top1[kt] += g[kt]; }
            }
        }
        float mine[16], oth[16];
#pragma unroll
        for (int i = 0; i < 16; ++i) {
            const unsigned a0 = __builtin_bit_cast(unsigned, top0[i]) | ((unsigned)hi << 2), a1 = __builtin_bit_cast(unsigned, top1[i]) | ((unsigned)hi << 2);
            const auto rr = __builtin_amdgcn_permlane32_swap(a0, a1, false, false);
            mine[i] = __builtin_bit_cast(float, (unsigned)rr[0]); oth[i] = __builtin_bit_cast(float, (unsigned)rr[1]);
        }
        pk_merge_top16(mine, oth);
        float s1[16], s2[16];
#pragma unroll
        for (int i = 0; i < 16; ++i) { const unsigned m = __builtin_bit_cast(unsigned, mine[i]); const auto rr = __builtin_amdgcn_permlane32_swap(m, m, false, false);
            s1[i] = __builtin_bit_cast(float, (unsigned)rr[0]); s2[i] = __builtin_bit_cast(float, (unsigned)rr[1]); }
#pragma unroll
        for (int q4 = 0; q4 < 4; ++q4) {
            unsigned w1 = 0, w2 = 0;
#pragma unroll
            for (int k = 0; k < 4; ++k) { w1 |= (__builtin_bit_cast(unsigned, s1[4 * q4 + k]) & 127u) << (8 * k); w2 |= (__builtin_bit_cast(unsigned, s2[4 * q4 + k]) & 127u) << (8 * k); }
            *(LAS unsigned*)(tab + 4 * q4) = w1; *(LAS unsigned*)(tab + 16 + 4 * q4) = w2;
        }
#define PK_CAND(a, b) pk_key(s1[a] + s2[b], 0xffffff00u, (unsigned)((15 - (a)) * 16 + (15 - (b))))
        float G1[16], G2[16], G3[16];
#pragma unroll
        for (int b = 0; b < 16; ++b) G1[b] = PK_CAND(0, b);
#pragma unroll
        for (int b = 0; b < 8; ++b) { G2[b] = PK_CAND(1, b); G2[8 + b] = PK_CAND(15 - b, 0); }
        pk_bitonic16(G2);
        pk_merge_top16(G1, G2);
        G3[0] = PK_CAND(2, 0); G3[1] = PK_CAND(2, 1); G3[2] = PK_CAND(2, 2); G3[3] = PK_CAND(2, 3); G3[4] = PK_CAND(2, 4);
        G3[5] = PK_CAND(3, 0); G3[6] = PK_CAND(3, 1); G3[7] = PK_CAND(3, 2); G3[8] = PK_CAND(3, 3);
        G3[9] = PK_CAND(4, 0); G3[10] = PK_CAND(4, 1); G3[11] = PK_CAND(4, 2);
        G3[12] = PK_CAND(5, 0); G3[13] = PK_CAND(5, 1); G3[14] = PK_CAND(6, 0); G3[15] = PK_CAND(6, 1);
        pk_sort16(G3);
        G3[15] = __builtin_fmaxf(G3[15], PK_CAND(7, 0)); G3[14] = __builtin_fmaxf(G3[14], PK_CAND(7, 1));
        pk_bitonic16(G3);
        pk_merge_top16(G1, G3);
#undef PK_CAND
        LDS_WAIT();
        int e[16]; float pr[16]; float den = 0.f;
#pragma unroll
        for (int k = 0; k < 16; ++k) {
            const unsigned id = __builtin_bit_cast(unsigned, G1[k]) & 255u; const int a = 15 - (int)(id >> 4), b = 15 - (int)(id & 15u);
            const int i1 = *(const LAS unsigned char*)(tab + a), i2 = *(const LAS unsigned char*)(tab + 16 + b);
            e[k] = i1 * PNK + i2;
            pr[k] = __builtin_amdgcn_exp2f((G1[k] - G1[0]) * 1.4426950408889634f); den += pr[k];
        }
        const float inv = 1.f / den;
        const float* sc = (const float*)(ws + (hi == 0 ? WS_PSU : WS_PSV)) + layer * PNE;
        float scv[16];
#pragma unroll
        for (int k = 0; k < 16; ++k) scv[k] = sc[e[k]];
        if (hi == 0) {
#pragma unroll
            for (int k = 0; k < 4; ++k) { *(v4u*)(idx + (size_t)tok * PSEL + h * PTOPK + 4 * k) = (v4u){(unsigned)e[4 * k], (unsigned)e[4 * k + 1], (unsigned)e[4 * k + 2], (unsigned)e[4 * k + 3]};
                *(f32x4*)(suk + (size_t)tok * PSEL + h * PTOPK + 4 * k) = (f32x4){scv[4 * k], scv[4 * k + 1], scv[4 * k + 2], scv[4 * k + 3]}; }
        } else {
#pragma unroll
            for (int k = 0; k < 4; ++k) *(f32x4*)(gate + (size_t)tok * PSEL + h * PTOPK + 4 * k) = (f32x4){pr[4 * k] * inv * scv[4 * k], pr[4 * k + 1] * inv * scv[4 * k + 1], pr[4 * k + 2] * inv * scv[4 * k + 2], pr[4 * k + 3] * inv * scv[4 * k + 3]};
        }
    }
}

typedef _Float16 f16x2_t __attribute__((ext_vector_type(2)));
typedef _Float16 f16x8_t __attribute__((ext_vector_type(8)));
typedef short v4i16_t __attribute__((ext_vector_type(4)));
__device__ __forceinline__ void p2_mixer(const Args& A, Frame& F) {
    unsigned char* ws = A.ws;
    const bf16* aglu = (const bf16*)(ws + WS_AGLU); const bf16* ug = (const bf16*)(ws + WS_UG); const bf16* vg = (const bf16*)(ws + WS_VG); bf16* cat = (bf16*)(ws + WS_CAT);
    const float* cw = A.in[I_CONVW]; const float* cb = A.in[I_CONVB]; const float* clg = A.in[I_CLNG]; const float* clb = A.in[I_CLNB];
    const float* slg = A.in[I_SLNG]; const float* slb = A.in[I_SLNB]; const float* sb = A.in[I_SGUB]; const bf16* sgw = (const bf16*)(ws + WS_SGW);
    LAS unsigned char* L = F.lds;
    const int lane = F.lane, wave = F.wave;
    for (int unit = blockIdx.x; unit < T / 128; unit += F.G) {
        const int row0 = unit * 128, tin = (unit & 31) * 128;
#pragma unroll 1
        for (int pass = 0; pass < 2; ++pass) {
        if ((pass == 0) != ((blockIdx.x & 1) != 0)) {
        {
            const int cp = F.tid & 255, hf = F.tid >> 8, t0 = hf * 64;
            float w0[31], w1[31], x0[31], x1[31];
#pragma unroll
            for (int j = 0; j < 31; ++j) { const f32x2 ww = *(const f32x2*)(cw + j * 512 + 2 * cp); w0[j] = ww.x; w1[j] = ww.y; }
            const f32x2 bias = *(const f32x2*)(cb + 2 * cp);
            const unsigned char* gb = (const unsigned char*)aglu;
            unsigned o = (unsigned)(((row0 + t0 - 31) * 512 + 2 * cp) * 2);
            x0[0] = 0.f; x1[0] = 0.f;
#pragma unroll
            for (int s = 1; s < 31; ++s) { const int tt = s - 31; o += 1024u; asm volatile("" : "+v"(o)); unsigned wv = 0u; if (tin + t0 + tt >= 0) wv = *(const unsigned*)(gb + o); x0[s] = bf_lo(wv); x1[s] = bf_hi(wv); }
            unsigned lo = (unsigned)(t0 * 1024 + cp * 4);
            unsigned pre[4];
#pragma unroll
            for (int i = 0; i < 4; ++i) pre[i] = *(const unsigned*)(gb + (unsigned)(o + 1024u * (unsigned)(i + 1)));
            const unsigned olast = o + 1024u * 64u;
#pragma unroll 1
            for (int tb = 0; tb < 64; tb += 31) {
#pragma unroll
                for (int s = 0; s < 31; ++s) {
                    const int t = tb + s;
                    if (t < 64) {
                        o += 1024u; asm volatile("" : "+v"(o));
                        const unsigned wv = pre[s & 3]; { unsigned on = o + 4096u; on = on < olast ? on : olast; pre[s & 3] = *(const unsigned*)(gb + on); }
                        x0[s] = bf_lo(wv); x1[s] = bf_hi(wv);
                        float a0 = bias.x, a1 = bias.y;
#pragma unroll
                        for (int j = 0; j < 31; ++j) { a0 += w0[j] * x0[(s + 1 + j) % 31]; a1 += w1[j] * x1[(s + 1 + j) % 31]; }
                        const f16x2_t ov = {(_Float16)a0, (_Float16)a1};
                        *(LAS f16x2_t*)(L + lo) = ov; lo += 1024u; asm volatile("" : "+v"(lo));
                    }
                }
                { const unsigned p0 = pre[3], p1 = pre[0], p2 = pre[1], p3 = pre[2]; pre[0] = p0; pre[1] = p1; pre[2] = p2; pre[3] = p3; }
            }
        }
        __syncthreads();
#pragma unroll 2
        for (int k = 0; k < 16; ++k) {
            const int tl = wave * 16 + k; const f16x8_t hv = *(const LAS f16x8_t*)(L + tl * 1024 + lane * 16);
            float v[8]; float s = 0.f;
#pragma unroll
            for (int i = 0; i < 8; ++i) { v[i] = (float)hv[i]; s += v[i]; }
            const float mu = wave_sum(s) * (1.f / 512.f); float q = 0.f;
#pragma unroll
            for (int i = 0; i < 8; ++i) { v[i] -= mu; q += v[i] * v[i]; }
            const float rstd = rsqrtf(wave_sum(q) * (1.f / 512.f) + EPS);
            const f32x4 g0 = *(const f32x4*)(clg + lane * 8), g1 = *(const f32x4*)(clg + lane * 8 + 4), b0 = *(const f32x4*)(clb + lane * 8), b1 = *(const f32x4*)(clb + lane * 8 + 4);
            const float gg[8] = {g0.x, g0.y, g0.z, g0.w, g1.x, g1.y, g1.z, g1.w}, bb[8] = {b0.x, b0.y, b0.z, b0.w, b1.x, b1.y, b1.z, b1.w};
            float y[8];
#pragma unroll
            for (int i = 0; i < 8; ++i) { const float z = v[i] * rstd * gg[i] + bb[i]; y[i] = z * __builtin_amdgcn_rcpf(1.f + __expf(-z)); }
            v4u o; o.x = pk2(y[0], y[1]); o.y = pk2(y[2], y[3]); o.z = pk2(y[4], y[5]); o.w = pk2(y[6], y[7]);
            *(v4u*)(cat + (size_t)(row0 + tl) * 1024 + lane * 8) = o;
        }
        __syncthreads();
        } else {
#pragma unroll 1
        for (int k4 = 0; k4 < 16; k4 += 8) {
        v4u rawv[8];
#pragma unroll
        for (int k = 0; k < 8; ++k) rawv[k] = *(const v4u*)(vg + (size_t)(row0 + wave * 16 + k4 + k) * 512 + lane * 8);
#pragma unroll
        for (int k = 0; k < 8; ++k) {
            const int tl = wave * 16 + k4 + k;
            const v4u raw = rawv[k];
            float v[8] = {bf_lo(raw.x), bf_hi(raw.x), bf_lo(raw.y), bf_hi(raw.y), bf_lo(raw.z), bf_hi(raw.z), bf_lo(raw.w), bf_hi(raw.w)};
            float s = 0.f;
#pragma unroll
            for (int i = 0; i < 8; ++i) s += v[i];
            const float mu = wave_sum(s) * (1.f / 512.f); float q = 0.f;
#pragma unroll
            for (int i = 0; i < 8; ++i) { v[i] -= mu; q += v[i] * v[i]; }
            const float rstd = rsqrtf(wave_sum(q) * (1.f / 512.f) + EPS);
            const f32x4 g0 = *(const f32x4*)(slg + lane * 8), g1 = *(const f32x4*)(slg + lane * 8 + 4), b0 = *(const f32x4*)(slb + lane * 8), b1 = *(const f32x4*)(slb + lane * 8 + 4);
            const float gg[8] = {g0.x, g0.y, g0.z, g0.w, g1.x, g1.y, g1.z, g1.w}, bb[8] = {b0.x, b0.y, b0.z, b0.w, b1.x, b1.y, b1.z, b1.w};
#pragma unroll
            for (int i = 0; i < 8; ++i) v[i] = v[i] * rstd * gg[i] + bb[i];
            v4u o; o.x = pk2(v[0], v[1]); o.y = pk2(v[2], v[3]); o.z = pk2(v[4], v[5]); o.w = pk2(v[6], v[7]);
            *(LAS v4u*)(L + tl * 1024 + lane * 16) = o;
        }
        }
        __syncthreads();
        {
            const int h = wave, fr = lane & 15, fq = lane >> 4;
            const bf16* wh = sgw + (size_t)h * 128 * 128;
#pragma unroll 1
            for (int nh = 0; nh < 2; ++nh) {
                bf16x8 bfr[4][2];
#pragma unroll
                for (int ks = 0; ks < 4; ++ks)
#pragma unroll
                    for (int nt = 0; nt < 2; ++nt) {
                        const int n0 = h * 64 + (nh * 2 + nt) * 16;
                        const LAS unsigned char* pa = L + (size_t)(32 * ks + 8 * fq + (fr >> 2)) * 1024 + (n0 + 4 * (fr & 3)) * 2;
                        const v4i16_t lo = __builtin_amdgcn_ds_read_tr16_b64_v4i16((LAS v4i16_t*)pa), hi4 = __builtin_amdgcn_ds_read_tr16_b64_v4i16((LAS v4i16_t*)(pa + 4 * 1024));
                        bfr[ks][nt] = (bf16x8){lo[0], lo[1], lo[2], lo[3], hi4[0], hi4[1], hi4[2], hi4[3]};
                    }
                bf16x8 afn[4]; const int c = h * 64 + nh * 32 + 4 * fq;
#pragma unroll
                for (int ks = 0; ks < 4; ++ks) afn[ks] = *(const bf16x8*)(wh + (size_t)fr * 128 + 32 * ks + 8 * fq);
                v2u un0 = *(const v2u*)(ug + (size_t)(row0 + fr) * 512 + c), un1 = *(const v2u*)(ug + (size_t)(row0 + fr) * 512 + c + 16); float btn = sb[h * 128 + fr];
#pragma unroll 1
                for (int mt = 0; mt < 8; ++mt) {
                    bf16x8 af[4];
#pragma unroll
                    for (int ks = 0; ks < 4; ++ks) af[ks] = afn[ks];
                    const int t = 16 * mt + fr;
                    const v2u u0 = un0, u1 = un1; const float bt = btn;
                    { const int mn = mt < 7 ? mt + 1 : mt, tn = 16 * mn + fr;
#pragma unroll
                      for (int ks = 0; ks < 4; ++ks) afn[ks] = *(const bf16x8*)(wh + (size_t)tn * 128 + 32 * ks + 8 * fq);
                      un0 = *(const v2u*)(ug + (size_t)(row0 + tn) * 512 + c); un1 = *(const v2u*)(ug + (size_t)(row0 + tn) * 512 + c + 16); btn = sb[h * 128 + tn]; }
                    f32x4 acc0 = (f32x4){0.f, 0.f, 0.f, 0.f}, acc1 = (f32x4){0.f, 0.f, 0.f, 0.f};
#pragma unroll
                    for (int ks = 0; ks < 4; ++ks)
                        if (2 * ks <= mt) {
                            acc0 = __builtin_amdgcn_mfma_f32_16x16x32_bf16(bfr[ks][0], af[ks], acc0, 0, 0, 0);
                            acc1 = __builtin_amdgcn_mfma_f32_16x16x32_bf16(bfr[ks][1], af[ks], acc1, 0, 0, 0);
                        }
                    v2u o0, o1;
                    o0.x = pk2(bf_lo(u0.x) * (acc0[0] + bt), bf_hi(u0.x) * (acc0[1] + bt)); o0.y = pk2(bf_lo(u0.y) * (acc0[2] + bt), bf_hi(u0.y) * (acc0[3] + bt));
                    o1.x = pk2(bf_lo(u1.x) * (acc1[0] + bt), bf_hi(u1.x) * (acc1[1] + bt)); o1.y = pk2(bf_lo(u1.y) * (acc1[2] + bt), bf_hi(u1.y) * (acc1[3] + bt));
                    *(v2u*)(cat + (size_t)(row0 + t) * 1024 + 512 + c) = o0; *(v2u*)(cat + (size_t)(row0 + t) * 1024 + 512 + c + 16) = o1;
                }
            }
        }
        __syncthreads();
        }
        }
    }
}

struct S1a { int e0, e1; float a0, a1, b0, b1; v4u hq; float hs; };
__device__ __forceinline__ void s1a_load(S1a& s, const unsigned char* ws, int t, int lane) {
    const int* idx = (const int*)(ws + WS_IDX); const float* gsv = (const float*)(ws + WS_GATE); const float* suk = (const float*)(ws + WS_SUK);
    s.e0 = idx[(size_t)t * PSEL + lane]; s.e1 = idx[(size_t)t * PSEL + 64 + lane];
    s.a0 = suk[(size_t)t * PSEL + lane]; s.a1 = suk[(size_t)t * PSEL + 64 + lane];
    s.b0 = gsv[(size_t)t * PSEL + lane]; s.b1 = gsv[(size_t)t * PSEL + 64 + lane];
    s.hq = *(const v4u*)(ws + WS_HQ + (size_t)t * D + lane * 16); s.hs = ((const float*)(ws + WS_HQS))[t];
}
struct ChunkA { v4u rows[8]; v4u hq; float sa, sb; int kk, nv, t; };
struct WalkA { S1a cur, nxt; unsigned long long m0, m1; int it, nit, wrank, nw, nslice, xs0, xstep; bool done; };
__device__ __forceinline__ int walk_tok(const WalkA& w, int it) { return w.wrank + (it / w.nslice) * w.nw; }
__device__ __forceinline__ void walk_masks(WalkA& w) { const int xs = w.xs0 + (w.it % w.nslice) * w.xstep; w.m0 = __ballot((w.cur.e0 >> 11) == xs); w.m1 = __ballot((w.cur.e1 >> 11) == xs); }
template <int MODE> __device__ __forceinline__ void gen_a(ChunkA& c, WalkA& w, const unsigned char* ws, const unsigned char* ut, int lane, int cls) {
    while ((w.m0 | w.m1) == 0ull && !w.done) {
        ++w.it;
        if (w.it >= w.nit) { w.done = true; break; }
        w.cur = w.nxt;
        { const int itn = (w.it + 1 < w.nit) ? w.it + 1 : w.nit - 1; s1a_load(w.nxt, ws, walk_tok(w, itn), lane); }
        walk_masks(w);
    }
    if (w.done) { c.nv = 0; return; }
    int kl = 0, nv = 0, kkv = 0;
    unsigned long long lo = w.m0, hi = w.m1;
#pragma unroll
    for (int i = 0; i < 8; ++i) {
        const bool has = (lo | hi) != 0ull, uselo = lo != 0ull;
        const unsigned long long m = uselo ? lo : hi;
        const int kp = (uselo ? 0 : 64) + __builtin_ctzll(m | 0x8000000000000000ull);
        const unsigned long long mc = m & (m - 1ull);
        lo = uselo ? mc : lo; hi = uselo ? hi : mc;
        const int k = has ? kp : kl; nv += has ? 1 : 0; kl = k;
        const int e = __builtin_amdgcn_readlane(k < 64 ? w.cur.e0 : w.cur.e1, k & 63);
        if (MODE == 1) { c.rows[i] = w.cur.hq; c.rows[i].x += (unsigned)e; } else
        c.rows[i] = *(const v4u*)(ut + (size_t)e * D + lane * 16);
        kkv = (cls == i) ? k : kkv;
    }
    w.m0 = lo; w.m1 = hi;
    const float a0s = __shfl(w.cur.a0, kkv & 63), a1s = __shfl(w.cur.a1, kkv & 63), b0s = __shfl(w.cur.b0, kkv & 63), b1s = __shfl(w.cur.b1, kkv & 63);
    c.sa = w.cur.hs * (kkv < 64 ? a0s : a1s); c.sb = kkv < 64 ? b0s : b1s; c.kk = kkv; c.nv = nv; c.t = walk_tok(w, w.it); c.hq = w.cur.hq;
}
__device__ __forceinline__ void compute_a(const ChunkA& c, float* cb, int lane, int cls) {
    int d[8];
#pragma unroll
    for (int i = 0; i < 8; ++i) { const v4u& ur = c.rows[i];
        int s = __builtin_amdgcn_sdot4((int)ur.x, (int)c.hq.x, 0, false); s = __builtin_amdgcn_sdot4((int)ur.y, (int)c.hq.y, s, false); s = __builtin_amdgcn_sdot4((int)ur.z, (int)c.hq.z, s, false); d[i] = __builtin_amdgcn_sdot4((int)ur.w, (int)c.hq.w, s, false); }
    const bool b3 = lane & 8;
    int q4[4];
#pragma unroll
    for (int i = 0; i < 4; ++i) { const auto rr = __builtin_amdgcn_permlane32_swap((unsigned)d[i], (unsigned)d[i + 4], false, false); q4[i] = (int)rr[0] + (int)rr[1]; }
    int q2[2];
#pragma unroll
    for (int i = 0; i < 2; ++i) {
        const auto ra = __builtin_amdgcn_permlane16_swap((unsigned)q4[i], (unsigned)q4[i], false, false), rb = __builtin_amdgcn_permlane16_swap((unsigned)q4[i + 2], (unsigned)q4[i + 2], false, false);
        const int sa_ = (int)ra[0] + (int)ra[1], sb_ = (int)rb[0] + (int)rb[1]; q2[i] = (lane & 16) ? sb_ : sa_; }
    int q1; { const int send = b3 ? q2[0] : q2[1], keep = b3 ? q2[1] : q2[0]; q1 = keep + dpp_i<DPP_ROR8>(send); }
    q1 += dpp_i<DPP_HMIRROR>(q1); q1 += dpp_i<DPP_XOR2>(q1); q1 += dpp_i<DPP_XOR1>(q1);
    const float cf = c.sb * gelu_tanh((float)q1 * c.sa);
    if ((lane & 7) == 0 && cls < c.nv) cb[(size_t)c.t * PSEL + c.kk] = cf;
}
template <int MODE> __device__ __forceinline__ void p7a_act(const Args& A, Frame& F, int layer) {
    unsigned char* ws = A.ws;
    const unsigned char* ut = ws + WS_PU + (size_t)layer * PNE * D; float* cb = (float*)(ws + (MODE == 0 ? WS_CB : WS_SUK + 0));
    const int lane = F.lane;
    const int cls = ((lane >> 5) & 1) * 4 + ((lane >> 4) & 1) * 2 + ((lane >> 3) & 1);
    WalkA w;
    w.xs0 = F.xi; w.xstep = F.nx; w.nslice = F.xi < 8 ? (7 - F.xi) / F.nx + 1 : 0;
    w.wrank = F.xr * NWAVES + F.wave; w.nw = F.xn * NWAVES;
    const int cnt = (w.wrank < T) ? (T - 1 - w.wrank) / w.nw + 1 : 0;
    w.nit = cnt * w.nslice; w.it = 0; w.done = (w.nit == 0);
    if (w.done) return;
    s1a_load(w.cur, ws, walk_tok(w, 0), lane); s1a_load(w.nxt, ws, walk_tok(w, w.nit > 1 ? 1 : 0), lane);
    walk_masks(w);
    ChunkA ca, cbf;
    gen_a<MODE>(ca, w, ws, ut, lane, cls);
    while (ca.nv > 0) {
        gen_a<MODE>(cbf, w, ws, ut, lane, cls);
        compute_a(ca, cb, lane, cls);
        if (cbf.nv == 0) break;
        gen_a<MODE>(ca, w, ws, ut, lane, cls);
        compute_a(cbf, cb, lane, cls);
    }
}
__device__ __forceinline__ void y_ld_e(v4u (&e)[2], const unsigned char* ws, int t, int r) {
    const int* idx = (const int*)(ws + WS_IDX);
    e[0] = *(const v4u*)(idx + (size_t)t * PSEL + 8 * r); e[1] = *(const v4u*)(idx + (size_t)t * PSEL + 8 * r + 4);
}
template <int MODE> __device__ __forceinline__ void rows_issue8(v4u (&rows)[8], const v4u (&e4)[2], const unsigned char* base, unsigned loff) {
#pragma unroll
    for (int i = 0; i < 8; ++i) { const unsigned e = ((const unsigned*)&e4[i >> 2])[i & 3]; if (MODE == 1) { rows[i] = e4[0]; rows[i].x += e; } else { const unsigned off = e * 128u + loff; rows[i] = *(const v4u*)(base + off); } }
}
__device__ __forceinline__ void part_planes(v4u& hh, v4u& hl, const v4u& a, const v4u& b) {
    const unsigned w[8] = {a.x, a.y, a.z, a.w, b.x, b.y, b.z, b.w}; unsigned oh[4], ol[4];
#pragma unroll
    for (int q = 0; q < 4; ++q) { const unsigned w0 = w[2 * q], w1 = w[2 * q + 1];
        const unsigned h0 = (((w0 >> 4) & 0x0F0F0F0Fu) + ((w0 >> 3) & 0x01010101u)) & 0x0F0F0F0Fu, h1 = (((w1 >> 4) & 0x0F0F0F0Fu) + ((w1 >> 3) & 0x01010101u)) & 0x0F0F0F0Fu;
        ol[q] = (w0 & 0x0F0F0F0Fu) | ((w1 & 0x0F0F0F0Fu) << 4); oh[q] = h0 | (h1 << 4); }
    hh = (v4u){oh[0], oh[1], oh[2], oh[3]}; hl = (v4u){ol[0], ol[1], ol[2], ol[3]};
}
__device__ __forceinline__ void part_round(const v4u (&rows)[8], const v4u& hh4, const v4u& hl4, int* po, int j) {
    int sm[8];
    const unsigned hh[4] = {hh4.x, hh4.y, hh4.z, hh4.w}, hl[4] = {hl4.x, hl4.y, hl4.z, hl4.w};
#pragma unroll
    for (int i = 0; i < 8; ++i) {
        const unsigned w[4] = {rows[i].x, rows[i].y, rows[i].z, rows[i].w}; int sh = 0, sl = 0;
#pragma unroll
        for (int q = 0; q < 4; ++q) { sh = __builtin_amdgcn_sdot8((int)w[q], (int)hh[q], sh, false); sl = __builtin_amdgcn_sdot8((int)w[q], (int)hl[q], sl, false); }
        int s_ = (sh << 4) + sl;
        s_ += dpp_i<DPP_XOR1>(s_); s_ += dpp_i<DPP_XOR2>(s_); s_ += dpp_i<DPP_HMIRROR>(s_);
        sm[i] = s_;
    }
    if (j == 0) { *(v4u*)po = (v4u){(unsigned)sm[0], (unsigned)sm[1], (unsigned)sm[2], (unsigned)sm[3]}; *(v4u*)(po + 4) = (v4u){(unsigned)sm[4], (unsigned)sm[5], (unsigned)sm[6], (unsigned)sm[7]}; }
}
template <int MODE> __device__ __forceinline__ void p7a_part(const Args& A, Frame& F, int layer) {
    unsigned char* ws = A.ws;
    const unsigned char* ut = ws + WS_PU + (size_t)layer * PNE * 512; int* part = (int*)(ws + (MODE == 1 ? WS_R4 + 64 * MiB : WS_PART));
    const int lane = F.lane, g = lane >> 3, j = lane & 7;
    const int nslice = F.xi < 8 ? (7 - F.xi) / F.nx + 1 : 0, xs0 = F.xi, xstep = F.nx;
    const int wrank = F.xr * NWAVES + F.wave, nw = F.xn * NWAVES;
    constexpr int NSUP = T / 16;
    const int cnt = (wrank < NSUP) ? (NSUP - 1 - wrank) / nw + 1 : 0, nit = cnt * nslice * 16;
    if (nit == 0) return;
#define IT_T(it) (wrank + ((it) / nslice) * nw)
#define IT_X(it) (xs0 + ((it) % nslice) * xstep)
#define IT_C(it) ((it) < nit ? (it) : nit - 1)
#define Y_TOK(R) (2 * (8 * IT_T((R) >> 4) + g) + (IT_X((R) >> 4) >> 2))
#define Y_SL(R) (IT_X((R) >> 4) & 3)
#define P_LDH(dh, dl, R) do { const unsigned char* hp_ = ws + WS_HQ + (size_t)Y_TOK(R) * D + Y_SL(R) * 256 + j * 32; dh = *(const v4u*)hp_; dl = *(const v4u*)(hp_ + 16); } while (0)
    v4u E[4][2]; v4u buf[4][8]; v4u Hh, Hl, Nh, Nl;
    { v4u e0[2];
      y_ld_e(e0, ws, Y_TOK(0), 0); P_LDH(Hh, Hl, 0); rows_issue8<MODE>(buf[0], e0, ut + (size_t)Y_SL(0) * PNE * 128, (unsigned)(j * 16));
      { const int i1 = IT_C(1); y_ld_e(e0, ws, Y_TOK(i1), i1 & 15); rows_issue8<MODE>(buf[1], e0, ut + (size_t)Y_SL(i1) * PNE * 128, (unsigned)(j * 16)); }
      { const int i2 = IT_C(2); y_ld_e(e0, ws, Y_TOK(i2), i2 & 15); rows_issue8<MODE>(buf[2], e0, ut + (size_t)Y_SL(i2) * PNE * 128, (unsigned)(j * 16)); }
      { const int i3 = IT_C(3); y_ld_e(E[3], ws, Y_TOK(i3), i3 & 15); } { const int i4 = IT_C(4); y_ld_e(E[0], ws, Y_TOK(i4), i4 & 15); } { const int i5 = IT_C(5); y_ld_e(E[1], ws, Y_TOK(i5), i5 & 15); }
      Nh = Hh; Nl = Hl; }
#define P_POS(p) do { const int R = it + (p); \
        { const int r6 = IT_C(R + 6), r3 = IT_C(R + 3); y_ld_e(E[((p) + 2) & 3], ws, Y_TOK(r6), r6 & 15); \
          if ((R & 15) == 12) { const int rn = IT_C(R + 4); P_LDH(Nh, Nl, rn); } \
          rows_issue8<MODE>(buf[((p) + 3) & 3], E[((p) + 3) & 3], ut + (size_t)Y_SL(r3) * PNE * 128, (unsigned)(j * 16)); } \
        if ((R & 15) == 0) { part_planes(Hh, Hl, Nh, Nl); } \
        part_round(buf[(p) & 3], Hh, Hl, part + ((size_t)Y_SL(R) * T + Y_TOK(R)) * PSEL + 8 * (R & 15), j); } while (0)
#pragma unroll 1
    for (int it = 0; it < nit; it += 4) { P_POS(0); P_POS(1); P_POS(2); P_POS(3); }
#undef P_POS
#undef P_LDH
}
__device__ __forceinline__ void p7c_combine(const Args& A, Frame& F) {
    unsigned char* ws = A.ws;
    const int* part = (const int*)(ws + WS_PART); const float* suk = (const float*)(ws + WS_SUK); const float* gsv = (const float*)(ws + WS_GATE); const float* hsb = (const float*)(ws + WS_HQS);
    unsigned* cq = (unsigned*)(ws + WS_CB); float* csc = (float*)(ws + WS_CB + 8 * MiB);
    const size_t gt = (size_t)blockIdx.x * NTHREADS + F.tid, NT = (size_t)F.G * NTHREADS;
    for (size_t i4 = gt; i4 < (size_t)T * PSEL / 4; i4 += NT) {
        int s0 = 0, s1 = 0, s2 = 0, s3 = 0;
#pragma unroll
        for (int x = 0; x < 4; ++x) { const v4u p = *(const v4u*)(part + (size_t)x * T * PSEL + 4 * i4); s0 += (int)p.x; s1 += (int)p.y; s2 += (int)p.z; s3 += (int)p.w; }
        const size_t t = (4 * i4) >> 7;
        const f32x4 a = *(const f32x4*)(suk + 4 * i4), b = *(const f32x4*)(gsv + 4 * i4); const float hs = hsb[t];
        const float c0 = b.x * gelu_tanh((float)s0 * hs * a.x), c1 = b.y * gelu_tanh((float)s1 * hs * a.y), c2 = b.z * gelu_tanh((float)s2 * hs * a.z), c3 = b.w * gelu_tanh((float)s3 * hs * a.w);
        float m = fmaxf(fmaxf(fabsf(c0), fabsf(c1)), fmaxf(fabsf(c2), fabsf(c3)));
#pragma unroll
        for (int o = 1; o < 32; o <<= 1) m = fmaxf(m, __shfl_xor(m, o));
        const float inv = m > 0.f ? 127.f / m : 0.f;
        const int q0 = (int)rintf(c0 * inv), q1 = (int)rintf(c1 * inv), q2 = (int)rintf(c2 * inv), q3 = (int)rintf(c3 * inv);
        cq[i4] = (unsigned)(q0 & 255) | ((unsigned)(q1 & 255) << 8) | ((unsigned)(q2 & 255) << 16) | ((unsigned)(q3 & 255) << 24);
        if ((i4 & 31) == 0) csc[t] = m * (1.f / 127.f);
    }
}
__device__ __forceinline__ v2u y_ld_c(const unsigned char* ws, int t, int r) { return *(const v2u*)(ws + WS_CB + (size_t)t * PSEL + 8 * r); }
__device__ __forceinline__ void y_round(int (&y)[32], int& csum, const v4u (&rows)[8], const v2u& cq) {
#pragma unroll
    for (int kq = 0; kq < 2; ++kq) {
        const int c4 = (int)((const unsigned*)&cq)[kq];
        csum = __builtin_amdgcn_sdot4(c4, 0x01010101, csum, false);
#pragma unroll
        for (int q = 0; q < 4; ++q) {
            const unsigned r0 = ((const unsigned*)&rows[4 * kq])[q], r1 = ((const unsigned*)&rows[4 * kq + 1])[q], r2 = ((const unsigned*)&rows[4 * kq + 2])[q], r3 = ((const unsigned*)&rows[4 * kq + 3])[q];
            const unsigned u0 = __builtin_amdgcn_perm(r1, r0, 0x05010400u), u1 = __builtin_amdgcn_perm(r1, r0, 0x07030602u), u2 = __builtin_amdgcn_perm(r3, r2, 0x05010400u), u3 = __builtin_amdgcn_perm(r3, r2, 0x07030602u);
            const unsigned t[4] = {__builtin_amdgcn_perm(u2, u0, 0x05040100u), __builtin_amdgcn_perm(u2, u0, 0x07060302u), __builtin_amdgcn_perm(u3, u1, 0x05040100u), __builtin_amdgcn_perm(u3, u1, 0x07060302u)};
#pragma unroll
            for (int bb = 0; bb < 4; ++bb) {
                y[8 * q + 2 * bb] = __builtin_amdgcn_sdot4((int)t[bb], c4, y[8 * q + 2 * bb], false);
                y[8 * q + 2 * bb + 1] = __builtin_amdgcn_sdot4((int)(t[bb] & 0x0F0F0F0Fu), c4, y[8 * q + 2 * bb + 1], false); }
        }
    }
}
template <bool NN, int MODE = 0> __device__ __forceinline__ void p7b_y(const Args& A, Frame& F, int layer, const float* gnext, bf16* xout) {
    unsigned char* ws = A.ws;
    const unsigned char* vt = ws + WS_PV + (size_t)layer * PNE * 512;
    const int lane = F.lane, g = lane >> 3, j = lane & 7;
    const int nslice = F.xi < 8 ? (7 - F.xi) / F.nx + 1 : 0, xs0 = F.xi, xstep = F.nx;
    const int wrank = F.xr * NWAVES + F.wave, nw = F.xn * NWAVES;
    constexpr int NSUP = T / 16;
    const int cnt = (wrank < NSUP) ? (NSUP - 1 - wrank) / nw + 1 : 0, nit = cnt * nslice * 16;
    if (nit == 0) return;
    v4u E[4][2]; v2u Cq[4]; v4u buf[4][8]; int y[32]; int csum = 0;
    { v4u e0[2];
      y_ld_e(e0, ws, Y_TOK(0), 0); Cq[0] = y_ld_c(ws, Y_TOK(0), 0); rows_issue8<MODE>(buf[0], e0, vt + (size_t)Y_SL(0) * PNE * 128, (unsigned)(j * 16));
      { const int i1 = IT_C(1); y_ld_e(e0, ws, Y_TOK(i1), i1 & 15); Cq[1] = y_ld_c(ws, Y_TOK(i1), i1 & 15); rows_issue8<MODE>(buf[1], e0, vt + (size_t)Y_SL(i1) * PNE * 128, (unsigned)(j * 16)); }
      { const int i2 = IT_C(2); y_ld_e(e0, ws, Y_TOK(i2), i2 & 15); Cq[2] = y_ld_c(ws, Y_TOK(i2), i2 & 15); rows_issue8<MODE>(buf[2], e0, vt + (size_t)Y_SL(i2) * PNE * 128, (unsigned)(j * 16)); }
      { const int i3 = IT_C(3); y_ld_e(E[3], ws, Y_TOK(i3), i3 & 15); } { const int i4 = IT_C(4); y_ld_e(E[0], ws, Y_TOK(i4), i4 & 15); } { const int i5 = IT_C(5); y_ld_e(E[1], ws, Y_TOK(i5), i5 & 15); } }
#define Y_POS(p) do { const int R = it + (p); \
        { const int r6 = IT_C(R + 6), r3 = IT_C(R + 3); y_ld_e(E[((p) + 2) & 3], ws, Y_TOK(r6), r6 & 15); Cq[((p) + 3) & 3] = y_ld_c(ws, Y_TOK(r3), r3 & 15); \
          rows_issue8<MODE>(buf[((p) + 3) & 3], E[((p) + 3) & 3], vt + (size_t)Y_SL(r3) * PNE * 128, (unsigned)(j * 16)); } \
        if ((R & 15) == 0) { _Pragma("unroll") for (int i = 0; i < 32; ++i) y[i] = 0; csum = 0; } \
        y_round(y, csum, buf[(p) & 3], Cq[(p) & 3]); \
        if ((R & 15) == 15) { const int tt = Y_TOK(R); bf16* xo = xout + (size_t)tt * D + Y_SL(R) * 256 + j * 32; const float cs = ((const float*)(ws + WS_CB + 8 * MiB))[tt]; \
            v4u xv[4]; _Pragma("unroll") for (int q = 0; q < 4; ++q) xv[q] = *(const v4u*)(xo + 8 * q); \
            _Pragma("unroll") for (int q = 0; q < 4; ++q) { v4u o; unsigned* op = (unsigned*)&o; const unsigned* xp = (const unsigned*)&xv[q]; \
                  \
                _Pragma("unroll") for (int e = 0; e < 4; ++e) { const int c0 = 2 * e, c1 = 2 * e + 1; \
                    const int v0 = (c0 < 4) ? y[8 * q + 2 * c0 + 1] - 8 * csum : (y[8 * q + 2 * (c0 - 4)] - y[8 * q + 2 * (c0 - 4) + 1]) >> 4; \
                    const int v1 = (c1 < 4) ? y[8 * q + 2 * c1 + 1] - 8 * csum : (y[8 * q + 2 * (c1 - 4)] - y[8 * q + 2 * (c1 - 4) + 1]) >> 4; \
                    op[e] = pk2(bf_lo(xp[e]) + (float)v0 * cs, bf_hi(xp[e]) + (float)v1 * cs); } \
                *(v4u*)(xo + 8 * q) = o; } } } while (0)
#pragma unroll 1
    for (int it = 0; it < nit; it += 4) { Y_POS(0); Y_POS(1); Y_POS(2); Y_POS(3); }
#undef Y_POS
#undef Y_TOK
#undef Y_SL
#undef IT_T
#undef IT_X
#undef IT_C
}
__device__ __forceinline__ void p_norm_final(const Args& A, Frame& F, const bf16* xres, const float* g) {
    const int gw = F.vcu * NWAVES + F.wave, NGW = F.G * NWAVES, lane = F.lane;
    for (int m = gw; m < T; m += NGW) {
        const v4u a = *(const GAS v4u*)(xres + (size_t)m * D + lane * 16), b = *(const GAS v4u*)(xres + (size_t)m * D + lane * 16 + 8);
        f32x4 v[4] = {(f32x4){bf_lo(a.x), bf_hi(a.x), bf_lo(a.y), bf_hi(a.y)}, (f32x4){bf_lo(a.z), bf_hi(a.z), bf_lo(a.w), bf_hi(a.w)}, (f32x4){bf_lo(b.x), bf_hi(b.x), bf_lo(b.y), bf_hi(b.y)}, (f32x4){bf_lo(b.z), bf_hi(b.z), bf_lo(b.w), bf_hi(b.w)}};
        float s = 0.f;
#pragma unroll
        for (int q = 0; q < 4; ++q) s += (v[q].x * v[q].x + v[q].y * v[q].y) + (v[q].z * v[q].z + v[q].w * v[q].w);
        const float r = rsqrtf(wave_sum(s) * (1.f / D) + EPS);
#pragma unroll
        for (int q = 0; q < 4; ++q) *(GAS f32x4*)(A.out + (size_t)m * D + lane * 16 + 4 * q) = v[q] * r * *(const GAS f32x4*)(g + lane * 16 + 4 * q);
    }
}
#ifndef MK_ONE_LAUNCH
#define MK_ONE_LAUNCH 1
#endif
constexpr int NPH = 20;
#ifndef PROBE_DUP
#define PROBE_DUP 0
#endif
__global__ void __launch_bounds__(NTHREADS, 2) fwd(Args args) {
    extern __shared__ __attribute__((aligned(16))) unsigned char lds[];
    Frame F;
    F.lds = (LAS unsigned char*)lds;
    F.MISC = (volatile LAS unsigned*)(F.lds + MISC_OFF);
    F.tid = threadIdx.x; F.lane = F.tid & 63; F.wave = __builtin_amdgcn_readfirstlane(F.tid >> 6);
    F.G = gridDim.x; { const int bx = blockIdx.x; F.vcu = (F.G % 8 == 0) ? (bx % 8) * (F.G / 8) + bx / 8 : bx; }
    unsigned char* ws = args.ws;
    F.ctl = (gu32*)(ws + WS_CTL);
    for (int u = F.tid; u < (LDS_BYTES - LDSCTL_OFF) / 4; u += NTHREADS) ((LAS unsigned*)(F.lds + LDSCTL_OFF))[u] = 0u;
    __syncthreads();
    XcdBarrier bar; bar.bar = (unsigned*)(F.ctl + CW_BAR); bar.x = 0; bar.st = nullptr;
    { bar.bar = (unsigned*)(F.ctl + CW_BAR); bar.x = xb_xcc_id(); bar.st = F.MISC + 8;
      if (F.tid == 0) F.MISC[10] = xb_add(&bar.bar[XB_XCNT(bar.x)], 1u); }
#define GRID_BAR() do { if (MK_ONE_LAUNCH) { xcd_barrier(bar); if (PROBE_DUP == 120) xcd_barrier(bar); } } while (0)
    const int lo = args.ph_lo, hi = args.ph_hi;
#ifdef ONLY_PH
#define IN(k) ((k) == ONLY_PH && lo <= (k) && (k) < hi)
#else
#define IN(k) (lo <= (k) && (k) < hi)
#endif
    bf16* hA = (bf16*)(ws + WS_HA);

    if (IN(0)) { p0_prologue(args, F); GRID_BAR(); if (PROBE_DUP == 100) { p0_prologue(args, F); GRID_BAR(); } if (PROBE_DUP == 131) { p0_prologue<1>(args, F); GRID_BAR(); } if (PROBE_DUP == 132) { p0_prologue<2>(args, F); GRID_BAR(); } if (PROBE_DUP == 133) { p0_prologue<3>(args, F); GRID_BAR(); } if (PROBE_DUP == 134) { p0_prologue<4>(args, F); GRID_BAR(); } if (PROBE_DUP == 135) { p0_weights8(args, F); GRID_BAR(); } p0_weights8(args, F); GRID_BAR(); }
    {
        if (F.tid == 0) { unsigned below = 0u;
#pragma unroll
            for (unsigned j = 0; j < 16; ++j) { const unsigned c = xb_ld(&bar.bar[XB_XCNT(j)]); below += (j < bar.x && c > 0u) ? 1u : 0u; }
            F.MISC[11] = below; }
        __syncthreads();
        F.xi = __builtin_amdgcn_readfirstlane((int)F.MISC[11]); F.xr = __builtin_amdgcn_readfirstlane((int)F.MISC[10]); F.xn = __builtin_amdgcn_readfirstlane((int)F.MISC[8]); F.nx = __builtin_amdgcn_readfirstlane((int)F.MISC[9]);
        if (F.xn < 1) F.xn = 1; if (F.nx < 1) F.nx = 1;
    }
    if (IN(1)) {
        pg8::Gemm g{(const bf16*)(ws + WS_HQ), (const bf16*)(ws + WS_WIN), T, MIX_IN, D / 2}; pg8::StaticOrder S; S.init(T, MIX_IN, F.G, (int)blockIdx.x);
        pg8::EpiI8<pg8::EpiMixIn> E{pg8::EpiMixIn{(bf16*)(ws + WS_AGLU), (bf16*)(ws + WS_UG), (bf16*)(ws + WS_VG)}, (const float*)(ws + WS_HQS), (const float*)(ws + WS_WSC)};
        pg8::gemm_phase<pg8::EpiI8<pg8::EpiMixIn>, pg8::StaticOrder, true, true, true>(F.lds, g, S, E);
        GRID_BAR();
        if (PROBE_DUP == 101) { pg8::gemm_phase<pg8::EpiI8<pg8::EpiMixIn>, pg8::StaticOrder, true, true, true>(F.lds, g, S, E); GRID_BAR(); }
    }
    if (IN(2)) { p2_mixer(args, F); GRID_BAR(); if (PROBE_DUP == 102) { p2_mixer(args, F); GRID_BAR(); } }
    if (IN(3)) {
        pg8::Gemm g{(const bf16*)(ws + WS_CAT), (const bf16*)(ws + WS_WOUT), T, D, D}; pg8::StaticOrder S; S.init(T, D, F.G, (int)blockIdx.x);
        pg8::EpiResB<false> E{args.in[I_X], nullptr, hA, D};
        pg8::gemm_phase<pg8::EpiResB<false>, pg8::StaticOrder, true, true>(F.lds, g, S, E);
        GRID_BAR();
    }
#define PEER_PHASES(layer, pb) do { \
        if (IN(pb)) { p_rms<true>(args, F, hA, args.in[I_GFFN] + (layer) * D); GRID_BAR(); } \
        if (IN((pb) + 1)) { \
            pg8::Gemm g{(const bf16*)(ws + WS_HQ), (const bf16*)(ws + WS_WQ + (size_t)(layer) * 2048 * D), T, 2048, D / 2}; pg8::StaticOrder S; S.init(T, 2048, F.G, (int)blockIdx.x); \
            pg8::EpiI8Bf16<false> E{(bf16*)(ws + WS_QP), 2048, 0, 0, 1.f, (const float*)(ws + WS_HQS), (const float*)(ws + WS_WSC) + 2048 + (layer) * 2048, nullptr, 0}; \
            pg8::gemm_phase<pg8::EpiI8Bf16<false>, pg8::StaticOrder, true, true, true>(F.lds, g, S, E); \
            GRID_BAR(); \
            if (PROBE_DUP == 105) { pg8::gemm_phase<pg8::EpiI8Bf16<false>, pg8::StaticOrder, true, true, true>(F.lds, g, S, E); GRID_BAR(); } \
        } \
        if (IN((pb) + 2)) { if (PROBE_DUP == 116) { p6_route<1>(args, F, (layer)); GRID_BAR(); } p6_route<0>(args, F, (layer)); GRID_BAR(); if (PROBE_DUP == 106) { p6_route<0>(args, F, (layer)); GRID_BAR(); } } \
        if (IN((pb) + 3)) { if (PROBE_DUP == 117) { p7a_part<1>(args, F, (layer)); GRID_BAR(); } p7a_part<0>(args, F, (layer)); GRID_BAR(); if (PROBE_DUP == 107) { p7a_part<0>(args, F, (layer)); GRID_BAR(); } p7c_combine(args, F); GRID_BAR(); if (PROBE_DUP == 108) { p7c_combine(args, F); GRID_BAR(); } } \
        if (IN((pb) + 4)) { if (PROBE_DUP == 118) { p7b_y<false, 1>(args, F, (layer), args.in[I_GFIN], (bf16*)(ws + WS_PART)); GRID_BAR(); } if (PROBE_DUP == 121) { p7b_y<false, 3>(args, F, (layer), args.in[I_GFIN], (bf16*)(ws + WS_PART)); GRID_BAR(); } if (PROBE_DUP == 119) { p7b_y<false, 2>(args, F, (layer), args.in[I_GFIN], (bf16*)(ws + WS_PART)); GRID_BAR(); } p7b_y<false>(args, F, (layer), args.in[I_GFIN], hA); GRID_BAR(); } \
        if (IN((pb) + 5)) { if ((layer) == 0) { p_rms<true, false>(args, F, hA, args.in[I_GMIX] + D); GRID_BAR(); } else p_norm_final(args, F, hA, args.in[I_GFIN]); } \
    } while (0)
    PEER_PHASES(0, 4);
    if (IN(10)) {
        pg8::Gemm g{(const bf16*)(ws + WS_HQ), (const bf16*)(ws + WS_WQKV), T, 3 * D, D / 2}; pg8::StaticOrder S; S.init(T, 3 * D, F.G, (int)blockIdx.x);
        pg8::EpiI8Bf16<true> E{(bf16*)(ws + WS_Q), D, D, (size_t)(WS_K - WS_Q) / 2, attn_body::C2, (const float*)(ws + WS_HQS), (const float*)(ws + WS_WSC) + 6144, (float*)(ws + WS_KMEAN), T / 256};
        pg8::gemm_phase<pg8::EpiI8Bf16<true>, pg8::StaticOrder, true, true, true>(F.lds, g, S, E);
        GRID_BAR();
    }
    if (IN(12)) {
        static_assert(attn_body::ATTN_LDS_BYTES <= RING_BYTES && attn_body::GLUT_OFF == LUT_OFF && attn_body::GLUT_N == LUT_N, "attention body geometry vs frame");
        const attn_body::AttnTensors AT{(const attn_body::bf16*)(ws + WS_Q), (const attn_body::bf16*)(ws + WS_K), (const attn_body::bf16*)(ws + WS_V), (attn_body::bf16*)(ws + WS_Q), (const float*)(ws + WS_KMEAN), (const float*)(ws + WS_LUT)};
        const attn_body::StaticOrder S((int)F.G, (int)blockIdx.x);
        if (PROBE_DUP == 112) { const attn_body::AttnTensors AT2{AT.Q, AT.K, AT.V, (attn_body::bf16*)(ws + WS_IDX), AT.KM, AT.GLUT}; attn_body::attn_phase<attn_body::StaticOrder>((char*)lds, AT2, S); GRID_BAR(); }
        if (PROBE_DUP == 113) { const attn_body::AttnTensors AT2{AT.Q, AT.K, AT.V, (attn_body::bf16*)(ws + WS_IDX), AT.KM, AT.GLUT}; attn_body::attn_phase<attn_body::StaticOrder, 8, true>((char*)lds, AT2, S); GRID_BAR(); }
        attn_body::attn_phase<attn_body::StaticOrder>((char*)lds, AT, S);
        GRID_BAR();
    }
    { int t_ = threadIdx.x; asm volatile("" : "+v"(t_)); F.tid = t_; F.lane = t_ & 63; }
    if (IN(13)) {
        pg8::Gemm g{(const bf16*)(ws + WS_Q), (const bf16*)(ws + WS_WO), T, D, D}; pg8::StaticOrder S; S.init(T, D, F.G, (int)blockIdx.x);
        pg8::EpiResB<true> E{nullptr, hA, hA, D};
        pg8::gemm_phase<pg8::EpiResB<true>, pg8::StaticOrder, true, true>(F.lds, g, S, E);
        GRID_BAR();
    }
    PEER_PHASES(1, 14);
#undef PEER_PHASES
#undef IN
#undef GRID_BAR
}

extern "C" void kernel_launch(void* const* d_in, const int* in_sizes, int n_in, void* d_out, int out_size, void* d_ws, size_t ws_size, hipStream_t stream) {
    static int grid = 0;
    if (grid == 0) {
        if (n_in != 21 || in_sizes[0] != T * D || out_size != T * D || ws_size < WS_END) { fprintf(stderr, "kernel_launch: unexpected shapes (n_in %d, in0 %d, out %d, ws %zu); nothing launched\n", n_in, n_in > 0 ? in_sizes[0] : -1, out_size, ws_size); grid = -1; return; }
        int dev = 0, cus = 0, per_cu = 0;
        if (hipGetDevice(&dev) != hipSuccess || hipDeviceGetAttribute(&cus, hipDeviceAttributeMultiprocessorCount, dev) != hipSuccess) { grid = -1; return; }
        if (hipFuncSetAttribute((const void*)fwd, hipFuncAttributeMaxDynamicSharedMemorySize, LDS_BYTES) != hipSuccess) { fprintf(stderr, "kernel_launch: hipFuncSetAttribute failed\n"); grid = -1; return; }
        if (hipOccupancyMaxActiveBlocksPerMultiprocessor(&per_cu, (const void*)fwd, NTHREADS, LDS_BYTES) != hipSuccess || per_cu < 1) fprintf(stderr, "kernel_launch: occupancy query reports %d workgroups per CU\n", per_cu);
        (void)hipGetLastError();
        grid = cus;
    }
    if (grid < 0) return;
    if (hipMemsetAsync((char*)d_ws + WS_CTL, 0, CTL_ZERO_BYTES, stream) != hipSuccess) { fprintf(stderr, "kernel_launch: hipMemsetAsync failed\n"); return; }
    Args a{};
    for (int i = 0; i < 21; ++i) a.in[i] = (const float*)d_in[i];
    a.out = (float*)d_out; a.ws = (unsigned char*)d_ws;
#if MK_ONE_LAUNCH
    a.ph_lo = 0; a.ph_hi = NPH; a.li = 0;
    hipLaunchKernelGGL(fwd, dim3(grid), dim3(NTHREADS), LDS_BYTES, stream, a);
#else
    for (int p = 0; p < NPH; ++p) { a.ph_lo = p; a.ph_hi = p + 1; a.li = p; hipLaunchKernelGGL(fwd, dim3(grid), dim3(NTHREADS), LDS_BYTES, stream, a); }
#endif
    const hipError_t le = hipPeekAtLastError();
    if (le != hipSuccess) fprintf(stderr, "kernel_launch: launch failed: %s\n", hipGetErrorName(le));
}
```

```cpp
#include <hip/hip_runtime.h>
#include <cstdio>
#include <cstdint>
namespace pg8 {
#define PG8_LAS __attribute__((address_space(3)))
typedef unsigned short bf16_t;
typedef short bf16x8 __attribute__((ext_vector_type(8)));
typedef float f32x4 __attribute__((ext_vector_type(4)));
typedef unsigned u32x4 __attribute__((ext_vector_type(4)));
constexpr int BM = 256, BK = 64, HALF = 128, HTB = HALF * BK * 2  , STAGE_BYTES = 8 * HTB, NXCD = 8, WGM = 8;

__host__ __device__ __forceinline__ int lds_byte(int r, int c) { const int st = (r >> 4) * 2 + (c >> 5), rr = r & 15, cc = c & 31, ob = rr * 64 + cc * 2; return st * 1024 + (ob ^ (((ob >> 9) & 1) << 5)); }
__host__ __device__ __forceinline__ void stage_rc(int b, int& R, int& C) { const int st = b / 1024, sb = b % 1024, swz = sb ^ (((sb >> 9) & 1) << 5); R = (st >> 1) * 16 + swz / 64; C = (st & 1) * 32 + (swz % 64) / 2; }
__host__ __device__ __forceinline__ int perm32(int rho) { const int n = rho >> 4, i = rho & 15; return 8 * (i >> 2) + 4 * n + (i & 3); }

struct Unit { int pm, pn; };
struct Gemm { const bf16_t* A; const bf16_t* Bt; int M, N, K; };

struct StaticOrder {
    int nM, nN, nwg, G, c;
    __host__ __device__ void init(int M, int N, int G_, int c_) { nM = M / BM; nN = N / BM; nwg = nM * nN; G = G_; c = c_; }
    __host__ __device__ bool next(int i, Unit& u) const {
        const long L = (long)i * G + c; if (L >= nwg) return false;
        int wgid = (int)L; { const int q = nwg / NXCD, r = nwg % NXCD, xcd = wgid % NXCD, off = wgid / NXCD; wgid = (xcd < r ? xcd * (q + 1) : r * (q + 1) + (xcd - r) * q) + off; }
        const int nig = WGM * nN, gid = wgid / nig, fm = gid * WGM, gsz = (nM - fm) < WGM ? (nM - fm) : WGM;
        u.pm = fm + ((wgid % nig) % gsz); u.pn = (wgid % nig) / gsz; return true;
    }
    __device__ __forceinline__ void a_ready(const Unit&) const {}
    __device__ __forceinline__ void done(const Unit&) const {}
};

__device__ __forceinline__ unsigned cvt_pk_bf16(float lo, float hi) { unsigned r; asm volatile("v_cvt_pk_bf16_f32 %0, %1, %2" : "=v"(r) : "v"(lo), "v"(hi)); return r; }
typedef float f32x2 __attribute__((ext_vector_type(2)));
__device__ __forceinline__ f32x2 gelu_pk(f32x2 v) {
    const f32x2 av = __builtin_elementwise_abs(v), d = av * 0.2316418882f + 1.0f;
    f32x2 t; t.x = __builtin_amdgcn_rcpf(d.x); t.y = __builtin_amdgcn_rcpf(d.y);
    f32x2 q = t * 0.5307027145f + (-0.7265760135f); q = q * t + 0.7107068705f; q = q * t + (-0.142248368f); q = q * t + 0.127414796f; q = q * t;
    const f32x2 s = (v * v) * (-0.72134752044f);
    f32x2 e; e.x = __builtin_amdgcn_exp2f(s.x); e.y = __builtin_amdgcn_exp2f(s.y);
    const f32x2 m = v * (q * e), r = v - m;
    f32x2 o; o.x = v.x < 0.f ? m.x : r.x; o.y = v.y < 0.f ? m.y : r.y; return o;
}

template <int ACT  > struct EpiBf16 {
    static constexpr bool PERM = true, AFTER_DRAIN = false; static_assert(ACT == 0 || ACT == 1, "EpiBf16: ACT is 0 (none) or 1 (gelu_pk)");
    bf16_t* O; int ldc; const float* bias; int split_cols; size_t split_stride; float scale0;
    __device__ __forceinline__ void operator()(const f32x4 (&acc)[2][2][4][2], const Unit& u, int wr, int wc, int fr, int fq) const {
        const int row0 = u.pm * BM + wr * 64 + fr; int colt = u.pn * BM; bf16_t* base = O;
        float sc = 1.f; if (split_cols) { const int t = colt / split_cols; base += (size_t)t * split_stride; colt -= t * split_cols; if (t == 0) sc = scale0; }
        const int col0 = colt + wc * 32 + 8 * fq, bcol0 = u.pn * BM + wc * 32 + 8 * fq;
        f32x4 bv[2][2];
#pragma unroll
        for (int bj = 0; bj < 2; ++bj)
#pragma unroll
            for (int n = 0; n < 2; ++n) bv[bj][n] = bias ? *(const f32x4*)(bias + bcol0 + bj * HALF + 4 * n) : (f32x4){0.f, 0.f, 0.f, 0.f};
#pragma unroll
        for (int ai = 0; ai < 2; ++ai)
#pragma unroll
            for (int m = 0; m < 4; ++m) { bf16_t* rowp = base + (size_t)(row0 + ai * HALF + m * 16) * ldc + col0;
#pragma unroll
                for (int bj = 0; bj < 2; ++bj) { f32x4 v0 = acc[ai][bj][m][0] + bv[bj][0], v1 = acc[ai][bj][m][1] + bv[bj][1];
                    if (ACT == 1) { f32x2 a = gelu_pk((f32x2){v0[0], v0[1]}), b = gelu_pk((f32x2){v0[2], v0[3]}), c = gelu_pk((f32x2){v1[0], v1[1]}), d = gelu_pk((f32x2){v1[2], v1[3]});
                        v0 = (f32x4){a.x, a.y, b.x, b.y}; v1 = (f32x4){c.x, c.y, d.x, d.y}; }
                    v0 = v0 * sc; v1 = v1 * sc; u32x4 w; w.x = cvt_pk_bf16(v0[0], v0[1]); w.y = cvt_pk_bf16(v0[2], v0[3]); w.z = cvt_pk_bf16(v1[0], v1[1]); w.w = cvt_pk_bf16(v1[2], v1[3]);
                    *(u32x4*)(rowp + bj * HALF) = w; } }
    }
};
typedef int i32x4 __attribute__((ext_vector_type(4)));
__device__ __forceinline__ float sigmoid_f(float x) { return __builtin_amdgcn_rcpf(1.0f + __expf(-x)); }
__device__ __forceinline__ float gelu_tanh_f(float x) { const float t = 1.5957691216057308f * (x + 0.044715f * x * x * x); return x * sigmoid_f(t); }
struct EpiMixIn {
    static constexpr bool PERM = true, AFTER_DRAIN = false;
    bf16_t* aglu; bf16_t* ug; bf16_t* vg;
    __device__ __forceinline__ void operator()(const f32x4 (&acc)[2][2][4][2], const Unit& u, int wr, int wc, int fr, int fq) const {
        const int row0 = u.pm * BM + wr * 64 + fr;
        if (u.pn < 4) {
            const int col0 = u.pn * 128 + wc * 32 + 8 * fq;
#pragma unroll
            for (int ai = 0; ai < 2; ++ai)
#pragma unroll
                for (int m = 0; m < 4; ++m) {
                    const f32x4 v0 = acc[ai][0][m][0], v1 = acc[ai][0][m][1], g0 = acc[ai][1][m][0], g1 = acc[ai][1][m][1];
                    u32x4 w;
                    w.x = cvt_pk_bf16(v0[0] * sigmoid_f(g0[0]), v0[1] * sigmoid_f(g0[1])); w.y = cvt_pk_bf16(v0[2] * sigmoid_f(g0[2]), v0[3] * sigmoid_f(g0[3]));
                    w.z = cvt_pk_bf16(v1[0] * sigmoid_f(g1[0]), v1[1] * sigmoid_f(g1[1])); w.w = cvt_pk_bf16(v1[2] * sigmoid_f(g1[2]), v1[3] * sigmoid_f(g1[3]));
                    *(u32x4*)(aglu + (size_t)(row0 + ai * HALF + m * 16) * 512 + col0) = w;
                }
        } else {
            bf16_t* dst = (u.pn < 6) ? ug : vg; const int col0 = (u.pn & 1) * 256 + wc * 32 + 8 * fq;
#pragma unroll
            for (int ai = 0; ai < 2; ++ai)
#pragma unroll
                for (int m = 0; m < 4; ++m)
#pragma unroll
                    for (int bj = 0; bj < 2; ++bj) {
                        const f32x4 v0 = acc[ai][bj][m][0], v1 = acc[ai][bj][m][1];
                        u32x4 w;
                        w.x = cvt_pk_bf16(gelu_tanh_f(v0[0]), gelu_tanh_f(v0[1])); w.y = cvt_pk_bf16(gelu_tanh_f(v0[2]), gelu_tanh_f(v0[3]));
                        w.z = cvt_pk_bf16(gelu_tanh_f(v1[0]), gelu_tanh_f(v1[1])); w.w = cvt_pk_bf16(gelu_tanh_f(v1[2]), gelu_tanh_f(v1[3]));
                        *(u32x4*)(dst + (size_t)(row0 + ai * HALF + m * 16) * 512 + col0 + bj * HALF) = w;
                    }
        }
    }
};
struct EpiRes {
    static constexpr bool PERM = false, AFTER_DRAIN = false;
    const float* base; float* out; int ldc;
    __device__ __forceinline__ void operator()(const f32x4 (&acc)[2][2][4][2], const Unit& u, int wr, int wc, int fr, int fq) const {
        const int col0 = u.pn * BM + wc * 32 + 4 * fq;
#pragma unroll
        for (int ai = 0; ai < 2; ++ai)
#pragma unroll
            for (int m = 0; m < 4; ++m) { const size_t off = (size_t)(u.pm * BM + ai * HALF + wr * 64 + m * 16 + fr) * ldc + col0;
#pragma unroll
                for (int bj = 0; bj < 2; ++bj)
#pragma unroll
                    for (int n = 0; n < 2; ++n) { const f32x4 bs = *(const f32x4*)(base + off + bj * HALF + n * 16); *(f32x4*)(out + off + bj * HALF + n * 16) = bs + acc[ai][bj][m][n]; } }
    }
};

struct EpiQKV {
    static constexpr bool PERM = true, AFTER_DRAIN = false;
    bf16_t* Q; size_t split_stride; const float* ssq; float* kmf; float qscale, eps;
    __device__ __forceinline__ void operator()(const f32x4 (&acc)[2][2][4][2], const Unit& u, int wr, int wc, int fr, int fq) const {
        const int row0 = u.pm * BM + wr * 64 + fr; const int tsel = u.pn >> 2, colt = (u.pn & 3) * 256;
        bf16_t* base = Q + (size_t)tsel * split_stride; const int col0 = colt + wc * 32 + 8 * fq;
        const float sc = tsel == 0 ? qscale : 1.f;
        f32x4 cs[2][2];
#pragma unroll
        for (int bj = 0; bj < 2; ++bj) { cs[bj][0] = (f32x4){0.f, 0.f, 0.f, 0.f}; cs[bj][1] = (f32x4){0.f, 0.f, 0.f, 0.f}; }
#pragma unroll
        for (int ai = 0; ai < 2; ++ai)
#pragma unroll
            for (int m = 0; m < 4; ++m) { const int row = row0 + ai * HALF + m * 16; const float rs = rsqrtf(ssq[row] * (1.0f / 1024.0f) + eps) * sc;
#pragma unroll
                for (int bj = 0; bj < 2; ++bj) { const f32x4 v0 = acc[ai][bj][m][0] * rs, v1 = acc[ai][bj][m][1] * rs; cs[bj][0] += v0; cs[bj][1] += v1;
                    u32x4 w; w.x = cvt_pk_bf16(v0[0], v0[1]); w.y = cvt_pk_bf16(v0[2], v0[3]); w.z = cvt_pk_bf16(v1[0], v1[1]); w.w = cvt_pk_bf16(v1[2], v1[3]);
                    *(u32x4*)(base + (size_t)row * 1024 + col0 + bj * HALF) = w; } }
        if (tsel == 1) {
#pragma unroll
            for (int bj = 0; bj < 2; ++bj)
#pragma unroll
                for (int n = 0; n < 2; ++n)
#pragma unroll
                    for (int e = 0; e < 4; ++e) { float v = cs[bj][n][e];
                        v += __builtin_bit_cast(float, __builtin_amdgcn_update_dpp(0, __builtin_bit_cast(int, v), 0xB1, 0xf, 0xf, true)); v += __builtin_bit_cast(float, __builtin_amdgcn_update_dpp(0, __builtin_bit_cast(int, v), 0x4E, 0xf, 0xf, true));
                        v += __builtin_bit_cast(float, __builtin_amdgcn_update_dpp(0, __builtin_bit_cast(int, v), 0x141, 0xf, 0xf, true)); v += __builtin_bit_cast(float, __builtin_amdgcn_update_dpp(0, __builtin_bit_cast(int, v), 0x128, 0xf, 0xf, true));
                        if (fr == 0) atomicAdd(kmf + (size_t)u.pm * 1024 + col0 + bj * HALF + 4 * n + e, v * (1.0f / 256.0f)); }
        }
    }
};

template <class Inner> struct EpiI8 {
    static constexpr bool PERM = true, AFTER_DRAIN = false; static_assert(Inner::PERM, "EpiI8 wraps PERM epilogues");
    Inner E; const float* sa; const float* sb;
    __device__ __forceinline__ void operator()(const f32x4 (&acc)[2][2][4][2], const Unit& u, int wr, int wc, int fr, int fq) const {
        const int cb0 = u.pn * BM + wc * 32 + 8 * fq, row0 = u.pm * BM + wr * 64 + fr;
        f32x4 sbv[2][2];
#pragma unroll
        for (int bj = 0; bj < 2; ++bj)
#pragma unroll
            for (int n = 0; n < 2; ++n) sbv[bj][n] = *(const f32x4*)(sb + cb0 + bj * HALF + 4 * n);
        f32x4 cv[2][2][4][2];
#pragma unroll
        for (int ai = 0; ai < 2; ++ai)
#pragma unroll
            for (int m = 0; m < 4; ++m) { const float ra = sa[row0 + ai * HALF + m * 16];
#pragma unroll
                for (int bj = 0; bj < 2; ++bj)
#pragma unroll
                    for (int n = 0; n < 2; ++n) { const i32x4 iv = __builtin_bit_cast(i32x4, acc[ai][bj][m][n]);
                        cv[ai][bj][m][n] = (f32x4){(float)iv[0], (float)iv[1], (float)iv[2], (float)iv[3]} * ra * sbv[bj][n]; } }
        E(cv, u, wr, wc, fr, fq);
    }
};

template <bool BF> struct EpiResB {
    static constexpr bool PERM = true, AFTER_DRAIN = false;
    const float* basef; const bf16_t* baseb; bf16_t* outb; int ldc;
    __device__ __forceinline__ void operator()(const f32x4 (&acc)[2][2][4][2], const Unit& u, int wr, int wc, int fr, int fq) const {
        const int col0 = u.pn * BM + wc * 32 + 8 * fq;
#pragma unroll
        for (int ai = 0; ai < 2; ++ai)
#pragma unroll
            for (int m = 0; m < 4; ++m) { const size_t off = (size_t)(u.pm * BM + ai * HALF + wr * 64 + m * 16 + fr) * ldc + col0;
#pragma unroll
                for (int bj = 0; bj < 2; ++bj) { const size_t o = off + bj * HALF; f32x4 b0, b1;
                    if (BF) { const u32x4 w = *(const u32x4*)(baseb + o);
                        b0 = (f32x4){__builtin_bit_cast(float, w.x << 16), __builtin_bit_cast(float, w.x & 0xffff0000u), __builtin_bit_cast(float, w.y << 16), __builtin_bit_cast(float, w.y & 0xffff0000u)};
                        b1 = (f32x4){__builtin_bit_cast(float, w.z << 16), __builtin_bit_cast(float, w.z & 0xffff0000u), __builtin_bit_cast(float, w.w << 16), __builtin_bit_cast(float, w.w & 0xffff0000u)}; }
                    else { b0 = *(const f32x4*)(basef + o); b1 = *(const f32x4*)(basef + o + 4); }
                    const f32x4 v0 = b0 + acc[ai][bj][m][0], v1 = b1 + acc[ai][bj][m][1];
                    u32x4 wv; wv.x = cvt_pk_bf16(v0[0], v0[1]); wv.y = cvt_pk_bf16(v0[2], v0[3]); wv.z = cvt_pk_bf16(v1[0], v1[1]); wv.w = cvt_pk_bf16(v1[2], v1[3]);
                    *(u32x4*)(outb + o) = wv; } }
    }
};

struct EpiQKVM {
    static constexpr bool PERM = true, AFTER_DRAIN = false;
    EpiBf16<0> B; float* kmp; int ntm;
    __device__ __forceinline__ void operator()(const f32x4 (&acc)[2][2][4][2], const Unit& u, int wr, int wc, int fr, int fq) const {
        B(acc, u, wr, wc, fr, fq);
        if (u.pn >= 4 && u.pn < 8) {
            float* dst = kmp + ((size_t)wr * ntm + u.pm) * 1024 + (u.pn - 4) * BM + wc * 32 + 8 * fq;
#pragma unroll
            for (int bj = 0; bj < 2; ++bj)
#pragma unroll
                for (int n = 0; n < 2; ++n) { f32x4 cs = (acc[0][bj][0][n] + acc[0][bj][1][n]) + (acc[0][bj][2][n] + acc[0][bj][3][n]) + ((acc[1][bj][0][n] + acc[1][bj][1][n]) + (acc[1][bj][2][n] + acc[1][bj][3][n]));
#pragma unroll
                    for (int e = 0; e < 4; ++e) { float v = cs[e];
                        v += __builtin_bit_cast(float, __builtin_amdgcn_update_dpp(0, __builtin_bit_cast(int, v), 0xB1, 0xf, 0xf, true)); v += __builtin_bit_cast(float, __builtin_amdgcn_update_dpp(0, __builtin_bit_cast(int, v), 0x4E, 0xf, 0xf, true));
                        v += __builtin_bit_cast(float, __builtin_amdgcn_update_dpp(0, __builtin_bit_cast(int, v), 0x141, 0xf, 0xf, true)); v += __builtin_bit_cast(float, __builtin_amdgcn_update_dpp(0, __builtin_bit_cast(int, v), 0x128, 0xf, 0xf, true));
                        cs[e] = v * (1.0f / 256.0f); }
                    if (fr == 0) *(f32x4*)(dst + bj * HALF + 4 * n) = cs; }
        }
    }
};

template <bool KM> struct EpiI8Bf16 {
    static constexpr bool PERM = true, AFTER_DRAIN = false;
    bf16_t* O; int ldc; int split_cols; size_t split_stride; float scale0; const float* sa; const float* sb; float* kmp; int ntm;
    __device__ __forceinline__ void operator()(const f32x4 (&acc)[2][2][4][2], const Unit& u, int wr, int wc, int fr, int fq) const {
        const int row0 = u.pm * BM + wr * 64 + fr; int colt = u.pn * BM, tsel = 0; bf16_t* base = O; float sc = 1.f;
        if (split_cols) { tsel = colt / split_cols; base += (size_t)tsel * split_stride; colt -= tsel * split_cols; if (tsel == 0) sc = scale0; }
        const int col0 = colt + wc * 32 + 8 * fq, cb0 = u.pn * BM + wc * 32 + 8 * fq;
        f32x4 sbv[2][2], cs[2][2];
#pragma unroll
        for (int bj = 0; bj < 2; ++bj)
#pragma unroll
            for (int n = 0; n < 2; ++n) { sbv[bj][n] = *(const f32x4*)(sb + cb0 + bj * HALF + 4 * n) * sc; cs[bj][n] = (f32x4){0.f, 0.f, 0.f, 0.f}; }
#pragma unroll
        for (int ai = 0; ai < 2; ++ai)
#pragma unroll
            for (int m = 0; m < 4; ++m) { const int row = row0 + ai * HALF + m * 16; const float ra = sa[row]; bf16_t* rowp = base + (size_t)row * ldc + col0;
#pragma unroll
                for (int bj = 0; bj < 2; ++bj) { const i32x4 i0 = __builtin_bit_cast(i32x4, acc[ai][bj][m][0]), i1 = __builtin_bit_cast(i32x4, acc[ai][bj][m][1]);
                    const f32x4 v0 = (f32x4){(float)i0[0], (float)i0[1], (float)i0[2], (float)i0[3]} * ra * sbv[bj][0], v1 = (f32x4){(float)i1[0], (float)i1[1], (float)i1[2], (float)i1[3]} * ra * sbv[bj][1];
                    if (KM) { cs[bj][0] += v0; cs[bj][1] += v1; }
                    u32x4 w; w.x = cvt_pk_bf16(v0[0], v0[1]); w.y = cvt_pk_bf16(v0[2], v0[3]); w.z = cvt_pk_bf16(v1[0], v1[1]); w.w = cvt_pk_bf16(v1[2], v1[3]);
                    *(u32x4*)(rowp + bj * HALF) = w; } }
        if (KM && tsel == 1) {
            float* dst = kmp + ((size_t)wr * ntm + u.pm) * 1024 + colt + wc * 32 + 8 * fq;
#pragma unroll
            for (int bj = 0; bj < 2; ++bj)
#pragma unroll
                for (int n = 0; n < 2; ++n) { f32x4 c = cs[bj][n];
#pragma unroll
                    for (int e = 0; e < 4; ++e) { float v = c[e];
                        v += __builtin_bit_cast(float, __builtin_amdgcn_update_dpp(0, __builtin_bit_cast(int, v), 0xB1, 0xf, 0xf, true)); v += __builtin_bit_cast(float, __builtin_amdgcn_update_dpp(0, __builtin_bit_cast(int, v), 0x4E, 0xf, 0xf, true));
                        v += __builtin_bit_cast(float, __builtin_amdgcn_update_dpp(0, __builtin_bit_cast(int, v), 0x141, 0xf, 0xf, true)); v += __builtin_bit_cast(float, __builtin_amdgcn_update_dpp(0, __builtin_bit_cast(int, v), 0x128, 0xf, 0xf, true));
                        c[e] = v * (1.0f / 256.0f); }
                    if (fr == 0) *(f32x4*)(dst + bj * HALF + 4 * n) = c; }
        }
    }
};

struct RouteOrder {
    int vcu, G, n;
    __host__ __device__ bool next(int i, Unit& u) const { const int L = i * G + vcu; if (L >= n) return false; u.pm = L >> 3; u.pn = L & 7; return true; }
    __device__ __forceinline__ void a_ready(const Unit&) const {}
    __device__ __forceinline__ void done(const Unit&) const {}
};
template <bool I8> __device__ __forceinline__ f32x4 mma_step(const bf16x8& b, const bf16x8& a, const f32x4& c) {
    if constexpr (I8) return __builtin_bit_cast(f32x4, __builtin_amdgcn_mfma_i32_16x16x64_i8(__builtin_bit_cast(i32x4, b), __builtin_bit_cast(i32x4, a), __builtin_bit_cast(i32x4, c), 0, 0, 0));
    else return __builtin_amdgcn_mfma_f32_16x16x32_bf16(b, a, c, 0, 0, 0);
}
template <class Epi, class Sched, bool ALIGN_EPI = false, bool SP2 = false, bool I8 = false>
__device__ __forceinline__ void gemm_phase(PG8_LAS unsigned char* lds, const Gemm g, const Sched& S, const Epi& E) {
    const int tid = threadIdx.x, wid = __builtin_amdgcn_readfirstlane(tid >> 6), lane = tid & 63, wr = wid >> 2, wc = wid & 3, fr = lane & 15, fq = lane >> 4;
    const int K = g.K, nt = K / BK;
    unsigned voffA[2], voffB[2];
#pragma unroll
    for (int i = 0; i < 2; ++i) { int R, C; stage_rc(tid * 16 + i * 8192, R, C); const int Rb = Epi::PERM ? ((R & ~31) + perm32(R & 31)) : R;
        voffA[i] = (unsigned)(R * K + C) * 2u; voffB[i] = (unsigned)(Rb * K + C) * 2u; }
    const size_t kstep = (size_t)(BK * 2);
    const size_t hstep = (size_t)HALF * K * 2;
    const size_t tstep = 2 * hstep;
    const unsigned ldsw = (unsigned)wid * 1024u;
    const int aoff = lds_byte(wr * 64 + fr, fq * 8), boff = lds_byte(wc * 32 + fr, fq * 8);
#define PG8_SA(b, h) (((b) * 2 + (h)) * HTB)
#define PG8_SB(b, h) ((4 + (b) * 2 + (h)) * HTB)
#define PG8_STAGE(bufoff, gbase, voff) do { _Pragma("unroll") for (int _i = 0; _i < 2; ++_i) \
        __builtin_amdgcn_global_load_lds((const unsigned*)((const char*)(gbase) + (voff)[_i]), (PG8_LAS unsigned*)(lds + (bufoff) + ldsw + _i * 8192), 16, 0, 0); } while (0)
#define PG8_LDA(dst, b, h) do { _Pragma("unroll") for (int m = 0; m < 4; ++m) _Pragma("unroll") for (int k = 0; k < 2; ++k) dst[m][k] = *(const PG8_LAS bf16x8*)(lds + PG8_SA(b, h) + aoff + m * 2048 + k * 1024); } while (0)
#define PG8_LDB(dst, b, h) do { _Pragma("unroll") for (int n = 0; n < 2; ++n) _Pragma("unroll") for (int k = 0; k < 2; ++k) dst[n][k] = *(const PG8_LAS bf16x8*)(lds + PG8_SB(b, h) + boff + n * 2048 + k * 1024); } while (0)
#define PG8_MMA(ai, bj, At, Bt) do { __builtin_amdgcn_s_setprio(1); _Pragma("unroll") for (int m = 0; m < 4; ++m) _Pragma("unroll") for (int n = 0; n < 2; ++n) _Pragma("unroll") for (int k = 0; k < 2; ++k) \
        acc[ai][bj][m][n] = mma_step<I8>(Bt[n][k], At[m][k], acc[ai][bj][m][n]); __builtin_amdgcn_s_setprio(0); } while (0)
#define PG8_WAIT_V(n) asm volatile("s_waitcnt vmcnt(" #n ")" ::: "memory")
#define PG8_WAIT_L(n) asm volatile("s_waitcnt lgkmcnt(" #n ")" ::: "memory")
#define PG8_BAR __builtin_amdgcn_s_barrier()
#define PG8_SCHED __builtin_amdgcn_sched_barrier(0)
    Unit cur, nxt; int ui = 0;
    if (!S.next(0, cur)) return;
    f32x4 acc[2][2][4][2];
#pragma unroll
    for (int a = 0; a < 2; ++a)
#pragma unroll
        for (int b = 0; b < 2; ++b)
#pragma unroll
            for (int m = 0; m < 4; ++m)
#pragma unroll
                for (int n = 0; n < 2; ++n) acc[a][b][m][n] = (f32x4){0.f, 0.f, 0.f, 0.f};
    bf16x8 At[4][2], B0[2][2], B1[2][2];
    const char* cA = (const char*)g.A + (size_t)cur.pm * tstep; const char* cB = (const char*)g.Bt + (size_t)cur.pn * tstep;
    S.a_ready(cur);
    if constexpr (SP2) {
        PG8_STAGE(PG8_SB(0, 0), cB, voffB); PG8_STAGE(PG8_SB(0, 1), cB + hstep, voffB); PG8_STAGE(PG8_SA(0, 0), cA, voffA); PG8_STAGE(PG8_SA(0, 1), cA + hstep, voffA);
        if (wr == 1) PG8_BAR;
        PG8_WAIT_V(2); PG8_BAR;
        PG8_STAGE(PG8_SB(1, 0), cB + kstep, voffB); PG8_STAGE(PG8_SA(1, 0), cA + kstep, voffA); PG8_STAGE(PG8_SB(1, 1), cB + hstep + kstep, voffB);
        PG8_WAIT_V(6); PG8_BAR;
    } else {
        PG8_STAGE(PG8_SB(0, 0), cB, voffB); PG8_STAGE(PG8_SA(0, 0), cA, voffA); PG8_STAGE(PG8_SB(0, 1), cB + hstep, voffB); PG8_STAGE(PG8_SA(0, 1), cA + hstep, voffA);
        if (wr == 1) PG8_BAR;
        PG8_WAIT_V(4); PG8_BAR;
        PG8_STAGE(PG8_SB(1, 0), cB + kstep, voffB); PG8_STAGE(PG8_SA(1, 0), cA + kstep, voffA); PG8_STAGE(PG8_SB(1, 1), cB + hstep + kstep, voffB);
        PG8_WAIT_V(6); PG8_BAR;
    }
    for (;;) {
        const bool has_next = S.next(ui + 1, nxt);
        const char* nA = has_next ? (const char*)g.A + (size_t)nxt.pm * tstep : cA; const char* nB = has_next ? (const char*)g.Bt + (size_t)nxt.pn * tstep : cB;
        for (int t = 0; t < nt; t += 2) {
            const bool last = (t == nt - 2);
            const char* a1 = cA + (size_t)(t + 1) * kstep;
            const char* a2 = last ? nA : cA + (size_t)(t + 2) * kstep; const char* b2 = last ? nB : cB + (size_t)(t + 2) * kstep;
            const char* a3 = a2 + kstep; const char* b3 = b2 + kstep;
            if (last && has_next) S.a_ready(nxt);
            if constexpr (SP2) {
            PG8_LDB(B0, 0, 0); PG8_LDB(B1, 0, 1); PG8_SCHED; PG8_LDA(At, 0, 0); PG8_STAGE(PG8_SA(1, 1), a1 + hstep, voffA);
            PG8_WAIT_V(8); PG8_WAIT_L(0); PG8_BAR; PG8_MMA(0, 0, At, B0); PG8_MMA(0, 1, At, B1); PG8_BAR; PG8_SCHED;
            PG8_LDA(At, 0, 1); PG8_STAGE(PG8_SB(0, 0), b2, voffB); PG8_STAGE(PG8_SB(0, 1), b2 + hstep, voffB); PG8_STAGE(PG8_SA(0, 0), a2, voffA);
            PG8_WAIT_V(8); PG8_WAIT_L(0); PG8_BAR; PG8_MMA(1, 0, At, B0); PG8_MMA(1, 1, At, B1); PG8_BAR; PG8_SCHED;
            PG8_LDB(B0, 1, 0); PG8_LDB(B1, 1, 1); PG8_SCHED; PG8_LDA(At, 1, 0); PG8_STAGE(PG8_SA(0, 1), a2 + hstep, voffA);
            PG8_WAIT_V(8); PG8_WAIT_L(0); PG8_BAR; PG8_MMA(0, 0, At, B0); PG8_MMA(0, 1, At, B1); PG8_BAR; PG8_SCHED;
            PG8_LDA(At, 1, 1); PG8_STAGE(PG8_SB(1, 0), b3, voffB); PG8_STAGE(PG8_SB(1, 1), b3 + hstep, voffB); PG8_STAGE(PG8_SA(1, 0), a3, voffA);
            PG8_WAIT_V(8); PG8_WAIT_L(0); PG8_BAR; PG8_MMA(1, 0, At, B0); PG8_MMA(1, 1, At, B1); PG8_BAR; PG8_SCHED;
            } else {
            PG8_LDB(B0, 0, 0); PG8_SCHED; PG8_LDA(At, 0, 0); PG8_STAGE(PG8_SA(1, 1), a1 + hstep, voffA);
            PG8_WAIT_L(8); PG8_BAR; PG8_WAIT_L(0); PG8_MMA(0, 0, At, B0); PG8_BAR; PG8_SCHED;
            PG8_LDB(B1, 0, 1); PG8_STAGE(PG8_SB(0, 0), b2, voffB);
            PG8_BAR; PG8_WAIT_L(0); PG8_MMA(0, 1, At, B1); PG8_BAR;
            PG8_LDA(At, 0, 1); PG8_STAGE(PG8_SA(0, 0), a2, voffA);
            PG8_BAR; PG8_WAIT_L(0); PG8_MMA(1, 0, At, B0); PG8_BAR; PG8_SCHED;
            PG8_STAGE(PG8_SB(0, 1), b2 + hstep, voffB);
            PG8_WAIT_V(6); PG8_BAR; PG8_MMA(1, 1, At, B1); PG8_BAR;
            PG8_LDB(B0, 1, 0); PG8_SCHED; PG8_LDA(At, 1, 0); PG8_STAGE(PG8_SA(0, 1), a2 + hstep, voffA);
            PG8_WAIT_L(8); PG8_BAR; PG8_WAIT_L(0); PG8_MMA(0, 0, At, B0); PG8_BAR; PG8_SCHED;
            PG8_LDB(B1, 1, 1); PG8_STAGE(PG8_SB(1, 0), b3, voffB);
            PG8_BAR; PG8_WAIT_L(0); PG8_MMA(0, 1, At, B1); PG8_BAR;
            PG8_LDA(At, 1, 1); PG8_STAGE(PG8_SA(1, 0), a3, voffA);
            PG8_BAR; PG8_WAIT_L(0); PG8_MMA(1, 0, At, B0); PG8_BAR; PG8_SCHED;
            PG8_STAGE(PG8_SB(1, 1), b3 + hstep, voffB);
            PG8_WAIT_V(6); PG8_BAR; PG8_MMA(1, 1, At, B1); PG8_BAR;
            }
        }
        if constexpr (ALIGN_EPI) { if (wr == 0) PG8_BAR; }
        if constexpr (!Epi::AFTER_DRAIN) { E(acc, cur, wr, wc, fr, fq); S.done(cur); }
        if (!has_next) break;
#pragma unroll
        for (int a = 0; a < 2; ++a)
#pragma unroll
            for (int b = 0; b < 2; ++b)
#pragma unroll
                for (int m = 0; m < 4; ++m)
#pragma unroll
                    for (int n = 0; n < 2; ++n) acc[a][b][m][n] = (f32x4){0.f, 0.f, 0.f, 0.f};
        cur = nxt; cA = nA; cB = nB; ++ui;
        if constexpr (ALIGN_EPI) { if (wr == 1) PG8_BAR; }
    }
    PG8_WAIT_V(0);
    if constexpr (!ALIGN_EPI) { if (wr == 0) PG8_BAR; }
    PG8_BAR;
    if constexpr (Epi::AFTER_DRAIN) { E.fused(acc, cur, wr, wc, fr, fq, lds, wid, lane); S.done(cur); }
#undef PG8_SA
#undef PG8_SB
#undef PG8_STAGE
#undef PG8_LDA
#undef PG8_LDB
#undef PG8_MMA
#undef PG8_WAIT_V
#undef PG8_WAIT_L
#undef PG8_BAR
#undef PG8_SCHED
}
}
#include <hip/hip_bf16.h>
#include <cmath>
namespace attn_body {
using bf16=__hip_bfloat16;
using bf16x8=__attribute__((ext_vector_type(8)))short;
using s16x4=__attribute__((ext_vector_type(4)))short;
using f32x16=__attribute__((ext_vector_type(16)))float;
using u32x4=__attribute__((ext_vector_type(4)))unsigned;
using f32x4_t=__attribute__((ext_vector_type(4)))float;
constexpr int BATCH=8,NHEAD=16,SEQ=4096,D=64,DM=NHEAD*D;
constexpr int NW=8,QBLK=32,QB=QBLK*NW,KVBLK=64,NQB=SEQ/QB;
constexpr int ATTN_PITCH=DM, ATTN_UNIT_ROWS=QB;
__device__ __forceinline__ int crow(int r,int hi){return (r&3)+8*(r>>2)+4*hi;}
#define SBAR() __builtin_amdgcn_sched_barrier(0)
__device__ __forceinline__ void cmask(f32x16&p0,f32x16&p1,int jb,int qrel,int hi){
  const float NEG=-INFINITY; int kb=64*jb+4*hi;
  #pragma unroll
  for(int r=0;r<16;++r){int kv=kb+(r&3)+8*(r>>2); if(kv>qrel)p0[r]=NEG; if(kv+32>qrel)p1[r]=NEG;}
}

constexpr int NSLOT=3, SLOTB=8192;
constexpr int LDS_K=0, LDS_V=NSLOT*SLOTB, LDS_WS=2*NSLOT*SLOTB, LDS_OST=LDS_WS+NW*64*4, LDS_LUTB=LDS_OST+NW*4096, LUTL_OFF=256, LUTL_N=SEQ+LUTL_OFF, LUTC_N=2048, LUTC_STRIDE=LUTC_N*4+64, LDS_LUTC=LDS_LUTB+LUTL_N*4+64, LDS_KMF=LDS_LUTC+3*LUTC_STRIDE, LDS_BND=LDS_KMF+16*64*2, LDS_BYTES=LDS_BND+32*4;
constexpr float C2=0.125f*1.4426950408889634f; constexpr int GLUT_OFF=256, GLUT_N=SEQ+GLUT_OFF;
__device__ __forceinline__ void glds16(const void*gsrc,unsigned lds_dst){unsigned keep;
  asm volatile("s_mov_b32 %0, m0\n\ts_mov_b32 m0, %2\n\ts_nop 0\n\tglobal_load_lds_dwordx4 %1, off\n\ts_mov_b32 m0, %0":"=&s"(keep):"v"(gsrc),"s"(lds_dst):"memory");}
__device__ __forceinline__ float max3f(float a,float b,float c){float r;asm("v_max3_f32 %0, %1, %2, %3":"=v"(r):"v"(a),"v"(b),"v"(c));return r;}
__device__ __forceinline__ float max2f(float a,float b){float r;asm("v_max_f32_e32 %0, %1, %2":"=v"(r):"v"(a),"v"(b));return r;}
__device__ __forceinline__ float fadd_s(float a,float b){float r;asm("v_add_f32_e32 %0, %1, %2":"=v"(r):"v"(a),"v"(b));return r;}
__device__ __forceinline__ float fsub_s(float a,float b){float r;asm("v_sub_f32_e32 %0, %1, %2":"=v"(r):"v"(a),"v"(b));return r;}
typedef float f32x2_t __attribute__((ext_vector_type(2))); typedef __bf16 bf16x2_t __attribute__((ext_vector_type(2)));
__device__ __forceinline__ unsigned cvtpk_s(float lo,float hi){f32x2_t v={lo,hi};bf16x2_t b=__builtin_convertvector(v,bf16x2_t);return __builtin_bit_cast(unsigned,b);}
#define WAIT_BAR(N) asm volatile("s_waitcnt vmcnt(" #N ") lgkmcnt(0)\n\ts_barrier":::"memory")

__device__ __forceinline__ void qkt(f32x16&p0,f32x16&p1,const char*Kslot,const bf16x8*qr,int r32,int hi){
  const char*kb=Kslot+hi*1024+r32*16;
  #pragma unroll
  for(int d0=0;d0<4;++d0){
    const bf16x8 b0=*reinterpret_cast<const bf16x8*>(kb+d0*2048);
    const bf16x8 b1=*reinterpret_cast<const bf16x8*>(kb+d0*2048+512);
    {p0=__builtin_amdgcn_mfma_f32_32x32x16_bf16(b0,qr[d0],p0,0,0,0);p1=__builtin_amdgcn_mfma_f32_32x32x16_bf16(b1,qr[d0],p1,0,0,0);}}
}
typedef __attribute__((address_space(3))) const char* lds_cptr; typedef __attribute__((address_space(3))) float* lds_fptr;
typedef short v4i16_t __attribute__((ext_vector_type(4)));
__device__ __forceinline__ void kload8(bf16x8*kf,lds_cptr kp){
  kf[0]=*(const __attribute__((address_space(3))) bf16x8*)(kp);      kf[1]=*(const __attribute__((address_space(3))) bf16x8*)(kp+512);
  kf[2]=*(const __attribute__((address_space(3))) bf16x8*)(kp+2048); kf[3]=*(const __attribute__((address_space(3))) bf16x8*)(kp+2560);
  kf[4]=*(const __attribute__((address_space(3))) bf16x8*)(kp+4096); kf[5]=*(const __attribute__((address_space(3))) bf16x8*)(kp+4608);
  kf[6]=*(const __attribute__((address_space(3))) bf16x8*)(kp+6144); kf[7]=*(const __attribute__((address_space(3))) bf16x8*)(kp+6656);
}
__device__ __forceinline__ void kload2(bf16x8*kf,lds_cptr kp,int j){ kf[2*j]=*(const __attribute__((address_space(3))) bf16x8*)(kp+j*2048); kf[2*j+1]=*(const __attribute__((address_space(3))) bf16x8*)(kp+j*2048+512); }
__device__ __forceinline__ s16x4 vtr(lds_cptr p){ return __builtin_bit_cast(s16x4,__builtin_amdgcn_ds_read_tr16_b64_v4i16((__attribute__((address_space(3))) v4i16_t*)p)); }
__device__ __forceinline__ float rowmax(const f32x16&p0,const f32x16&p1){
  float a=max3f(p0[0],p0[1],p1[0]),b=max3f(p0[2],p0[3],p1[1]);a=max3f(a,p1[2],p1[3]);
  #pragma unroll
  for(int r=4;r<16;r+=4){a=max3f(a,p0[r],p0[r+1]);b=max3f(b,p0[r+2],p0[r+3]);a=max3f(a,p1[r],p1[r+1]);b=max3f(b,p1[r+2],p1[r+3]);}
  const float m=max2f(a,b);
  auto rr=__builtin_amdgcn_permlane32_swap(__float_as_uint(m),__float_as_uint(m),false,false);
  return max2f(__uint_as_float(rr[0]),__uint_as_float(rr[1]));
}
__device__ __forceinline__ void pv(f32x16*o,int vb,bf16x8 pa0,bf16x8 pa1,bf16x8 pa2,bf16x8 pa3){
  #pragma unroll
  for(int d0=0;d0<2;++d0){s16x4 lo[4],hi[4];
    #pragma unroll
    for(int ks=0;ks<4;++ks){
      asm volatile("ds_read_b64_tr_b16 %0,%1 offset:%c2":"=&v"(lo[ks]):"v"(vb),"i"(d0*4096+ks*1024):"memory");
      asm volatile("ds_read_b64_tr_b16 %0,%1 offset:%c2":"=&v"(hi[ks]):"v"(vb),"i"(d0*4096+ks*1024+512):"memory");}
    asm volatile("s_waitcnt lgkmcnt(0)":::"memory");SBAR();
    #define PK(k) (bf16x8){lo[k][0],lo[k][1],lo[k][2],lo[k][3],hi[k][0],hi[k][1],hi[k][2],hi[k][3]}
    o[d0]=__builtin_amdgcn_mfma_f32_32x32x16_bf16(pa0,PK(0),o[d0],0,0,0);
    o[d0]=__builtin_amdgcn_mfma_f32_32x32x16_bf16(pa1,PK(1),o[d0],0,0,0);
    o[d0]=__builtin_amdgcn_mfma_f32_32x32x16_bf16(pa2,PK(2),o[d0],0,0,0);
    o[d0]=__builtin_amdgcn_mfma_f32_32x32x16_bf16(pa3,PK(3),o[d0],0,0,0);
    #undef PK
  }
}

#ifndef ATTN_STORE16
#define ATTN_STORE16(p,v) (*(u32x4*)(p)=(v))
#endif
template<int THRL,int PLAIN=0> __device__ __forceinline__ void attn_unit(int b,int h,int qb,const bf16*Q,const bf16*K,const bf16*V,bf16*O,const float*KM,const float*GLUT,char*shm,bool newhead,bool newbh,bool pre,bool nextsame){
  int tid_=threadIdx.x; asm volatile("":"+v"(tid_));
  const int tid=tid_,lane=tid&63,r32=lane&31,hi=lane>>5; const int wid=__builtin_amdgcn_readfirstlane(tid>>6);
  const long rowbase=(long)b*SEQ; const int q0=qb*QB;
  const bf16*Qw=Q+(rowbase+q0+wid*QBLK)*DM+h*D;
  const bf16*Kh=K+rowbase*DM+h*D,*Vh=V+rowbase*DM+h*D;
  const unsigned lds0=(unsigned)(uintptr_t)shm; const lds_cptr shm3=(lds_cptr)shm;
  float*wsf=(float*)(shm+LDS_WS)+wid*64;
  const bf16*ksrc=Kh+(long)lane*DM+wid*8;
  const bf16*vsrc=Vh+(long)(16*(wid&3)+(lane>>2))*DM+(wid>>2)*32+(lane&3)*8;
  const unsigned kdst=lds0+LDS_K+wid*1024, vdst=lds0+LDS_V+wid*1024;
  #define DMA_K(t,slot) glds16(ksrc+(long)(t)*KVBLK*DM,(unsigned)__builtin_amdgcn_readfirstlane(kdst+(slot)))
  #define DMA_V(t,slot) glds16(vsrc+(long)(t)*KVBLK*DM,(unsigned)__builtin_amdgcn_readfirstlane(vdst+(slot)))
  const int vb0=(int)(lds0+LDS_V)+((lane>>4)&1)*32+(lane&3)*8+(4*hi+((lane&15)>>2))*64;
  const char*Kbase=shm+LDS_K; bf16x8 kf[8];
  const lds_cptr kp0=shm3+LDS_K+hi*1024+r32*16; const lds_cptr vp0=shm3+LDS_V+((lane>>4)&1)*32+(lane&3)*8+(4*hi+((lane&15)>>2))*64;
  const int NT=(q0+QB)/KVBLK;
  if(newbh&&PLAIN!=1&&PLAIN!=4){
    __syncthreads();
    for(int e=tid;e<16*64;e+=NW*64){ const float*kp_=KM+((long)b*16+(e>>6))*DM+h*D+(e&63); ((__attribute__((address_space(3))) unsigned short*)(shm3+LDS_KMF))[e]=(unsigned short)(cvtpk_s(kp_[0]+kp_[BATCH*16*DM],0.f)&0xffffu); }
    __syncthreads(); }
  if(newhead&&tid<32){ const int b_=tid; int fd_=b_;
    if(b_>=16){ const int th_[16]={16,22,30,40,54,73,99,134,182,246,332,450,609,825,1117,1513}; fd_=16;
      #pragma unroll
      for(int i_=1;i_<16;++i_) fd_=(b_-16==i_)?th_[i_]:fd_; }
    ((__attribute__((address_space(3))) int*)(shm3+LDS_BND))[b_]=fd_; }
  if(newhead){ lds_fptr lutw=(lds_fptr)(shm3+LDS_LUTB); const float*gl=GLUT+(long)h*GLUT_N+(GLUT_OFF-LUTL_OFF);
    for(int i=tid;i<LUTL_N;i+=NW*64){ const int n=i-LUTL_OFF>0?i-LUTL_OFF:0; int bk=n;
        if(n>=16){ bk=16+(n>=22)+(n>=30)+(n>=40)+(n>=54)+(n>=73)+(n>=99)+(n>=134)+(n>=182)+(n>=246)+(n>=332)+(n>=450)+(n>=609)+(n>=825)+(n>=1117)+(n>=1513); }
        const float w_=__uint_as_float((__float_as_uint(gl[i]*1.4426950408889634f)&~31u)|(unsigned)bk); lutw[i]=w_;
        #pragma unroll
        for(int c_=1;c_<4;++c_){ const int ic_=i-c_; if(ic_>=0&&ic_<LUTC_N) ((lds_fptr)(shm3+LDS_LUTC+(c_-1)*LUTC_STRIDE))[ic_]=w_; } } }
  if(!pre){DMA_K(0,0);DMA_V(0,0);DMA_K(1,SLOTB);}
  bf16x8 qr[4];
  #pragma unroll
  for(int d0=0;d0<4;++d0)qr[d0]=*reinterpret_cast<const bf16x8*>(&Qw[(long)r32*DM+d0*16+hi*8]);
  unsigned selmask=0u;
  if(PLAIN==4) selmask=~0u;
  if(qb>0&&PLAIN!=4){ f32x16 g=f32x16{};
    #pragma unroll
    for(int d0=0;d0<4;++d0){ const bf16x8 kmf=*(__attribute__((address_space(3))) const bf16x8*)(shm3+LDS_KMF+(r32&15)*128+(d0*16+hi*8)*2); g=__builtin_amdgcn_mfma_f32_32x32x16_bf16(kmf,qr[d0],g,0,0,0); }
    float G[16];
    #pragma unroll
    for(int i=0;i<4;++i){ const auto ra_=__builtin_amdgcn_permlane32_swap(__float_as_uint(g[i]),__float_as_uint(g[i]),false,false), rb_=__builtin_amdgcn_permlane32_swap(__float_as_uint(g[4+i]),__float_as_uint(g[4+i]),false,false);
      G[i]=__uint_as_float(ra_[0]); G[4+i]=__uint_as_float(ra_[1]); G[8+i]=__uint_as_float(rb_[0]); G[12+i]=__uint_as_float(rb_[1]); }
    float m1_=-INFINITY,m2_=-INFINITY,m3_=-INFINITY;
    #pragma unroll
    for(int i=0;i<15;++i){ const float t0_=(i<qb)?G[i]:-INFINITY; G[i]=t0_; const float t1_=__builtin_fminf(m1_,t0_); m1_=__builtin_fmaxf(m1_,t0_); const float t2_=__builtin_fminf(m2_,t1_); m2_=__builtin_fmaxf(m2_,t1_); m3_=__builtin_fmaxf(m3_,t2_); }
    unsigned gt_=0u,ge_=0u;
    #pragma unroll
    for(int j=14;j>=0;--j){ gt_=gt_+gt_+(unsigned)(G[j]>m3_); ge_=ge_+ge_+(unsigned)(G[j]>=m3_); }
    { const unsigned eq_=ge_^gt_; const int need_=3-__builtin_popcount(gt_);
      const unsigned e1_=eq_&(0u-eq_), r1_=eq_^e1_, e2_=r1_&(0u-r1_), r2_=r1_^e2_, e3_=r2_&(0u-r2_);
      selmask=(gt_|e1_|(need_>=2?e2_:0u)|(need_>=3?e3_:0u))&((1u<<qb)-1u); } }
  const lds_fptr lutu=(lds_fptr)(shm3+LDS_LUTB)+(LUTL_OFF+q0+wid*QBLK);
  typedef __attribute__((address_space(3))) const f32x4_t* lds_f4ptr;
  const int lc_=(r32+1)&3;
  const lds_fptr lutq4=(lds_fptr)(shm3+(lc_==0?LDS_LUTB:LDS_LUTC+(lc_-1)*LUTC_STRIDE))+(LUTL_OFF-3+q0+wid*QBLK+r32-4*hi-lc_);
  const lds_fptr lutq=(lds_fptr)(shm3+LDS_LUTB)+(LUTL_OFF-59+q0+wid*QBLK+r32-4*hi);
  float mhat=0.f,l_reg=0.f;f32x16 o[2];o[0]=f32x16{};o[1]=f32x16{};
  const int qrel=wid*QBLK+r32;
  const int qlh_=q0+qrel-4*hi;
  #define CMASK(P0,P1,t) do{int jb_=(t)-(NT-4); if(jb_>=0)cmask(P0,P1,jb_,qrel,hi);}while(0)
  #define BIAS(P0,P1,t) do{ if(PLAIN==1){ _Pragma("unroll") for(int r_=0;r_<16;++r_){ P0[r_]=-mhat; P1[r_]=-mhat; } SBAR(); } else { \
      const bool keep_=((t)>=NT-4)||((selmask>>((t)>>2))&1u); const float mh_=keep_?mhat:INFINITY; \
      const lds_fptr lu_=lutu-64*(t); const unsigned umax_=__builtin_amdgcn_readfirstlane(__float_as_uint(lu_[31])), umin_=__builtin_amdgcn_readfirstlane(__float_as_uint(lu_[-63])); \
      if(PLAIN!=3&&(PLAIN==2||PLAIN==4||((umax_^umin_)&31u)==0u)){ const float cv_=__uint_as_float(umax_)-mh_; _Pragma("unroll") for(int r_=0;r_<16;++r_){ P0[r_]=cv_; P1[r_]=cv_; } } \
      else if(PLAIN==0&&((umax_&31u)-(umin_&31u))==1u){   \
        const int bd_=__builtin_amdgcn_readfirstlane(((__attribute__((address_space(3))) const int*)(shm3+LDS_BND))[umax_&31u]); \
        const int dq_=qlh_-(64*(t)+bd_); const float va_=__uint_as_float(umin_)-mh_, vb_=__uint_as_float(umax_)-mh_; \
        _Pragma("unroll") for(int g_=0;g_<4;++g_){ _Pragma("unroll") for(int k_=0;k_<4;++k_){ P0[4*g_+k_]=(dq_>=8*g_+k_)?vb_:va_; P1[4*g_+k_]=(dq_>=32+8*g_+k_)?vb_:va_; } } } \
      else { const lds_fptr lp_=lutq4-64*(t); _Pragma("unroll") for(int g_=0;g_<4;++g_){ \
        const f32x4_t b0_=*(lds_f4ptr)(lp_-8*g_), b1_=*(lds_f4ptr)(lp_-8*g_-32); \
        _Pragma("unroll") for(int k_=0;k_<4;++k_){ P0[4*g_+k_]=b0_[3-k_]-mh_; P1[4*g_+k_]=b1_[3-k_]-mh_; } } } SBAR(); } }while(0)
  #define MMASK(P0,P1,t) do{}while(0)
  bool resc=false;
  #define START(P0,P1) do{ const float rm=rowmax(P0,P1); resc=false; \
    { const float dl=max2f(rm,-64.f); mhat=fadd_s(mhat,dl); \
      _Pragma("unroll") for(int r=0;r<16;++r){P0[r]=fsub_s(P0[r],dl);P1[r]=fsub_s(P1[r],dl);} \
      } \
    _Pragma("unroll") for(int r=0;r<16;++r)P0[r]=__builtin_amdgcn_exp2f(P0[r]); }while(0)
  #define RESC() do{ if(resc){ asm volatile("s_waitcnt lgkmcnt(0)":::"memory"); \
      _Pragma("unroll") for(int d_=0;d_<2;++d_) _Pragma("unroll") for(int r=0;r<16;++r)o[d_][r]*=wsf[crow(r,hi)]; } }while(0)
  f32x16 pA0,pA1,pB0,pB1;
  int sl_prev=0,sl_cur=0,sl_next=SLOTB;
  #define ROT() do{sl_prev=sl_cur;sl_cur=sl_next;sl_next=(sl_next==(NSLOT-1)*SLOTB)?0:sl_next+SLOTB;}while(0)
  DMA_K(2,2*SLOTB);
  WAIT_BAR(3);
  BIAS(pA0,pA1,0);qkt(pA0,pA1,Kbase,qr,r32,hi);asm volatile("s_nop 15\n\ts_nop 7":"+v"(pA0),"+v"(pA1));if(NT>4){MMASK(pA0,pA1,0);}CMASK(pA0,pA1,0);
  START(pA0,pA1);
  _Pragma("unroll") for(int r=0;r<16;++r)pA1[r]=__builtin_amdgcn_exp2f(pA1[r]);
  WAIT_BAR(0);
  DMA_K(3,0);DMA_V(1,SLOTB);
  ROT();
  kload8(kf,kp0+sl_cur);
  WAIT_BAR(2);
  s16x4 vlo[8],vhi[8]; u32x4 pw0,pw1,pw2,pw3;
  #define PKW(P,B) cvtpk_s(P[B],P[B+1])
  #define PAF(k) __builtin_bit_cast(bf16x8,pw##k)
  #define VFR(i) (bf16x8){vlo[i][0],vlo[i][1],vlo[i][2],vlo[i][3],vhi[i][0],vhi[i][1],vhi[i][2],vhi[i][3]}
  #define PIN(x) asm volatile("":"+v"(x))
  #define MX3(a,b,c) __builtin_fmaxf(__builtin_fmaxf((a),(b)),(c))
  #define GAPA(MF,A0,A1,A2,A3,W0,W1,PW) do{ MF; sacc+=A0; sacc+=A1; sacc+=A2; sacc+=A3; PIN(sacc); W0; W1; PIN(PW); SBAR(); }while(0)
  #define EX(v) __builtin_amdgcn_exp2f(v)
  #define GAPB(MF,X,B) do{ MF; X[B]=EX(X[B]); X[B+1]=EX(X[B+1]); X[B+2]=EX(X[B+2]); X[B+3]=EX(X[B+3]); PIN(X); SBAR(); }while(0)
  #define VRD(i) do{ vlo[i]=vtr(vp_+(((i)>>2)*4096+((i)&3)*1024)); vhi[i]=vtr(vp_+(((i)>>2)*4096+((i)&3)*1024+512)); }while(0)
  #define KRD(G,j) do{ if(G){ kload2(kf,kp0+sl_next,j); SBAR(); } }while(0)
  #define STEP(C0,C1,P0,P1,t,GK,GV,GL) do{ SBAR(); BIAS(C0,C1,t); \
    const lds_cptr vp_=vp0+sl_prev; \
    VRD(0); SBAR(); float sacc=(P0[0]+P0[1]); \
    GAPA(C0=__builtin_amdgcn_mfma_f32_32x32x16_bf16(kf[0],qr[0],C0,0,0,0), P0[2],P0[3],P0[4],P0[5],     pw0[0]=PKW(P0,0), pw0[1]=PKW(P0,2), pw0); \
    VRD(4); SBAR(); GAPA(C1=__builtin_amdgcn_mfma_f32_32x32x16_bf16(kf[1],qr[0],C1,0,0,0), P0[6],P0[7],P0[8],P0[9],     pw0[2]=PKW(P0,4), pw0[3]=PKW(P0,6), pw0); \
    VRD(1); SBAR(); GAPA(C0=__builtin_amdgcn_mfma_f32_32x32x16_bf16(kf[2],qr[1],C0,0,0,0),   P0[10],P0[11],P0[12],P0[13], pw1[0]=PKW(P0,8), pw1[1]=PKW(P0,10), pw1); \
    VRD(5); SBAR(); GAPA(C1=__builtin_amdgcn_mfma_f32_32x32x16_bf16(kf[3],qr[1],C1,0,0,0),   P0[14],P0[15],P1[0],P1[1],   pw1[2]=PKW(P0,12),pw1[3]=PKW(P0,14), pw1); \
    VRD(2); SBAR(); GAPA(C0=__builtin_amdgcn_mfma_f32_32x32x16_bf16(kf[4],qr[2],C0,0,0,0),   P1[2],P1[3],P1[4],P1[5],     pw2[0]=PKW(P1,0), pw2[1]=PKW(P1,2), pw2); \
    VRD(6); SBAR(); GAPA(C1=__builtin_amdgcn_mfma_f32_32x32x16_bf16(kf[5],qr[2],C1,0,0,0),   P1[6],P1[7],P1[8],P1[9],     pw2[2]=PKW(P1,4), pw2[3]=PKW(P1,6), pw2); \
    VRD(3); SBAR(); GAPA(C0=__builtin_amdgcn_mfma_f32_32x32x16_bf16(kf[6],qr[3],C0,0,0,0),   P1[10],P1[11],P1[12],P1[13], pw3[0]=PKW(P1,8), pw3[1]=PKW(P1,10), pw3); \
    VRD(7); SBAR(); GAPA(C1=__builtin_amdgcn_mfma_f32_32x32x16_bf16(kf[7],qr[3],C1,0,0,0),   P1[14],P1[15],0.f,0.f,       pw3[2]=PKW(P1,12),pw3[3]=PKW(P1,14), pw3); \
    l_reg+=sacc; \
    if(GK){DMA_K((t)+3,sl_cur);} if(GV){DMA_V((t)+1,sl_next);} \
    MMASK(C0,C1,t); CMASK(C0,C1,t); \
    { float a=MX3(C0[0],C0[1],C1[0]),b=MX3(C0[2],C0[3],C1[1]); a=MX3(a,C1[2],C1[3]); \
      _Pragma("unroll") for(int r=4;r<16;r+=4){a=MX3(a,C0[r],C0[r+1]);b=MX3(b,C0[r+2],C0[r+3]);a=MX3(a,C1[r],C1[r+1]);b=MX3(b,C1[r+2],C1[r+3]);} \
      float rm=__builtin_fmaxf(a,b); { auto rr=__builtin_amdgcn_permlane32_swap(__float_as_uint(rm),__float_as_uint(rm),false,false); rm=__builtin_fmaxf(__uint_as_float(rr[0]),__uint_as_float(rr[1])); } \
      resc=false; \
      if(__builtin_expect(__any(rm>(float)THRL),0)){ const float dl=__builtin_fmaxf(rm,0.f); mhat+=dl; \
        _Pragma("unroll") for(int r=0;r<16;++r){C0[r]-=dl;C1[r]-=dl;} \
        const float f=__builtin_amdgcn_exp2f(-dl); l_reg*=f; if(hi==0)wsf[r32]=f; resc=true; } } \
    SBAR(); \
    GAPB(o[0]=__builtin_amdgcn_mfma_f32_32x32x16_bf16(PAF(0),VFR(0),o[0],0,0,0), C0,0); \
    GAPB(o[1]=__builtin_amdgcn_mfma_f32_32x32x16_bf16(PAF(0),VFR(4),o[1],0,0,0), C0,4); \
    KRD(GL,0); GAPB(o[0]=__builtin_amdgcn_mfma_f32_32x32x16_bf16(PAF(1),VFR(1),o[0],0,0,0), C0,8); \
    KRD(GL,1); GAPB(o[1]=__builtin_amdgcn_mfma_f32_32x32x16_bf16(PAF(1),VFR(5),o[1],0,0,0), C0,12); \
    KRD(GL,2); GAPB(o[0]=__builtin_amdgcn_mfma_f32_32x32x16_bf16(PAF(2),VFR(2),o[0],0,0,0), C1,0); \
    KRD(GL,3); GAPB(o[1]=__builtin_amdgcn_mfma_f32_32x32x16_bf16(PAF(2),VFR(6),o[1],0,0,0), C1,4); \
    GAPB(o[0]=__builtin_amdgcn_mfma_f32_32x32x16_bf16(PAF(3),VFR(3),o[0],0,0,0), C1,8); \
    GAPB(o[1]=__builtin_amdgcn_mfma_f32_32x32x16_bf16(PAF(3),VFR(7),o[1],0,0,0), C1,12); \
    }while(0)
  int t=1;
  #undef CMASK
  #define CMASK(P0,P1,t) do{}while(0)
  for(;t+5<NT;t+=2){
    STEP(pB0,pB1,pA0,pA1,t,true,true,true);     WAIT_BAR(2); RESC(); ROT();
    STEP(pA0,pA1,pB0,pB1,t+1,true,true,true);   WAIT_BAR(2); RESC(); ROT();
  }
  #undef CMASK
  #define CMASK(P0,P1,t) do{int jb_=(t)-(NT-4); if(jb_>=0)cmask(P0,P1,jb_,qrel,hi);}while(0)
  #define ENDW(tt) do{ if((tt)+3<NT){WAIT_BAR(2);} else if((tt)+2<NT){WAIT_BAR(1);} else {WAIT_BAR(0);} }while(0)
  for(;t+1<NT;t+=2){
    STEP(pB0,pB1,pA0,pA1,t,(t+3<NT),(t+1<NT),(t+1<NT));       ENDW(t);   RESC(); ROT();
    STEP(pA0,pA1,pB0,pB1,t+1,(t+4<NT),(t+2<NT),(t+2<NT));     ENDW(t+1); RESC(); ROT();
  }
  STEP(pB0,pB1,pA0,pA1,NT-1,false,false,false); RESC();
  { float sacc=pB0[0]+pB0[1]; _Pragma("unroll") for(int r=2;r<16;++r)sacc+=pB0[r]; _Pragma("unroll") for(int r=0;r<16;++r)sacc+=pB1[r]; l_reg+=sacc;
    pw0=(u32x4){PKW(pB0,0),PKW(pB0,2),PKW(pB0,4),PKW(pB0,6)};pw1=(u32x4){PKW(pB0,8),PKW(pB0,10),PKW(pB0,12),PKW(pB0,14)};pw2=(u32x4){PKW(pB1,0),PKW(pB1,2),PKW(pB1,4),PKW(pB1,6)};pw3=(u32x4){PKW(pB1,8),PKW(pB1,10),PKW(pB1,12),PKW(pB1,14)};
    SBAR(); pv(o,vb0+sl_cur,PAF(0),PAF(1),PAF(2),PAF(3)); }
  asm volatile("s_waitcnt lgkmcnt(0)\n\ts_barrier":::"memory");
  if(nextsame){DMA_K(0,0);DMA_V(0,0);DMA_K(1,SLOTB);}
  #undef PKW
  #undef PAF
  #undef VFR
  #undef PIN
  #undef MX3
  #undef GAPA
  #undef GAPB
  #undef EX
  #undef VRD
  #undef KRD
  #undef STEP
  #undef ENDW
  {auto rr=__builtin_amdgcn_permlane32_swap(__float_as_uint(l_reg),__float_as_uint(l_reg),false,false);l_reg=__uint_as_float(rr[0])+__uint_as_float(rr[1]);}
  if(hi==0)wsf[32+r32]=l_reg;asm volatile("s_waitcnt lgkmcnt(0)":::"memory");
  float rli[16];
  #pragma unroll
  for(int r=0;r<16;++r)rli[r]=__builtin_amdgcn_rcpf(wsf[32+crow(r,hi)]);
  bf16*Ow=O+(rowbase+q0+wid*QBLK)*DM+h*D;
  { bf16*stg=(bf16*)(shm+LDS_OST)+wid*2048;
    #pragma unroll
    for(int r=0;r<16;++r){const int orow=crow(r,hi);
      #pragma unroll
      for(int d0=0;d0<2;++d0)stg[orow*64+d0*32+r32]=__float2bfloat16(o[d0][r]*rli[r]);}
    asm volatile("s_waitcnt lgkmcnt(0)":::"memory");
    #pragma unroll
    for(int i=0;i<4;++i){const int row=i*8+(lane>>3),ch=lane&7; const u32x4 v=*(const u32x4*)(stg+row*64+ch*8); ATTN_STORE16(Ow+(long)row*DM+ch*8,v);} }
  asm volatile("s_waitcnt lgkmcnt(0)":::"memory");
  #undef DMA_K
  #undef DMA_V
  #undef CMASK
  #undef BIAS
  #undef MMASK
  #undef START
  #undef RESC
  #undef ROT
}
constexpr int ATTN_LDS_BYTES=LDS_BYTES;
struct AttnTensors { const bf16* Q; const bf16* K; const bf16* V; bf16* O; const float* KM; const float* GLUT; };
struct AttnUnit { int bh; int qb; };
struct StaticOrder {
  int vcu,G;
  __device__ __forceinline__ explicit StaticOrder(int grid,int block):vcu((grid%8==0)?(block%8)*(grid/8)+block/8:block),G(grid){}
  __device__ __forceinline__ bool next(int i,AttnUnit&u)const{
    if(G==256){ if(i>=8)return false; const int s=vcu&1; u.bh=vcu>>1; const int k=i>>1; u.qb=(i&1)?(4*k+3-s):(4*k+s); return true; }
    const int L=i*G+vcu; if(L>=BATCH*NHEAD*NQB)return false; u.bh=L/NQB; u.qb=L%NQB; return true; }
  __device__ __forceinline__ void a_ready(const AttnUnit&)const{}
  __device__ __forceinline__ void done(const AttnUnit&)const{}
};
template<class Sched,int THRL=8,int PLAIN=0> __device__ __forceinline__ void attn_phase(char*lds,const AttnTensors&T,const Sched&S){
  AttnUnit u,un;
  int lasth=-1,lastbh=-1; bool have=S.next(0,u),pre=false;
  for(int i=0;have;++i){ const bool hn=S.next(i+1,un); const bool nextsame=hn&&un.bh==u.bh;
    S.a_ready(u); const int hh=u.bh%NHEAD; attn_unit<THRL,PLAIN>(u.bh/NHEAD,hh,u.qb,T.Q,T.K,T.V,T.O,T.KM,T.GLUT,lds,hh!=lasth,u.bh!=lastbh,pre,nextsame); lasth=hh; lastbh=u.bh; S.done(u);
    pre=nextsame; u=un; have=hn; }
}
#undef SBAR
#undef WAIT_BAR
}
constexpr int NWAVES = 8, NTHREADS = 512;
constexpr int BATCH = 8, SEQ = 4096, D = 1024, T = BATCH * SEQ;
constexpr int A_CH = 512, CONV_W = 31, B_HEADS = 8, B_CH = 512, SGU_CHUNK = 128, MIX_IN = 2048;
constexpr int MH = 16, MHD = 64, MBLK = 256, NBLK = SEQ / MBLK, MTOPK = 3;
constexpr int PH = 8, PNK = 128, PNE = PNK * PNK, PDK = 256, PTOPK = 16, PSEL = PH * PTOPK;
constexpr float EPS = 1e-6f;
constexpr int LUT_OFF = 256, LUT_N = SEQ + LUT_OFF;

constexpr size_t MiB = 1u << 20;
constexpr size_t WS_CTL = 0, CTL_ZERO_BYTES = 32 * 1024;
constexpr size_t WS_WIN = 1 * MiB, WS_WOUT = 5 * MiB, WS_WQKV = 7 * MiB, WS_WO = 13 * MiB, WS_WQ = 15 * MiB  , WS_SK = 23 * MiB  ;
constexpr size_t WS_WSC = 24 * MiB + 896 * 1024  ;
constexpr size_t WS_SGW = 24 * MiB  , WS_LUT = 24 * MiB + 512 * 1024  , WS_KMEAN = 25 * MiB  , WS_SSQ = 25 * MiB + 512 * 1024  ;
constexpr size_t WS_PU = 32 * MiB  , WS_PV = 64 * MiB  , WS_PSU = 96 * MiB  , WS_PSV = 96 * MiB + 256 * 1024;
constexpr size_t WS_HA = 160 * MiB;
constexpr size_t WS_R4 = 224 * MiB;
constexpr size_t WS_AGLU = WS_R4, WS_UG = WS_R4 + 32 * MiB, WS_VG = WS_R4 + 64 * MiB, WS_CAT = WS_R4 + 96 * MiB;
constexpr size_t WS_Q = WS_R4, WS_K = WS_R4 + 64 * MiB, WS_V = WS_R4 + 128 * MiB;
constexpr size_t WS_QP = WS_R4;
constexpr size_t WS_PART = WS_R4;
constexpr size_t WS_CB = WS_R4 + 160 * MiB;
constexpr size_t WS_IDX = 416 * MiB, WS_GATE = 432 * MiB, WS_HQ = 448 * MiB  , WS_HQS = 480 * MiB  , WS_SUK = 481 * MiB  , WS_END = 497 * MiB;
constexpr int CW_TMO = 0, CW_BAR = 4096, CW_CMAX = 65536  ;

constexpr int RING_BYTES = 131072, LDSCTL_OFF = RING_BYTES, MISC_OFF = LDSCTL_OFF + 320, LDS_BYTES = 147456;

#define GAS __attribute__((address_space(1)))
#define LAS __attribute__((address_space(3)))
typedef unsigned short bf16;
typedef unsigned v4u __attribute__((ext_vector_type(4)));
typedef unsigned v2u __attribute__((ext_vector_type(2)));
typedef float f32x4 __attribute__((ext_vector_type(4)));
typedef float f32x2 __attribute__((ext_vector_type(2)));
typedef short bf16x8 __attribute__((ext_vector_type(8)));
typedef GAS unsigned gu32;
typedef GAS unsigned long long gu64;
#define RLX_AGENT __ATOMIC_RELAXED, __HIP_MEMORY_SCOPE_AGENT
#define LDS_WAIT() asm volatile("s_waitcnt lgkmcnt(0)" ::: "memory")
#define VM_WAIT() asm volatile("s_waitcnt vmcnt(0)" ::: "memory")
__device__ __forceinline__ unsigned f2bf(float f) { unsigned u = __builtin_bit_cast(unsigned, f); return (u + 0x7fffu + ((u >> 16) & 1u)) >> 16; }
__device__ __forceinline__ unsigned pk2(float lo, float hi) { return f2bf(lo) | (f2bf(hi) << 16); }
__device__ __forceinline__ float bf_lo(unsigned w) { return __builtin_bit_cast(float, w << 16); }
__device__ __forceinline__ float bf_hi(unsigned w) { return __builtin_bit_cast(float, w & 0xffff0000u); }
__device__ __forceinline__ float bf2f(bf16 h) { return __builtin_bit_cast(float, (unsigned)h << 16); }

__device__ __forceinline__ float gelu_tanh(float x) { const float t = 1.5957691216057308f * (x + 0.044715f * x * x * x); return x / (1.0f + __expf(-t)); }
template <int CTRL> __device__ __forceinline__ int dpp_i(int x) { return __builtin_amdgcn_update_dpp(0, x, CTRL, 0xf, 0xf, true); }
template <int CTRL> __device__ __forceinline__ float dpp_f(float x) { return __builtin_bit_cast(float, __builtin_amdgcn_update_dpp(0, __builtin_bit_cast(int, x), CTRL, 0xf, 0xf, true)); }
constexpr int DPP_XOR1 = 0xB1, DPP_XOR2 = 0x4E, DPP_HMIRROR = 0x141, DPP_ROR8 = 0x128;
__device__ __forceinline__ float wave_sum(float v) {
    v += dpp_f<DPP_XOR1>(v); v += dpp_f<DPP_XOR2>(v); v += dpp_f<DPP_HMIRROR>(v); v += dpp_f<DPP_ROR8>(v);
    { const unsigned u = __builtin_bit_cast(unsigned, v); const auto r = __builtin_amdgcn_permlane16_swap(u, u, false, false); v = __builtin_bit_cast(float, (unsigned)r[0]) + __builtin_bit_cast(float, (unsigned)r[1]); }
    { const unsigned u = __builtin_bit_cast(unsigned, v); const auto r = __builtin_amdgcn_permlane32_swap(u, u, false, false); v = __builtin_bit_cast(float, (unsigned)r[0]) + __builtin_bit_cast(float, (unsigned)r[1]); }
    return v;
}
__device__ __forceinline__ float wave_max(float m) {
    m = fmaxf(m, dpp_f<DPP_XOR1>(m)); m = fmaxf(m, dpp_f<DPP_XOR2>(m)); m = fmaxf(m, dpp_f<DPP_HMIRROR>(m)); m = fmaxf(m, dpp_f<DPP_ROR8>(m));
    { const unsigned u = __builtin_bit_cast(unsigned, m); const auto r = __builtin_amdgcn_permlane16_swap(u, u, false, false); m = fmaxf(__builtin_bit_cast(float, (unsigned)r[0]), __builtin_bit_cast(float, (unsigned)r[1])); }
    { const unsigned u = __builtin_bit_cast(unsigned, m); const auto r = __builtin_amdgcn_permlane32_swap(u, u, false, false); m = fmaxf(__builtin_bit_cast(float, (unsigned)r[0]), __builtin_bit_cast(float, (unsigned)r[1])); }
    return m;
}

__device__ __forceinline__ void st_asm16(void* p, const v4u& v) { asm volatile("global_store_dwordx4 %0, %1, off\n\ts_nop 1" :: "v"(p), "v"(v) : "memory"); }
__device__ __forceinline__ void st_asm8(void* p, const v2u& v) { asm volatile("global_store_dwordx2 %0, %1, off\n\ts_nop 1" :: "v"(p), "v"(v) : "memory"); }
__device__ __forceinline__ void st_asm4(void* p, unsigned v) { asm volatile("global_store_dword %0, %1, off\n\ts_nop 1" :: "v"(p), "v"(v) : "memory"); }
#define XB_TMO      128
#define XB_XCNT(j)  (256  + 64 * (j))
#define XB_XSUB(j)  (1280 + 64 * (j))
#define XB_XGEN(j)  (2304 + 64 * (j))
#define XB_TOP      3328
#define XB_TOPGEN   3392
#define XCD_BAR_WORDS 3456
#define XB_SPIN_CAP (1u << 18)

__device__ __forceinline__ unsigned xb_ld(unsigned* p)              { return __hip_atomic_load(p, __ATOMIC_RELAXED, __HIP_MEMORY_SCOPE_AGENT); }
__device__ __forceinline__ unsigned xb_add(unsigned* p, unsigned v) { return __hip_atomic_fetch_add(p, v, __ATOMIC_RELAXED, __HIP_MEMORY_SCOPE_AGENT); }
__device__ __forceinline__ unsigned xb_xcc_id() { return (unsigned)__builtin_amdgcn_s_getreg((3 << 11) | 20) & 0xFu; }
#define XB_SPIN(cond, bar) do { unsigned _sp = 0; while (cond) { __builtin_amdgcn_s_sleep(1); \
    if ((++_sp & 255u) == 0u) { if (xb_ld(&(bar)[XB_TMO])) break; if (_sp > XB_SPIN_CAP) { atomicAdd(&(bar)[XB_TMO], 1u); break; } } } } while (0)

struct XcdBarrier {
    unsigned* bar; unsigned x;
    volatile LAS unsigned* st;
};

__device__ __forceinline__ XcdBarrier xcd_barrier_post(unsigned* bar, volatile LAS unsigned* st) {
    XcdBarrier b; b.bar = bar; b.x = xb_xcc_id(); b.st = st;
    if (threadIdx.x == 0) (void)xb_add(&bar[XB_XCNT(b.x)], 1u);
    return b;
}
__device__ __forceinline__ void xcd_barrier_complete(unsigned* bar, unsigned x, unsigned& nloc, unsigned& nx) {
    const unsigned G = gridDim.x * gridDim.y * gridDim.z;
    unsigned sum, cnt, mine, sp = 0u;
    for (;;) {
        sum = 0u; cnt = 0u; mine = 0u;
#pragma unroll
        for (unsigned j = 0; j < 16; ++j) { const unsigned c = xb_ld(&bar[XB_XCNT(j)]); sum += c; cnt += (c > 0u) ? 1u : 0u; mine = (j == x) ? c : mine; }
        if (sum == G) break;
        __builtin_amdgcn_s_sleep(1);
        if ((++sp & 255u) == 0u) { if (xb_ld(&bar[XB_TMO])) break; if (sp > XB_SPIN_CAP) { atomicAdd(&bar[XB_TMO], 1u); break; } }
    }
    nloc = mine > 0u ? mine : 1u; nx = cnt > 0u ? cnt : 1u;
}

__device__ __forceinline__ void xcd_barrier(const XcdBarrier& b) {
    asm volatile("s_waitcnt vmcnt(0)" ::: "memory");
    __syncthreads();
    if (threadIdx.x == 0) {
        unsigned* bar = b.bar;
        __builtin_amdgcn_s_waitcnt(0);
        unsigned nloc = b.st[0], nx = b.st[1];
        if (nloc == 0u) { xcd_barrier_complete(bar, b.x, nloc, nx); b.st[0] = nloc; b.st[1] = nx; }
        const unsigned old = xb_add(&bar[XB_XSUB(b.x)], 1u);
        const unsigned gen = old / nloc;
        if (old + 1u == (gen + 1u) * nloc) {
            __builtin_amdgcn_fence(__ATOMIC_RELEASE, "agent");
            asm volatile("s_waitcnt vmcnt(0)" ::: "memory");
            const unsigned og = xb_add(&bar[XB_TOP], 1u);
            const unsigned tg = og / nx;
            if (og + 1u == (tg + 1u) * nx) xb_add(&bar[XB_TOPGEN], 1u);
            else XB_SPIN(xb_ld(&bar[XB_TOPGEN]) == tg, bar);
            __builtin_amdgcn_fence(__ATOMIC_ACQUIRE, "agent");
            xb_add(&bar[XB_XGEN(b.x)], 1u);
            asm volatile("s_waitcnt vmcnt(0)" ::: "memory");
        } else {
            XB_SPIN(xb_ld(&bar[XB_XGEN(b.x)]) == gen, bar);
            __builtin_amdgcn_fence(__ATOMIC_ACQUIRE, "agent");
            asm volatile("s_waitcnt vmcnt(0)" ::: "memory");
        }
    }
    __syncthreads();
}
struct Args { const float* in[21]; float* out; unsigned char* ws; int ph_lo, ph_hi, li, pad; };
struct Frame {
    LAS unsigned char* lds;
    volatile LAS unsigned* MISC;
    gu32* ctl;
    int tid, lane, wave, vcu, G;
    int xi, xr, xn, nx;
};
enum { I_X = 0, I_WIN, I_CONVW, I_CONVB, I_CLNG, I_CLNB, I_SLNG, I_SLNB, I_SGUW, I_SGUB, I_WOUT, I_WQKV, I_WO, I_RELB, I_PWQ, I_PSK, I_PU, I_PV, I_GMIX, I_GFFN, I_GFIN };

template <int MODE>
__device__ __forceinline__ void p0_transpose_item(const float* W, int K, int N, bf16* WT, LAS float* scr, int item, int lane) {
    const int nblk = N / 32, kb = item / nblk, nb = item % nblk, k0 = 64 * kb, n0 = 32 * nb;
    int d0 = n0;
    if (MODE == 1) { const int seg = n0 >> 9, c = n0 & 511; d0 = (seg == 0) ? ((c >> 7) * 256 + (c & 127)) : (seg == 1) ? ((c >> 7) * 256 + 128 + (c & 127)) : n0; }
#pragma unroll 8
    for (int i = 0; i < 32; ++i) { const int kk = 2 * i + (lane >> 5); scr[kk * 33 + (lane & 31)] = W[(size_t)(k0 + kk) * N + n0 + (lane & 31)]; }
    LDS_WAIT(); asm volatile("" ::: "memory");
    const int c = lane & 7;
#pragma unroll
    for (int j = 0; j < 4; ++j) { const int n = (lane >> 3) + 8 * j; const LAS float* s = scr + (8 * c) * 33 + n;
        v4u o; o.x = pk2(s[0 * 33], s[1 * 33]); o.y = pk2(s[2 * 33], s[3 * 33]); o.z = pk2(s[4 * 33], s[5 * 33]); o.w = pk2(s[6 * 33], s[7 * 33]);
        *(GAS v4u*)(WT + (size_t)(d0 + n) * K + k0 + 8 * c) = o; }
    LDS_WAIT(); asm volatile("" ::: "memory");
}
template <int MODE> __device__ __forceinline__ int wq8_dst(int n0) { if (MODE == 1) { const int seg = n0 >> 9, c = n0 & 511; return (seg == 0) ? ((c >> 7) * 256 + (c & 127)) : (seg == 1) ? ((c >> 7) * 256 + 128 + (c & 127)) : n0; } return n0; }
template <int MODE>
__device__ __forceinline__ void p0_colmax_item(const float* W, int N, unsigned* cmax, int item, int lane) {
    const int nblk = N / 32, kb = item / nblk, nb = item % nblk, k0 = 64 * kb, n0 = 32 * nb, d0 = wq8_dst<MODE>(n0);
    float m = 0.f;
#pragma unroll 8
    for (int i = 0; i < 32; ++i) m = fmaxf(m, fabsf(W[(size_t)(k0 + 2 * i + (lane >> 5)) * N + n0 + (lane & 31)]));
    m = fmaxf(m, __shfl_xor(m, 32));
    if (lane < 32) atomicMax(cmax + d0 + lane, __builtin_bit_cast(unsigned, m));
}
template <int MODE>
__device__ __forceinline__ void p0_wq8_item(const float* W, int N, unsigned char* WT, const unsigned* cmax, float* sc, LAS float* scr, int item, int lane) {
    const int nblk = N / 32, kb = item / nblk, nb = item % nblk, k0 = 64 * kb, n0 = 32 * nb, d0 = wq8_dst<MODE>(n0);
    const float m = __builtin_bit_cast(float, cmax[d0 + (lane & 31)]), inv = m > 0.f ? 127.f / m : 0.f;
    if (kb == 0 && lane < 32) sc[d0 + lane] = m * (1.f / 127.f);
#pragma unroll 8
    for (int i = 0; i < 32; ++i) { const int kk = 2 * i + (lane >> 5); scr[kk * 33 + (lane & 31)] = W[(size_t)(k0 + kk) * N + n0 + (lane & 31)] * inv; }
    LDS_WAIT(); asm volatile("" ::: "memory");
    const int c = lane & 7;
#pragma unroll
    for (int j = 0; j < 4; ++j) { const int n = (lane >> 3) + 8 * j; const LAS float* sp = scr + (8 * c) * 33 + n;
        int q[8];
#pragma unroll
        for (int i = 0; i < 8; ++i) q[i] = (int)rintf(sp[i * 33]);
        v2u o; o.x = (unsigned)(q[0] & 255) | ((unsigned)(q[1] & 255) << 8) | ((unsigned)(q[2] & 255) << 16) | ((unsigned)(q[3] & 255) << 24); o.y = (unsigned)(q[4] & 255) | ((unsigned)(q[5] & 255) << 8) | ((unsigned)(q[6] & 255) << 16) | ((unsigned)(q[7] & 255) << 24);
        *(GAS v2u*)(WT + (size_t)(d0 + n) * D + k0 + 8 * c) = o; }
    LDS_WAIT(); asm volatile("" ::: "memory");
}
__device__ __forceinline__ void rms_row_to_bf16(const float* xrow, const float* g, bf16* orow, int lane) {
    const GAS f32x4* xr = (const GAS f32x4*)xrow + lane;
    f32x4 v[4]; float s = 0.f;
#pragma unroll
    for (int j = 0; j < 4; ++j) { v[j] = xr[64 * j]; s += (v[j].x * v[j].x + v[j].y * v[j].y) + (v[j].z * v[j].z + v[j].w * v[j].w); }
    const float r = rsqrtf(wave_sum(s) * (1.f / D) + EPS);
    GAS v2u* o8 = (GAS v2u*)orow + lane;
#pragma unroll
    for (int j = 0; j < 4; ++j) { const f32x4 gg = ((const GAS f32x4*)g)[lane + 64 * j]; v2u o; o.x = pk2(v[j].x * r * gg.x, v[j].y * r * gg.y); o.y = pk2(v[j].z * r * gg.z, v[j].w * r * gg.w); o8[64 * j] = o; }
}
__device__ __forceinline__ int t5_bucket(int d) {
    const int n = d > 0 ? d : 0;
    if (n < 16) return n;
    int b = 16;
    b += (n >= 22); b += (n >= 30); b += (n >= 40); b += (n >= 54); b += (n >= 73); b += (n >= 99); b += (n >= 134); b += (n >= 182);
    b += (n >= 246); b += (n >= 332); b += (n >= 450); b += (n >= 609); b += (n >= 825); b += (n >= 1117); b += (n >= 1513);
    return b;
}
__device__ __forceinline__ void cvt8(const float* src, bf16* dst, size_t i8) {
    const f32x4 a = ((const GAS f32x4*)src)[2 * i8], b = ((const GAS f32x4*)src)[2 * i8 + 1];
    v4u o; o.x = pk2(a.x, a.y); o.y = pk2(a.z, a.w); o.z = pk2(b.x, b.y); o.w = pk2(b.z, b.w);
    ((GAS v4u*)dst)[i8] = o;
}
template <bool SRCB, bool NIB = true> __device__ __forceinline__ void p_rms(const Args& A, Frame& F, const void* srcv, const float* g) {
    const float* src = (const float*)srcv; const bf16* srcb = (const bf16*)srcv;
    const int gw = F.vcu * NWAVES + F.wave, NGW = F.G * NWAVES, lane = F.lane;
    f32x4 nv[4];
    auto ldrow = [&](int row, f32x4 (&o)[4]) {
        if (SRCB) { const v4u a = *(const GAS v4u*)(srcb + (size_t)row * D + lane * 16), b = *(const GAS v4u*)(srcb + (size_t)row * D + lane * 16 + 8);
            o[0] = (f32x4){bf_lo(a.x), bf_hi(a.x), bf_lo(a.y), bf_hi(a.y)}; o[1] = (f32x4){bf_lo(a.z), bf_hi(a.z), bf_lo(a.w), bf_hi(a.w)}; o[2] = (f32x4){bf_lo(b.x), bf_hi(b.x), bf_lo(b.y), bf_hi(b.y)}; o[3] = (f32x4){bf_lo(b.z), bf_hi(b.z), bf_lo(b.w), bf_hi(b.w)}; }
        else {
#pragma unroll
            for (int j = 0; j < 4; ++j) o[j] = *(const GAS f32x4*)(src + (size_t)row * D + lane * 16 + 4 * j); } };
    if (gw < T) ldrow(gw, nv);
    f32x4 gg[4];
#pragma unroll
    for (int j = 0; j < 4; ++j) gg[j] = *(const GAS f32x4*)(g + lane * 16 + 4 * j);
    for (int m = gw; m < T; m += NGW) {
        f32x4 v[4]; float s = 0.f;
#pragma unroll
        for (int j = 0; j < 4; ++j) v[j] = nv[j];
        { const int mn = (m + NGW < T) ? m + NGW : m; ldrow(mn, nv); }
#pragma unroll
        for (int j = 0; j < 4; ++j) s += (v[j].x * v[j].x + v[j].y * v[j].y) + (v[j].z * v[j].z + v[j].w * v[j].w);
        const float r = rsqrtf(wave_sum(s) * (1.f / D) + EPS); float mx = 0.f;
#pragma unroll
        for (int j = 0; j < 4; ++j) { v[j] = v[j] * r * gg[j]; mx = fmaxf(mx, fmaxf(fmaxf(fabsf(v[j].x), fabsf(v[j].y)), fmaxf(fabsf(v[j].z), fabsf(v[j].w)))); }
        mx = wave_max(mx);
        constexpr float QL = NIB ? 119.f : 127.f;
        const float inv = mx > 0.f ? QL / mx : 0.f;
        v4u oq; unsigned* qp = (unsigned*)&oq;
#pragma unroll
        for (int j = 0; j < 4; ++j) { const int a = (int)rintf(v[j].x * inv), b = (int)rintf(v[j].y * inv), c = (int)rintf(v[j].z * inv), d = (int)rintf(v[j].w * inv);
            qp[j] = (unsigned)(a & 255) | ((unsigned)(b & 255) << 8) | ((unsigned)(c & 255) << 16) | ((unsigned)(d & 255) << 24); }
        *(GAS v4u*)(A.ws + WS_HQ + (size_t)m * D + lane * 16) = oq;
        if (lane == 0) ((float*)(A.ws + WS_HQS))[m] = mx * (1.f / QL);
    }
}

template <int MODE> __device__ __forceinline__ void p0_wq8_strip(const float* W, int N, unsigned char* WT, float* sc, LAS float* xch, int strip, int wave, int lane) {
    const int n0 = 32 * strip, d0 = wq8_dst<MODE>(n0), r = lane >> 3, q = lane & 7;
    f32x4 v[16];
#pragma unroll
    for (int i = 0; i < 16; ++i) v[i] = *(const GAS f32x4*)(W + (size_t)(128 * wave + 16 * r + i) * N + n0 + 4 * q);
    f32x4 m = (f32x4){0.f, 0.f, 0.f, 0.f};
#pragma unroll
    for (int i = 0; i < 16; ++i) { m.x = fmaxf(m.x, fabsf(v[i].x)); m.y = fmaxf(m.y, fabsf(v[i].y)); m.z = fmaxf(m.z, fabsf(v[i].z)); m.w = fmaxf(m.w, fabsf(v[i].w)); }
#pragma unroll
    for (int c = 0; c < 4; ++c) { float x = m[c];
        x = fmaxf(x, dpp_f<DPP_ROR8>(x));
        { const unsigned u = __builtin_bit_cast(unsigned, x); const auto t = __builtin_amdgcn_permlane16_swap(u, u, false, false); x = fmaxf(__builtin_bit_cast(float, (unsigned)t[0]), __builtin_bit_cast(float, (unsigned)t[1])); }
        { const unsigned u = __builtin_bit_cast(unsigned, x); const auto t = __builtin_amdgcn_permlane32_swap(u, u, false, false); x = fmaxf(__builtin_bit_cast(float, (unsigned)t[0]), __builtin_bit_cast(float, (unsigned)t[1])); }
        m[c] = x; }
    if (lane < 8) *(LAS f32x4*)(xch + wave * 32 + 4 * q) = m;
    __syncthreads();
    f32x4 cm = (f32x4){0.f, 0.f, 0.f, 0.f};
#pragma unroll
    for (int w = 0; w < 8; ++w) { const f32x4 o = *(const LAS f32x4*)(xch + w * 32 + 4 * q); cm.x = fmaxf(cm.x, o.x); cm.y = fmaxf(cm.y, o.y); cm.z = fmaxf(cm.z, o.z); cm.w = fmaxf(cm.w, o.w); }
    if (wave == 0 && lane < 8) *(GAS f32x4*)(sc + d0 + 4 * q) = cm * (1.f / 127.f);
#pragma unroll
    for (int c = 0; c < 4; ++c) { const float inv = cm[c] > 0.f ? 127.f / cm[c] : 0.f; v4u o; unsigned* op = (unsigned*)&o;
#pragma unroll
        for (int g = 0; g < 4; ++g) { const int a0 = (int)rintf(v[4 * g][c] * inv), a1 = (int)rintf(v[4 * g + 1][c] * inv), a2 = (int)rintf(v[4 * g + 2][c] * inv), a3 = (int)rintf(v[4 * g + 3][c] * inv);
            op[g] = (unsigned)(a0 & 255) | ((unsigned)(a1 & 255) << 8) | ((unsigned)(a2 & 255) << 16) | ((unsigned)(a3 & 255) << 24); }
        *(GAS v4u*)(WT + (size_t)(d0 + 4 * q + c) * D + 128 * wave + 16 * r) = o; }
    __syncthreads();
}
template <int ONLY = 0> __device__ __forceinline__ void p0_prologue(const Args& A, Frame& F) {
    unsigned char* ws = A.ws;
    LAS float* scr = (LAS float*)(F.lds + F.wave * 16384);
    const int gw = F.vcu * NWAVES + F.wave, NGW = F.G * NWAVES;
    constexpr int I_OUT = 16 * 32, I_O = 16 * 32, J_IN = 16 * (MIX_IN / 32), J_WQ = 16 * (2048 / 32), J_QKV = 16 * (3 * D / 32);
    constexpr int NITEMS = I_OUT + I_O;
    if (ONLY == 0 || ONLY == 1) { constexpr int S_IN = MIX_IN / 32, S_WQ = 2048 / 32, S_QKV = 3 * D / 32; float* wsc = (float*)(ws + WS_WSC); LAS float* xch = (LAS float*)F.lds;
        for (int st = F.vcu; st < S_IN + 2 * S_WQ + S_QKV; st += F.G) { int r = st;
            if (r < S_IN) { p0_wq8_strip<1>(A.in[I_WIN], MIX_IN, ws + WS_WIN, wsc, xch, r, F.wave, F.lane); continue; } r -= S_IN;
            if (r < S_WQ) { p0_wq8_strip<0>(A.in[I_PWQ], 2048, ws + WS_WQ, wsc + 2048, xch, r, F.wave, F.lane); continue; } r -= S_WQ;
            if (r < S_WQ) { p0_wq8_strip<0>(A.in[I_PWQ] + (size_t)D * 2048, 2048, ws + WS_WQ + (size_t)2048 * D, wsc + 4096, xch, r, F.wave, F.lane); continue; } r -= S_WQ;
            p0_wq8_strip<0>(A.in[I_WQKV], 3 * D, ws + WS_WQKV, wsc + 6144, xch, r, F.wave, F.lane); } }
    unsigned* cmax = (unsigned*)(ws + WS_CTL) + CW_CMAX;
    if (ONLY == 0 || ONLY == 1)
    for (int it = gw; it < NITEMS; it += NGW) {
        int r = it;
        if (r < I_OUT) { p0_transpose_item<0>(A.in[I_WOUT], D, D, (bf16*)(ws + WS_WOUT), scr, r, F.lane); continue; } r -= I_OUT;
        p0_transpose_item<0>(A.in[I_WO], D, D, (bf16*)(ws + WS_WO), scr, r, F.lane);
    }
    const size_t gt = (size_t)blockIdx.x * NTHREADS + F.tid, NT = (size_t)F.G * NTHREADS;
    constexpr size_t N8_SK = (size_t)2 * PH * 2 * PNK * 128 / 8;
    f32x4 nv[4];
    if ((ONLY == 0 || ONLY == 2) && gw < 4 * PNE) { const float* src0 = (gw >= 2 * PNE ? A.in[I_PV] + (size_t)(gw - 2 * PNE) * D : A.in[I_PU] + (size_t)gw * D) + F.lane * 16;
#pragma unroll
        for (int j = 0; j < 4; ++j) nv[j] = *(const GAS f32x4*)(src0 + 4 * j); }
    if (ONLY == 0 || ONLY == 2)
    for (int row = gw; row < 4 * PNE; row += NGW) {
        const bool isv = row >= 2 * PNE; const int r = isv ? row - 2 * PNE : row;
        f32x4 v[4]; float m = 0.f;
#pragma unroll
        for (int j = 0; j < 4; ++j) v[j] = nv[j];
        { const int rn = (row + NGW < 4 * PNE) ? row + NGW : row;
          const float* srcn = (rn >= 2 * PNE ? A.in[I_PV] + (size_t)(rn - 2 * PNE) * D : A.in[I_PU] + (size_t)rn * D) + F.lane * 16;
#pragma unroll
          for (int j = 0; j < 4; ++j) nv[j] = *(const GAS f32x4*)(srcn + 4 * j); }
#pragma unroll
        for (int j = 0; j < 4; ++j) m = fmaxf(m, fmaxf(fmaxf(fabsf(v[j].x), fabsf(v[j].y)), fmaxf(fabsf(v[j].z), fabsf(v[j].w))));
        m = wave_max(m);
        float ss = 0.f;
#pragma unroll
        for (int j = 0; j < 4; ++j) ss += (v[j].x * v[j].x + v[j].y * v[j].y) + (v[j].z * v[j].z + v[j].w * v[j].w);
        ss = wave_sum(ss);
        {
            const float clip = fminf(m, 2.5f * sqrtf(ss * (1.f / D)));
            const float inv = clip > 0.f ? 7.f / clip : 0.f;
            v2u o2; unsigned* op = (unsigned*)&o2;
#pragma unroll
            for (int w = 0; w < 2; ++w) { unsigned ow = 0;
#pragma unroll
                for (int bb = 0; bb < 4; ++bb) { const int l = (int)fminf(fmaxf(rintf(v[2 * w][bb] * inv), -7.f), 7.f), h = (int)fminf(fmaxf(rintf(v[2 * w + 1][bb] * inv), -7.f), 7.f);
                    ow |= (unsigned)(((isv ? l + 8 : l) & 15) | ((h & 15) << 4)) << (8 * bb); }
                op[w] = ow; }
            *(GAS v2u*)(ws + (isv ? WS_PV : WS_PU) + (size_t)(r / PNE) * PNE * 512 + (size_t)(F.lane >> 4) * PNE * 128 + (size_t)(r % PNE) * 128 + (F.lane & 15) * 8) = o2;
            if (F.lane == 0) ((float*)(ws + (isv ? WS_PSV : WS_PSU)))[r] = clip * (1.f / 7.f);
        }
    }
    if (ONLY == 0 || ONLY == 3) {
    for (size_t i = gt; i < N8_SK; i += NT) cvt8(A.in[I_PSK], (bf16*)(ws + WS_SK), i);
    for (size_t i = gt; i < (size_t)B_HEADS * 128 * 128; i += NT) { const int s = (int)(i & 127), t = (int)((i >> 7) & 127); ((bf16*)(ws + WS_SGW))[i] = (bf16)f2bf(s <= t ? A.in[I_SGUW][i] : 0.f); }
    for (size_t i = gt; i < (size_t)MH * LUT_N; i += NT) { const int h = (int)(i / LUT_N), d = (int)(i % LUT_N) - LUT_OFF; ((float*)(ws + WS_LUT))[i] = A.in[I_RELB][t5_bucket(d) * MH + h]; }
    for (size_t i = gt; i < (size_t)(BATCH * NBLK * D + T); i += NT) ((float*)(ws + WS_KMEAN))[i] = 0.f;
    }
    if (ONLY == 0 || ONLY == 4) p_rms<false, false>(A, F, A.in[I_X], A.in[I_GMIX]);
}
__device__ __forceinline__ void p0_weights8(const Args& A, Frame& F) {
    unsigned char* ws = A.ws;
    LAS float* scr = (LAS float*)(F.lds + F.wave * 16384);
    const int gw = F.vcu * NWAVES + F.wave, NGW = F.G * NWAVES;
    constexpr int J_IN = 16 * (MIX_IN / 32), J_WQ = 16 * (2048 / 32), J_QKV = 16 * (3 * D / 32);
    const unsigned* cmax = (const unsigned*)(ws + WS_CTL) + CW_CMAX; float* wsc = (float*)(ws + WS_WSC);
    for (int it = gw; it < J_IN + 2 * J_WQ + J_QKV; it += NGW) {
        int r = it;
        if (r < J_IN) { p0_wq8_item<1>(A.in[I_WIN], MIX_IN, ws + WS_WIN, cmax, wsc, scr, r, F.lane); continue; } r -= J_IN;
        if (r < J_WQ) { p0_wq8_item<0>(A.in[I_PWQ], 2048, ws + WS_WQ, cmax + 2048, wsc + 2048, scr, r, F.lane); continue; } r -= J_WQ;
        if (r < J_WQ) { p0_wq8_item<0>(A.in[I_PWQ] + (size_t)D * 2048, 2048, ws + WS_WQ + (size_t)2048 * D, cmax + 4096, wsc + 4096, scr, r, F.lane); continue; } r -= J_WQ;
        p0_wq8_item<0>(A.in[I_WQKV], 3 * D, ws + WS_WQKV, cmax + 6144, wsc + 6144, scr, r, F.lane);
    }
}

__device__ __forceinline__ void p9_kmean(const Args& A, Frame& F) {
    const bf16* K = (const bf16*)(A.ws + WS_K); float* km = (float*)(A.ws + WS_KMEAN);
    const size_t gt = (size_t)blockIdx.x * NTHREADS + F.tid, NT = (size_t)F.G * NTHREADS;
    for (size_t i = gt; i < (size_t)BATCH * NBLK * D; i += NT) {
        const int col = (int)(i & 1023); const size_t bb = i >> 10; float s = 0.f;
        for (int r = 0; r < MBLK; ++r) s += bf2f(K[(bb * MBLK + r) * D + col]);
        km[i] = s * (1.f / MBLK);
    }
}

typedef float f32x16_t __attribute__((ext_vector_type(16)));
#define PK_CE(a, i, j) { const float hi_ = __builtin_fmaxf(a[i], a[j]), lo_ = __builtin_fminf(a[i], a[j]); a[i] = hi_; a[j] = lo_; }
__device__ __forceinline__ void pk_sort16(float (&a)[16]) {
#pragma unroll
    for (int p = 1; p < 16; p <<= 1)
#pragma unroll
        for (int k = p; k >= 1; k >>= 1)
#pragma unroll
            for (int j = k % p; j + k < 16; j += 2 * k)
#pragma unroll
                for (int i = 0; i < k; ++i)
                    if (i + j + k < 16 && (i + j) / (2 * p) == (i + j + k) / (2 * p)) PK_CE(a, i + j, i + j + k);
}
__device__ __forceinline__ void pk_bitonic16(float (&a)[16]) {
#pragma unroll
    for (int s = 8; s >= 1; s >>= 1)
#pragma unroll
        for (int i = 0; i < 16; ++i) if ((i & s) == 0) PK_CE(a, i, i + s);
}
__device__ __forceinline__ void pk_merge_top16(float (&a)[16], const float (&b)[16]) {
#pragma unroll
    for (int i = 0; i < 16; ++i) a[i] = __builtin_fmaxf(a[i], b[15 - i]);
    pk_bitonic16(a);
}
__device__ __forceinline__ float pk_key(float v, unsigned clr, unsigned id) { return __builtin_bit_cast(float, (__builtin_bit_cast(unsigned, v) & clr) | id); }
template <int MODE = 0> __device__ __forceinline__ void p6_route(const Args& A, Frame& F, int layer) {
    unsigned char* ws = A.ws;
    const bf16* qp = (const bf16*)(ws + WS_QP); const bf16* skb = (const bf16*)(ws + WS_SK) + (size_t)layer * PH * 2 * PNK * 128;
    int* idx = (int*)(ws + WS_IDX); float* gate = (float*)(ws + WS_GATE); float* suk = (float*)(ws + WS_SUK);
    LAS unsigned char* skl = F.lds;
    LAS unsigned char* tab = F.lds + 65536 + F.tid * 32;
    const int lane = F.lane, r32 = lane & 31, hi = lane >> 5;
    int cur_h = -1;
    bf16x8 qn[16];
    if (F.vcu < (T / 256) * PH) { const bf16* q0p = qp + (size_t)((F.vcu >> 3) * 256 + F.wave * 32 + r32) * 2048 + (F.vcu & 7) * 256 + hi * 8;
#pragma unroll
        for (int i = 0; i < 16; ++i) qn[i] = *(const bf16x8*)(q0p + 16 * i); }
    for (int u = F.vcu; u < (T / 256) * PH; u += F.G) {
        const int h = u & 7, tile = u >> 3;
        bf16x8 qc[16];
#pragma unroll
        for (int i = 0; i < 16; ++i) qc[i] = qn[i];
        { const int un = (u + F.G < (T / 256) * PH) ? u + F.G : u;
          const bf16* qnp = qp + (size_t)((un >> 3) * 256 + F.wave * 32 + r32) * 2048 + (un & 7) * 256 + hi * 8;
#pragma unroll
          for (int i = 0; i < 16; ++i) qn[i] = *(const bf16x8*)(qnp + 16 * i); }
        if (h != cur_h) {
            __syncthreads();
#pragma unroll
            for (int c = 0; c < 8; ++c) { const int id = F.tid + 512 * c, row = id >> 4, ch = id & 15;
                *(LAS v4u*)(skl + row * 256 + ((ch ^ (row & 15)) << 4)) = *(const v4u*)(skb + ((size_t)h * 256 + row) * 128 + ch * 8); }
            __syncthreads(); cur_h = h;
        }
        const int tok = tile * 256 + F.wave * 32 + r32;
        float top0[16], top1[16];
#pragma unroll
        for (int p = 0; p < 2; ++p) {
            bf16x8 qf[8];
#pragma unroll
            for (int ks = 0; ks < 8; ++ks) qf[ks] = qc[p * 8 + ks];
#pragma unroll
            for (int kt = 0; kt < 4; ++kt) {
                f32x16_t acc = {};
#pragma unroll
                for (int ks = 0; ks < 8; ++ks) { const bf16x8 a = *(const LAS bf16x8*)(skl + p * 32768 + (32 * kt + r32) * 256 + (((2 * ks + hi) ^ (r32 & 15)) << 4)); acc = __builtin_amdgcn_mfma_f32_32x32x16_bf16(a, qf[ks], acc, 0, 0, 0); }
                float g[16];
#pragma unroll
                for (int r = 0; r < 16; ++r) g[r] = pk_key(acc[r], 0xffffff80u, (unsigned)(32 * kt + (r & 3) + 8 * (r >> 2)));
                if (MODE != 1) pk_sort16(g);
                if (p == 0) { if (kt == 0) {
#pragma unroll
                        for (int i = 0; i < 16; ++i) top0[i] = g[i]; } else if (MODE != 1) pk_merge_top16(top0, g); else top0[kt] += g[kt]; }
                else { if (kt == 0) {
#pragma unroll
                        for (int i = 0; i < 16; ++i) top1[i] = g[i]; } else if (MODE != 1) pk_merge_top16(top1, g); else top1[kt] += g[kt]; }
            }
        }
        float mine[16], oth[16];
#pragma unroll
        for (int i = 0; i < 16; ++i) {
            const unsigned a0 = __builtin_bit_cast(unsigned, top0[i]) | ((unsigned)hi << 2), a1 = __builtin_bit_cast(unsigned, top1[i]) | ((unsigned)hi << 2);
            const auto rr = __builtin_amdgcn_permlane32_swap(a0, a1, false, false);
            mine[i] = __builtin_bit_cast(float, (unsigned)rr[0]); oth[i] = __builtin_bit_cast(float, (unsigned)rr[1]);
        }
        pk_merge_top16(mine, oth);
        float s1[16], s2[16];
#pragma unroll
        for (int i = 0; i < 16; ++i) { const unsigned m = __builtin_bit_cast(unsigned, mine[i]); const auto rr = __builtin_amdgcn_permlane32_swap(m, m, false, false);
            s1[i] = __builtin_bit_cast(float, (unsigned)rr[0]); s2[i] = __builtin_bit_cast(float, (unsigned)rr[1]); }
#pragma unroll
        for (int q4 = 0; q4 < 4; ++q4) {
            unsigned w1 = 0, w2 = 0;
#pragma unroll
            for (int k = 0; k < 4; ++k) { w1 |= (__builtin_bit_cast(unsigned, s1[4 * q4 + k]) & 127u) << (8 * k); w2 |= (__builtin_bit_cast(unsigned, s2[4 * q4 + k]) & 127u) << (8 * k); }
            *(LAS unsigned*)(tab + 4 * q4) = w1; *(LAS unsigned*)(tab + 16 + 4 * q4) = w2;
        }
#define PK_CAND(a, b) pk_key(s1[a] + s2[b], 0xffffff00u, (unsigned)((15 - (a)) * 16 + (15 - (b))))
        float G1[16], G2[16], G3[16];
#pragma unroll
        for (int b = 0; b < 16; ++b) G1[b] = PK_CAND(0, b);
#pragma unroll
        for (int b = 0; b < 8; ++b) { G2[b] = PK_CAND(1, b); G2[8 + b] = PK_CAND(15 - b, 0); }
        pk_bitonic16(G2);
        pk_merge_top16(G1, G2);
        G3[0] = PK_CAND(2, 0); G3[1] = PK_CAND(2, 1); G3[2] = PK_CAND(2, 2); G3[3] = PK_CAND(2, 3); G3[4] = PK_CAND(2, 4);
        G3[5] = PK_CAND(3, 0); G3[6] = PK_CAND(3, 1); G3[7] = PK_CAND(3, 2); G3[8] = PK_CAND(3, 3);
        G3[9] = PK_CAND(4, 0); G3[10] = PK_CAND(4, 1); G3[11] = PK_CAND(4, 2);
        G3[12] = PK_CAND(5, 0); G3[13] = PK_CAND(5, 1); G3[14] = PK_CAND(6, 0); G3[15] = PK_CAND(6, 1);
        pk_sort16(G3);
        G3[15] = __builtin_fmaxf(G3[15], PK_CAND(7, 0)); G3[14] = __builtin_fmaxf(G3[14], PK_CAND(7, 1));
        pk_bitonic16(G3);
        pk_merge_top16(G1, G3);
#undef PK_CAND
        LDS_WAIT();
        int e[16]; float pr[16]; float den = 0.f;
#pragma unroll
        for (int k = 0; k < 16; ++k) {
            const unsigned id = __builtin_bit_cast(unsigned, G1[k]) & 255u; const int a = 15 - (int)(id >> 4), b = 15 - (int)(id & 15u);
            const int i1 = *(const LAS unsigned char*)(tab + a), i2 = *(const LAS unsigned char*)(tab + 16 + b);
            e[k] = i1 * PNK + i2;
            pr[k] = __builtin_amdgcn_exp2f((G1[k] - G1[0]) * 1.4426950408889634f); den += pr[k];
        }
        const float inv = 1.f / den;
        const float* sc = (const float*)(ws + (hi == 0 ? WS_PSU : WS_PSV)) + layer * PNE;
        float scv[16];
#pragma unroll
        for (int k = 0; k < 16; ++k) scv[k] = sc[e[k]];
        if (hi == 0) {
#pragma unroll
            for (int k = 0; k < 2; ++k) *(v4u*)((unsigned short*)idx + (size_t)tok * PSEL + h * PTOPK + 8 * k) = (v4u){(unsigned)e[8 * k] | ((unsigned)e[8 * k + 1] << 16), (unsigned)e[8 * k + 2] | ((unsigned)e[8 * k + 3] << 16), (unsigned)e[8 * k + 4] | ((unsigned)e[8 * k + 5] << 16), (unsigned)e[8 * k + 6] | ((unsigned)e[8 * k + 7] << 16)};
#pragma unroll
            for (int k = 0; k < 2; ++k) *(v4u*)((bf16*)suk + (size_t)tok * PSEL + h * PTOPK + 8 * k) = (v4u){pk2(scv[8 * k], scv[8 * k + 1]), pk2(scv[8 * k + 2], scv[8 * k + 3]), pk2(scv[8 * k + 4], scv[8 * k + 5]), pk2(scv[8 * k + 6], scv[8 * k + 7])};
        } else {
#pragma unroll
            for (int k = 0; k < 2; ++k) *(v4u*)((bf16*)gate + (size_t)tok * PSEL + h * PTOPK + 8 * k) = (v4u){pk2(pr[8 * k] * inv * scv[8 * k], pr[8 * k + 1] * inv * scv[8 * k + 1]), pk2(pr[8 * k + 2] * inv * scv[8 * k + 2], pr[8 * k + 3] * inv * scv[8 * k + 3]),
                                                                                                          pk2(pr[8 * k + 4] * inv * scv[8 * k + 4], pr[8 * k + 5] * inv * scv[8 * k + 5]), pk2(pr[8 * k + 6] * inv * scv[8 * k + 6], pr[8 * k + 7] * inv * scv[8 * k + 7])};
        }
    }
}

typedef _Float16 f16x2_t __attribute__((ext_vector_type(2)));
typedef _Float16 f16x8_t __attribute__((ext_vector_type(8)));
typedef short v4i16_t __attribute__((ext_vector_type(4)));
__device__ __forceinline__ void p2_mixer(const Args& A, Frame& F) {
    unsigned char* ws = A.ws;
    const bf16* aglu = (const bf16*)(ws + WS_AGLU); const bf16* ug = (const bf16*)(ws + WS_UG); const bf16* vg = (const bf16*)(ws + WS_VG); bf16* cat = (bf16*)(ws + WS_CAT);
    const float* cw = A.in[I_CONVW]; const float* cb = A.in[I_CONVB]; const float* clg = A.in[I_CLNG]; const float* clb = A.in[I_CLNB];
    const float* slg = A.in[I_SLNG]; const float* slb = A.in[I_SLNB]; const float* sb = A.in[I_SGUB]; const bf16* sgw = (const bf16*)(ws + WS_SGW);
    LAS unsigned char* L = F.lds;
    const int lane = F.lane, wave = F.wave;
    for (int unit = blockIdx.x; unit < T / 128; unit += F.G) {
        const int row0 = unit * 128, tin = (unit & 31) * 128;
#pragma unroll 1
        for (int pass = 0; pass < 2; ++pass) {
        if ((pass == 0) != ((blockIdx.x & 1) != 0)) {
        {
            const int cp = F.tid & 255, hf = F.tid >> 8, t0 = hf * 64;
            float w0[31], w1[31], x0[31], x1[31];
#pragma unroll
            for (int j = 0; j < 31; ++j) { const f32x2 ww = *(const f32x2*)(cw + j * 512 + 2 * cp); w0[j] = ww.x; w1[j] = ww.y; }
            const f32x2 bias = *(const f32x2*)(cb + 2 * cp);
            const unsigned char* gb = (const unsigned char*)aglu;
            unsigned o = (unsigned)(((row0 + t0 - 31) * 512 + 2 * cp) * 2);
            x0[0] = 0.f; x1[0] = 0.f;
#pragma unroll
            for (int s = 1; s < 31; ++s) { const int tt = s - 31; o += 1024u; asm volatile("" : "+v"(o)); unsigned wv = 0u; if (tin + t0 + tt >= 0) wv = *(const unsigned*)(gb + o); x0[s] = bf_lo(wv); x1[s] = bf_hi(wv); }
            unsigned lo = (unsigned)(t0 * 1024 + cp * 4);
            unsigned pre[4];
#pragma unroll
            for (int i = 0; i < 4; ++i) pre[i] = *(const unsigned*)(gb + (unsigned)(o + 1024u * (unsigned)(i + 1)));
            const unsigned olast = o + 1024u * 64u;
#pragma unroll 1
            for (int tb = 0; tb < 64; tb += 31) {
#pragma unroll
                for (int s = 0; s < 31; ++s) {
                    const int t = tb + s;
                    if (t < 64) {
                        o += 1024u; asm volatile("" : "+v"(o));
                        const unsigned wv = pre[s & 3]; { unsigned on = o + 4096u; on = on < olast ? on : olast; pre[s & 3] = *(const unsigned*)(gb + on); }
                        x0[s] = bf_lo(wv); x1[s] = bf_hi(wv);
                        float a0 = bias.x, a1 = bias.y;
#pragma unroll
                        for (int j = 0; j < 31; ++j) { a0 += w0[j] * x0[(s + 1 + j) % 31]; a1 += w1[j] * x1[(s + 1 + j) % 31]; }
                        const f16x2_t ov = {(_Float16)a0, (_Float16)a1};
                        *(LAS f16x2_t*)(L + lo) = ov; lo += 1024u; asm volatile("" : "+v"(lo));
                    }
                }
                { const unsigned p0 = pre[3], p1 = pre[0], p2 = pre[1], p3 = pre[2]; pre[0] = p0; pre[1] = p1; pre[2] = p2; pre[3] = p3; }
            }
        }
        __syncthreads();
#pragma unroll 2
        for (int k = 0; k < 16; ++k) {
            const int tl = wave * 16 + k; const f16x8_t hv = *(const LAS f16x8_t*)(L + tl * 1024 + lane * 16);
            float v[8]; float s = 0.f;
#pragma unroll
            for (int i = 0; i < 8; ++i) { v[i] = (float)hv[i]; s += v[i]; }
            const float mu = wave_sum(s) * (1.f / 512.f); float q = 0.f;
#pragma unroll
            for (int i = 0; i < 8; ++i) { v[i] -= mu; q += v[i] * v[i]; }
            const float rstd = rsqrtf(wave_sum(q) * (1.f / 512.f) + EPS);
            const f32x4 g0 = *(const f32x4*)(clg + lane * 8), g1 = *(const f32x4*)(clg + lane * 8 + 4), b0 = *(const f32x4*)(clb + lane * 8), b1 = *(const f32x4*)(clb + lane * 8 + 4);
            const float gg[8] = {g0.x, g0.y, g0.z, g0.w, g1.x, g1.y, g1.z, g1.w}, bb[8] = {b0.x, b0.y, b0.z, b0.w, b1.x, b1.y, b1.z, b1.w};
            float y[8];
#pragma unroll
            for (int i = 0; i < 8; ++i) { const float z = v[i] * rstd * gg[i] + bb[i]; y[i] = z * __builtin_amdgcn_rcpf(1.f + __expf(-z)); }
            v4u o; o.x = pk2(y[0], y[1]); o.y = pk2(y[2], y[3]); o.z = pk2(y[4], y[5]); o.w = pk2(y[6], y[7]);
            *(v4u*)(cat + (size_t)(row0 + tl) * 1024 + lane * 8) = o;
        }
        __syncthreads();
        } else {
#pragma unroll 1
        for (int k4 = 0; k4 < 16; k4 += 8) {
        v4u rawv[8];
#pragma unroll
        for (int k = 0; k < 8; ++k) rawv[k] = *(const v4u*)(vg + (size_t)(row0 + wave * 16 + k4 + k) * 512 + lane * 8);
#pragma unroll
        for (int k = 0; k < 8; ++k) {
            const int tl = wave * 16 + k4 + k;
            const v4u raw = rawv[k];
            float v[8] = {bf_lo(raw.x), bf_hi(raw.x), bf_lo(raw.y), bf_hi(raw.y), bf_lo(raw.z), bf_hi(raw.z), bf_lo(raw.w), bf_hi(raw.w)};
            float s = 0.f;
#pragma unroll
            for (int i = 0; i < 8; ++i) s += v[i];
            const float mu = wave_sum(s) * (1.f / 512.f); float q = 0.f;
#pragma unroll
            for (int i = 0; i < 8; ++i) { v[i] -= mu; q += v[i] * v[i]; }
            const float rstd = rsqrtf(wave_sum(q) * (1.f / 512.f) + EPS);
            const f32x4 g0 = *(const f32x4*)(slg + lane * 8), g1 = *(const f32x4*)(slg + lane * 8 + 4), b0 = *(const f32x4*)(slb + lane * 8), b1 = *(const f32x4*)(slb + lane * 8 + 4);
            const float gg[8] = {g0.x, g0.y, g0.z, g0.w, g1.x, g1.y, g1.z, g1.w}, bb[8] = {b0.x, b0.y, b0.z, b0.w, b1.x, b1.y, b1.z, b1.w};
#pragma unroll
            for (int i = 0; i < 8; ++i) v[i] = v[i] * rstd * gg[i] + bb[i];
            v4u o; o.x = pk2(v[0], v[1]); o.y = pk2(v[2], v[3]); o.z = pk2(v[4], v[5]); o.w = pk2(v[6], v[7]);
            *(LAS v4u*)(L + tl * 1024 + lane * 16) = o;
        }
        }
        __syncthreads();
        {
            const int h = wave, fr = lane & 15, fq = lane >> 4;
            const bf16* wh = sgw + (size_t)h * 128 * 128;
#pragma unroll 1
            for (int nh = 0; nh < 2; ++nh) {
                bf16x8 bfr[4][2];
#pragma unroll
                for (int ks = 0; ks < 4; ++ks)
#pragma unroll
                    for (int nt = 0; nt < 2; ++nt) {
                        const int n0 = h * 64 + nh * 32 + 4 * nt;
                        const LAS unsigned char* pa = L + (size_t)(32 * ks + 8 * fq + (fr >> 2)) * 1024 + (n0 + 8 * (fr & 3)) * 2;
                        const v4i16_t lo = __builtin_amdgcn_ds_read_tr16_b64_v4i16((LAS v4i16_t*)pa), hi4 = __builtin_amdgcn_ds_read_tr16_b64_v4i16((LAS v4i16_t*)(pa + 4 * 1024));
                        bfr[ks][nt] = (bf16x8){lo[0], lo[1], lo[2], lo[3], hi4[0], hi4[1], hi4[2], hi4[3]};
                    }
                bf16x8 afn[4]; const int c = h * 64 + nh * 32 + 8 * fq;
#pragma unroll
                for (int ks = 0; ks < 4; ++ks) afn[ks] = *(const bf16x8*)(wh + (size_t)fr * 128 + 32 * ks + 8 * fq);
                v4u un = *(const v4u*)(ug + (size_t)(row0 + fr) * 512 + c); float btn = sb[h * 128 + fr];
#pragma unroll 1
                for (int mt = 0; mt < 8; ++mt) {
                    bf16x8 af[4];
#pragma unroll
                    for (int ks = 0; ks < 4; ++ks) af[ks] = afn[ks];
                    const int t = 16 * mt + fr;
                    const v4u uu = un; const float bt = btn;
                    { const int mn = mt < 7 ? mt + 1 : mt, tn = 16 * mn + fr;
#pragma unroll
                      for (int ks = 0; ks < 4; ++ks) afn[ks] = *(const bf16x8*)(wh + (size_t)tn * 128 + 32 * ks + 8 * fq);
                      un = *(const v4u*)(ug + (size_t)(row0 + tn) * 512 + c); btn = sb[h * 128 + tn]; }
                    f32x4 acc0 = (f32x4){0.f, 0.f, 0.f, 0.f}, acc1 = (f32x4){0.f, 0.f, 0.f, 0.f};
#pragma unroll
                    for (int ks = 0; ks < 4; ++ks)
                        if (2 * ks <= mt) {
                            acc0 = __builtin_amdgcn_mfma_f32_16x16x32_bf16(bfr[ks][0], af[ks], acc0, 0, 0, 0);
                            acc1 = __builtin_amdgcn_mfma_f32_16x16x32_bf16(bfr[ks][1], af[ks], acc1, 0, 0, 0);
                        }
                    v4u o;
                    o.x = pk2(bf_lo(uu.x) * (acc0[0] + bt), bf_hi(uu.x) * (acc0[1] + bt)); o.y = pk2(bf_lo(uu.y) * (acc0[2] + bt), bf_hi(uu.y) * (acc0[3] + bt));
                    o.z = pk2(bf_lo(uu.z) * (acc1[0] + bt), bf_hi(uu.z) * (acc1[1] + bt)); o.w = pk2(bf_lo(uu.w) * (acc1[2] + bt), bf_hi(uu.w) * (acc1[3] + bt));
                    *(v4u*)(cat + (size_t)(row0 + t) * 1024 + 512 + c) = o;
                }
            }
        }
        __syncthreads();
        }
        }
    }
}

struct S1a { int e0, e1; float a0, a1, b0, b1; v4u hq; float hs; };
__device__ __forceinline__ void s1a_load(S1a& s, const unsigned char* ws, int t, int lane) {
    const int* idx = (const int*)(ws + WS_IDX); const float* gsv = (const float*)(ws + WS_GATE); const float* suk = (const float*)(ws + WS_SUK);
    s.e0 = idx[(size_t)t * PSEL + lane]; s.e1 = idx[(size_t)t * PSEL + 64 + lane];
    s.a0 = suk[(size_t)t * PSEL + lane]; s.a1 = suk[(size_t)t * PSEL + 64 + lane];
    s.b0 = gsv[(size_t)t * PSEL + lane]; s.b1 = gsv[(size_t)t * PSEL + 64 + lane];
    s.hq = *(const v4u*)(ws + WS_HQ + (size_t)t * D + lane * 16); s.hs = ((const float*)(ws + WS_HQS))[t];
}
struct ChunkA { v4u rows[8]; v4u hq; float sa, sb; int kk, nv, t; };
struct WalkA { S1a cur, nxt; unsigned long long m0, m1; int it, nit, wrank, nw, nslice, xs0, xstep; bool done; };
__device__ __forceinline__ int walk_tok(const WalkA& w, int it) { return w.wrank + (it / w.nslice) * w.nw; }
__device__ __forceinline__ void walk_masks(WalkA& w) { const int xs = w.xs0 + (w.it % w.nslice) * w.xstep; w.m0 = __ballot((w.cur.e0 >> 11) == xs); w.m1 = __ballot((w.cur.e1 >> 11) == xs); }
template <int MODE> __device__ __forceinline__ void gen_a(ChunkA& c, WalkA& w, const unsigned char* ws, const unsigned char* ut, int lane, int cls) {
    while ((w.m0 | w.m1) == 0ull && !w.done) {
        ++w.it;
        if (w.it >= w.nit) { w.done = true; break; }
        w.cur = w.nxt;
        { const int itn = (w.it + 1 < w.nit) ? w.it + 1 : w.nit - 1; s1a_load(w.nxt, ws, walk_tok(w, itn), lane); }
        walk_masks(w);
    }
    if (w.done) { c.nv = 0; return; }
    int kl = 0, nv = 0, kkv = 0;
    unsigned long long lo = w.m0, hi = w.m1;
#pragma unroll
    for (int i = 0; i < 8; ++i) {
        const bool has = (lo | hi) != 0ull, uselo = lo != 0ull;
        const unsigned long long m = uselo ? lo : hi;
        const int kp = (uselo ? 0 : 64) + __builtin_ctzll(m | 0x8000000000000000ull);
        const unsigned long long mc = m & (m - 1ull);
        lo = uselo ? mc : lo; hi = uselo ? hi : mc;
        const int k = has ? kp : kl; nv += has ? 1 : 0; kl = k;
        const int e = __builtin_amdgcn_readlane(k < 64 ? w.cur.e0 : w.cur.e1, k & 63);
        if (MODE == 1) { c.rows[i] = w.cur.hq; c.rows[i].x += (unsigned)e; } else
        c.rows[i] = *(const v4u*)(ut + (size_t)e * D + lane * 16);
        kkv = (cls == i) ? k : kkv;
    }
    w.m0 = lo; w.m1 = hi;
    const float a0s = __shfl(w.cur.a0, kkv & 63), a1s = __shfl(w.cur.a1, kkv & 63), b0s = __shfl(w.cur.b0, kkv & 63), b1s = __shfl(w.cur.b1, kkv & 63);
    c.sa = w.cur.hs * (kkv < 64 ? a0s : a1s); c.sb = kkv < 64 ? b0s : b1s; c.kk = kkv; c.nv = nv; c.t = walk_tok(w, w.it); c.hq = w.cur.hq;
}
__device__ __forceinline__ void compute_a(const ChunkA& c, float* cb, int lane, int cls) {
    int d[8];
#pragma unroll
    for (int i = 0; i < 8; ++i) { const v4u& ur = c.rows[i];
        int s = __builtin_amdgcn_sdot4((int)ur.x, (int)c.hq.x, 0, false); s = __builtin_amdgcn_sdot4((int)ur.y, (int)c.hq.y, s, false); s = __builtin_amdgcn_sdot4((int)ur.z, (int)c.hq.z, s, false); d[i] = __builtin_amdgcn_sdot4((int)ur.w, (int)c.hq.w, s, false); }
    const bool b3 = lane & 8;
    int q4[4];
#pragma unroll
    for (int i = 0; i < 4; ++i) { const auto rr = __builtin_amdgcn_permlane32_swap((unsigned)d[i], (unsigned)d[i + 4], false, false); q4[i] = (int)rr[0] + (int)rr[1]; }
    int q2[2];
#pragma unroll
    for (int i = 0; i < 2; ++i) {
        const auto ra = __builtin_amdgcn_permlane16_swap((unsigned)q4[i], (unsigned)q4[i], false, false), rb = __builtin_amdgcn_permlane16_swap((unsigned)q4[i + 2], (unsigned)q4[i + 2], false, false);
        const int sa_ = (int)ra[0] + (int)ra[1], sb_ = (int)rb[0] + (int)rb[1]; q2[i] = (lane & 16) ? sb_ : sa_; }
    int q1; { const int send = b3 ? q2[0] : q2[1], keep = b3 ? q2[1] : q2[0]; q1 = keep + dpp_i<DPP_ROR8>(send); }
    q1 += dpp_i<DPP_HMIRROR>(q1); q1 += dpp_i<DPP_XOR2>(q1); q1 += dpp_i<DPP_XOR1>(q1);
    const float cf = c.sb * gelu_tanh((float)q1 * c.sa);
    if ((lane & 7) == 0 && cls < c.nv) cb[(size_t)c.t * PSEL + c.kk] = cf;
}
template <int MODE> __device__ __forceinline__ void p7a_act(const Args& A, Frame& F, int layer) {
    unsigned char* ws = A.ws;
    const unsigned char* ut = ws + WS_PU + (size_t)layer * PNE * D; float* cb = (float*)(ws + (MODE == 0 ? WS_CB : WS_SUK + 0));
    const int lane = F.lane;
    const int cls = ((lane >> 5) & 1) * 4 + ((lane >> 4) & 1) * 2 + ((lane >> 3) & 1);
    WalkA w;
    w.xs0 = F.xi; w.xstep = F.nx; w.nslice = F.xi < 8 ? (7 - F.xi) / F.nx + 1 : 0;
    w.wrank = F.xr * NWAVES + F.wave; w.nw = F.xn * NWAVES;
    const int cnt = (w.wrank < T) ? (T - 1 - w.wrank) / w.nw + 1 : 0;
    w.nit = cnt * w.nslice; w.it = 0; w.done = (w.nit == 0);
    if (w.done) return;
    s1a_load(w.cur, ws, walk_tok(w, 0), lane); s1a_load(w.nxt, ws, walk_tok(w, w.nit > 1 ? 1 : 0), lane);
    walk_masks(w);
    ChunkA ca, cbf;
    gen_a<MODE>(ca, w, ws, ut, lane, cls);
    while (ca.nv > 0) {
        gen_a<MODE>(cbf, w, ws, ut, lane, cls);
        compute_a(ca, cb, lane, cls);
        if (cbf.nv == 0) break;
        gen_a<MODE>(ca, w, ws, ut, lane, cls);
        compute_a(cbf, cb, lane, cls);
    }
}
__device__ __forceinline__ void y_ld_e(v4u (&e)[2], const unsigned char* ws, int t, int r) {
    const unsigned short* idx = (const unsigned short*)(ws + WS_IDX);
    e[0] = *(const v4u*)(idx + (size_t)t * PSEL + 8 * r);
}
template <int MODE> __device__ __forceinline__ void rows_issue8(v4u (&rows)[8], const v4u (&e4)[2], const unsigned char* base, unsigned loff) {
#pragma unroll
    for (int i = 0; i < 8; ++i) { const unsigned w = ((const unsigned*)&e4[0])[i >> 1]; const unsigned e = (i & 1) ? (w >> 16) : (w & 0xffffu); if (MODE == 1) { rows[i] = e4[0]; rows[i].x += e; } else { const unsigned off = e * 128u + loff; rows[i] = *(const v4u*)(base + off); } }
}
__device__ __forceinline__ void part_planes(v4u& hh, v4u& hl, const v4u& a, const v4u& b) {
    const unsigned w[8] = {a.x, a.y, a.z, a.w, b.x, b.y, b.z, b.w}; unsigned oh[4], ol[4];
#pragma unroll
    for (int q = 0; q < 4; ++q) { const unsigned w0 = w[2 * q], w1 = w[2 * q + 1];
        const unsigned h0 = (((w0 >> 4) & 0x0F0F0F0Fu) + ((w0 >> 3) & 0x01010101u)) & 0x0F0F0F0Fu, h1 = (((w1 >> 4) & 0x0F0F0F0Fu) + ((w1 >> 3) & 0x01010101u)) & 0x0F0F0F0Fu;
        ol[q] = (w0 & 0x0F0F0F0Fu) | ((w1 & 0x0F0F0F0Fu) << 4); oh[q] = h0 | (h1 << 4); }
    hh = (v4u){oh[0], oh[1], oh[2], oh[3]}; hl = (v4u){ol[0], ol[1], ol[2], ol[3]};
}
__device__ __forceinline__ void part_round(const v4u (&rows)[8], const v4u& hh4, const v4u& hl4, short* po, int j) {
    int sm[8];
    const unsigned hh[4] = {hh4.x, hh4.y, hh4.z, hh4.w}, hl[4] = {hl4.x, hl4.y, hl4.z, hl4.w};
#pragma unroll
    for (int i = 0; i < 8; ++i) {
        const unsigned w[4] = {rows[i].x, rows[i].y, rows[i].z, rows[i].w}; int sh = 0, sl = 0;
#pragma unroll
        for (int q = 0; q < 4; ++q) { sh = __builtin_amdgcn_sdot8((int)w[q], (int)hh[q], sh, false); sl = __builtin_amdgcn_sdot8((int)w[q], (int)hl[q], sl, false); }
        int s_ = (sh << 4) + sl;
        s_ += dpp_i<DPP_XOR1>(s_); s_ += dpp_i<DPP_XOR2>(s_); s_ += dpp_i<DPP_HMIRROR>(s_);
        sm[i] = s_;
    }
    if (j == 0) { unsigned w[4];
#pragma unroll
        for (int i = 0; i < 4; ++i) w[i] = ((unsigned)((sm[2 * i] + 4) >> 3) & 0xffffu) | ((unsigned)((sm[2 * i + 1] + 4) >> 3) << 16);
        st_asm16(po, (v4u){w[0], w[1], w[2], w[3]}); }
}
template <int MODE> __device__ __forceinline__ void p7a_part(const Args& A, Frame& F, int layer) {
    unsigned char* ws = A.ws;
    const unsigned char* ut = ws + WS_PU + (size_t)layer * PNE * 512; short* part = (short*)(ws + (MODE == 1 ? WS_R4 + 64 * MiB : WS_PART));
    const int lane = F.lane, g = lane >> 3, j = lane & 7;
    const int nslice = F.xi < 8 ? (7 - F.xi) / F.nx + 1 : 0, xs0 = F.xi, xstep = F.nx;
    const int wrank = F.xr * NWAVES + F.wave, nw = F.xn * NWAVES;
    constexpr int NSUP = T / 16;
    const int cnt = (wrank < NSUP) ? (NSUP - 1 - wrank) / nw + 1 : 0, nit = cnt * nslice * 16;
    if (nit == 0) return;
#define IT_T(it) (wrank + ((it) / nslice) * nw)
#define IT_X(it) (xs0 + ((it) % nslice) * xstep)
#define IT_C(it) ((it) < nit ? (it) : nit - 1)
#define Y_TOK(R) (2 * (8 * IT_T((R) >> 4) + g) + (IT_X((R) >> 4) >> 2))
#define Y_SL(R) (IT_X((R) >> 4) & 3)
#define P_LDH(dh, dl, R) do { const unsigned char* hp_ = ws + WS_HQ + (size_t)Y_TOK(R) * D + Y_SL(R) * 256 + j * 32; dh = *(const v4u*)hp_; dl = *(const v4u*)(hp_ + 16); } while (0)
    v4u E[4][2]; v4u buf[4][8]; v4u Hh, Hl, Nh, Nl;
    { v4u e0[2];
      y_ld_e(e0, ws, Y_TOK(0), 0); P_LDH(Hh, Hl, 0); rows_issue8<MODE>(buf[0], e0, ut + (size_t)Y_SL(0) * PNE * 128, (unsigned)(j * 16));
      { const int i1 = IT_C(1); y_ld_e(e0, ws, Y_TOK(i1), i1 & 15); rows_issue8<MODE>(buf[1], e0, ut + (size_t)Y_SL(i1) * PNE * 128, (unsigned)(j * 16)); }
      { const int i2 = IT_C(2); y_ld_e(e0, ws, Y_TOK(i2), i2 & 15); rows_issue8<MODE>(buf[2], e0, ut + (size_t)Y_SL(i2) * PNE * 128, (unsigned)(j * 16)); }
      { const int i3 = IT_C(3); y_ld_e(E[3], ws, Y_TOK(i3), i3 & 15); } { const int i4 = IT_C(4); y_ld_e(E[0], ws, Y_TOK(i4), i4 & 15); } { const int i5 = IT_C(5); y_ld_e(E[1], ws, Y_TOK(i5), i5 & 15); }
      Nh = Hh; Nl = Hl; }
#define P_POS(p) do { const int R = it + (p); \
        { const int r6 = IT_C(R + 6), r3 = IT_C(R + 3); y_ld_e(E[((p) + 2) & 3], ws, Y_TOK(r6), r6 & 15); \
          if ((R & 15) == 12) { const int rn = IT_C(R + 4); P_LDH(Nh, Nl, rn); } \
          rows_issue8<MODE>(buf[((p) + 3) & 3], E[((p) + 3) & 3], ut + (size_t)Y_SL(r3) * PNE * 128, (unsigned)(j * 16)); } \
        __builtin_amdgcn_sched_barrier(0);     \
        if ((R & 15) == 0) { part_planes(Hh, Hl, Nh, Nl); } \
        part_round(buf[(p) & 3], Hh, Hl, part + ((size_t)Y_SL(R) * T + Y_TOK(R)) * PSEL + 8 * (R & 15), j); } while (0)
#pragma unroll 1
    for (int it = 0; it < nit; it += 4) { P_POS(0); P_POS(1); P_POS(2); P_POS(3); }
#undef P_POS
#undef P_LDH
}
__device__ __forceinline__ void p7c_combine(const Args& A, Frame& F) {
    unsigned char* ws = A.ws;
    const short* part = (const short*)(ws + WS_PART); const bf16* suk = (const bf16*)(ws + WS_SUK); const bf16* gsv = (const bf16*)(ws + WS_GATE); const float* hsb = (const float*)(ws + WS_HQS);
    unsigned char* cq = ws + WS_CB; float* csc = (float*)(ws + WS_CB + 8 * MiB);
    const size_t gt = (size_t)blockIdx.x * NTHREADS + F.tid, NT = (size_t)F.G * NTHREADS;
    for (size_t i8 = gt; i8 < (size_t)T * PSEL / 8; i8 += NT) {
        int sm[8];
#pragma unroll
        for (int i = 0; i < 8; ++i) sm[i] = 0;
#pragma unroll
        for (int x = 0; x < 4; ++x) { const v4u p = *(const v4u*)(part + (size_t)x * T * PSEL + 8 * i8); const unsigned w[4] = {p.x, p.y, p.z, p.w};
#pragma unroll
            for (int i = 0; i < 4; ++i) { sm[2 * i] += (int)(short)(w[i] & 0xffffu); sm[2 * i + 1] += (int)w[i] >> 16; } }
        const size_t t = (8 * i8) >> 7;
        const v4u aw = *(const v4u*)(suk + 8 * i8), bw = *(const v4u*)(gsv + 8 * i8); const float hs = hsb[t] * 8.f;
        const unsigned au[4] = {aw.x, aw.y, aw.z, aw.w}, bu[4] = {bw.x, bw.y, bw.z, bw.w};
        float c[8]; float m = 0.f;
#pragma unroll
        for (int i = 0; i < 4; ++i) { c[2 * i] = bf_lo(bu[i]) * gelu_tanh((float)sm[2 * i] * hs * bf_lo(au[i])); c[2 * i + 1] = bf_hi(bu[i]) * gelu_tanh((float)sm[2 * i + 1] * hs * bf_hi(au[i]));
            m = fmaxf(m, fmaxf(fabsf(c[2 * i]), fabsf(c[2 * i + 1]))); }
        m = fmaxf(m, dpp_f<DPP_XOR1>(m)); m = fmaxf(m, dpp_f<DPP_XOR2>(m)); m = fmaxf(m, dpp_f<DPP_HMIRROR>(m)); m = fmaxf(m, dpp_f<DPP_ROR8>(m));
        const float inv = m > 0.f ? 127.f / m : 0.f;
        v2u o; unsigned* op = (unsigned*)&o;
#pragma unroll
        for (int h = 0; h < 2; ++h) { const int q0 = (int)rintf(c[4 * h] * inv), q1 = (int)rintf(c[4 * h + 1] * inv), q2 = (int)rintf(c[4 * h + 2] * inv), q3 = (int)rintf(c[4 * h + 3] * inv);
            op[h] = (unsigned)(q0 & 255) | ((unsigned)(q1 & 255) << 8) | ((unsigned)(q2 & 255) << 16) | ((unsigned)(q3 & 255) << 24); }
        *(v2u*)(cq + 8 * i8) = o;
        if ((i8 & 15) == 0) csc[t] = m * (1.f / 127.f);
    }
}
__device__ __forceinline__ v2u y_ld_c(const unsigned char* ws, int t, int r) { return *(const v2u*)(ws + WS_CB + (size_t)t * PSEL + 8 * r); }
__device__ __forceinline__ void y_round(int (&y)[32], int& csum, const v4u (&rows)[8], const v2u& cq) {
#pragma unroll
    for (int kq = 0; kq < 2; ++kq) {
        const int c4 = (int)((const unsigned*)&cq)[kq];
        csum = __builtin_amdgcn_sdot4(c4, 0x01010101, csum, false);
#pragma unroll
        for (int q = 0; q < 4; ++q) {
            const unsigned r0 = ((const unsigned*)&rows[4 * kq])[q], r1 = ((const unsigned*)&rows[4 * kq + 1])[q], r2 = ((const unsigned*)&rows[4 * kq + 2])[q], r3 = ((const unsigned*)&rows[4 * kq + 3])[q];
            const unsigned u0 = __builtin_amdgcn_perm(r1, r0, 0x05010400u), u1 = __builtin_amdgcn_perm(r1, r0, 0x07030602u), u2 = __builtin_amdgcn_perm(r3, r2, 0x05010400u), u3 = __builtin_amdgcn_perm(r3, r2, 0x07030602u);
            const unsigned t[4] = {__builtin_amdgcn_perm(u2, u0, 0x05040100u), __builtin_amdgcn_perm(u2, u0, 0x07060302u), __builtin_amdgcn_perm(u3, u1, 0x05040100u), __builtin_amdgcn_perm(u3, u1, 0x07060302u)};
#pragma unroll
            for (int bb = 0; bb < 4; ++bb) {
                y[8 * q + 2 * bb] = __builtin_amdgcn_sdot4((int)t[bb], c4, y[8 * q + 2 * bb], false);
                y[8 * q + 2 * bb + 1] = __builtin_amdgcn_sdot4((int)(t[bb] & 0x0F0F0F0Fu), c4, y[8 * q + 2 * bb + 1], false); }
        }
    }
}
template <bool NN, int MODE = 0> __device__ __forceinline__ void p7b_y(const Args& A, Frame& F, int layer, const float* gnext, bf16* xout) {
    unsigned char* ws = A.ws;
    const unsigned char* vt = ws + WS_PV + (size_t)layer * PNE * 512;
    const int lane = F.lane, g = lane >> 3, j = lane & 7;
    const int nslice = F.xi < 8 ? (7 - F.xi) / F.nx + 1 : 0, xs0 = F.xi, xstep = F.nx;
    const int wrank = F.xr * NWAVES + F.wave, nw = F.xn * NWAVES;
    constexpr int NSUP = T / 16;
    const int cnt = (wrank < NSUP) ? (NSUP - 1 - wrank) / nw + 1 : 0, nit = cnt * nslice * 16;
    if (nit == 0) return;
    v4u E[4][2]; v2u Cq[4]; v4u buf[4][8]; int y[32]; int csum = 0;
    { v4u e0[2];
      y_ld_e(e0, ws, Y_TOK(0), 0); Cq[0] = y_ld_c(ws, Y_TOK(0), 0); rows_issue8<MODE>(buf[0], e0, vt + (size_t)Y_SL(0) * PNE * 128, (unsigned)(j * 16));
      { const int i1 = IT_C(1); y_ld_e(e0, ws, Y_TOK(i1), i1 & 15); Cq[1] = y_ld_c(ws, Y_TOK(i1), i1 & 15); rows_issue8<MODE>(buf[1], e0, vt + (size_t)Y_SL(i1) * PNE * 128, (unsigned)(j * 16)); }
      { const int i2 = IT_C(2); y_ld_e(e0, ws, Y_TOK(i2), i2 & 15); Cq[2] = y_ld_c(ws, Y_TOK(i2), i2 & 15); rows_issue8<MODE>(buf[2], e0, vt + (size_t)Y_SL(i2) * PNE * 128, (unsigned)(j * 16)); }
      { const int i3 = IT_C(3); y_ld_e(E[3], ws, Y_TOK(i3), i3 & 15); } { const int i4 = IT_C(4); y_ld_e(E[0], ws, Y_TOK(i4), i4 & 15); } { const int i5 = IT_C(5); y_ld_e(E[1], ws, Y_TOK(i5), i5 & 15); } }
#define Y_POS(p) do { const int R = it + (p); \
        { const int r6 = IT_C(R + 6), r3 = IT_C(R + 3); y_ld_e(E[((p) + 2) & 3], ws, Y_TOK(r6), r6 & 15); Cq[((p) + 3) & 3] = y_ld_c(ws, Y_TOK(r3), r3 & 15); \
          rows_issue8<MODE>(buf[((p) + 3) & 3], E[((p) + 3) & 3], vt + (size_t)Y_SL(r3) * PNE * 128, (unsigned)(j * 16)); } \
        __builtin_amdgcn_sched_barrier(0);     \
        if ((R & 15) == 0) { _Pragma("unroll") for (int i = 0; i < 32; ++i) y[i] = 0; csum = 0; } \
        y_round(y, csum, buf[(p) & 3], Cq[(p) & 3]); \
        if ((R & 15) == 15) { const int tt = Y_TOK(R); bf16* xo = xout + (size_t)tt * D + Y_SL(R) * 256 + j * 32; const float cs = ((const float*)(ws + WS_CB + 8 * MiB))[tt]; \
            v4u xv[4]; _Pragma("unroll") for (int q = 0; q < 4; ++q) xv[q] = *(const v4u*)(xo + 8 * q); \
            _Pragma("unroll") for (int q = 0; q < 4; ++q) { v4u o; unsigned* op = (unsigned*)&o; const unsigned* xp = (const unsigned*)&xv[q]; \
                  \
                _Pragma("unroll") for (int e = 0; e < 4; ++e) { const int c0 = 2 * e, c1 = 2 * e + 1; \
                    const int v0 = (c0 < 4) ? y[8 * q + 2 * c0 + 1] - 8 * csum : (y[8 * q + 2 * (c0 - 4)] - y[8 * q + 2 * (c0 - 4) + 1]) >> 4; \
                    const int v1 = (c1 < 4) ? y[8 * q + 2 * c1 + 1] - 8 * csum : (y[8 * q + 2 * (c1 - 4)] - y[8 * q + 2 * (c1 - 4) + 1]) >> 4; \
                    op[e] = pk2(bf_lo(xp[e]) + (float)v0 * cs, bf_hi(xp[e]) + (float)v1 * cs); } \
                st_asm16(xo + 8 * q, o); } } } while (0)
#pragma unroll 1
    for (int it = 0; it < nit; it += 4) { Y_POS(0); Y_POS(1); Y_POS(2); Y_POS(3); }
#undef Y_POS
#undef Y_TOK
#undef Y_SL
#undef IT_T
#undef IT_X
#undef IT_C
}
__device__ __forceinline__ void p_norm_final(const Args& A, Frame& F, const bf16* xres, const float* g) {
    const int gw = F.vcu * NWAVES + F.wave, NGW = F.G * NWAVES, lane = F.lane;
    for (int m = gw; m < T; m += NGW) {
        const v4u a = *(const GAS v4u*)(xres + (size_t)m * D + lane * 16), b = *(const GAS v4u*)(xres + (size_t)m * D + lane * 16 + 8);
        f32x4 v[4] = {(f32x4){bf_lo(a.x), bf_hi(a.x), bf_lo(a.y), bf_hi(a.y)}, (f32x4){bf_lo(a.z), bf_hi(a.z), bf_lo(a.w), bf_hi(a.w)}, (f32x4){bf_lo(b.x), bf_hi(b.x), bf_lo(b.y), bf_hi(b.y)}, (f32x4){bf_lo(b.z), bf_hi(b.z), bf_lo(b.w), bf_hi(b.w)}};
        float s = 0.f;
#pragma unroll
        for (int q = 0; q < 4; ++q) s += (v[q].x * v[q].x + v[q].y * v[q].y) + (v[q].z * v[q].z + v[q].w * v[q].w);
        const float r = rsqrtf(wave_sum(s) * (1.f / D) + EPS);
#pragma unroll
        for (int q = 0; q < 4; ++q) *(GAS f32x4*)(A.out + (size_t)m * D + lane * 16 + 4 * q) = v[q] * r * *(const GAS f32x4*)(g + lane * 16 + 4 * q);
    }
}
#ifndef MK_ONE_LAUNCH
#define MK_ONE_LAUNCH 1
#endif
constexpr int NPH = 20;
#ifndef PROBE_DUP
#define PROBE_DUP 0
#endif
__global__ void __launch_bounds__(NTHREADS, 2) fwd(Args args) {
    extern __shared__ __attribute__((aligned(16))) unsigned char lds[];
    Frame F;
    F.lds = (LAS unsigned char*)lds;
    F.MISC = (volatile LAS unsigned*)(F.lds + MISC_OFF);
    F.tid = threadIdx.x; F.lane = F.tid & 63; F.wave = __builtin_amdgcn_readfirstlane(F.tid >> 6);
    F.G = gridDim.x; { const int bx = blockIdx.x; F.vcu = (F.G % 8 == 0) ? (bx % 8) * (F.G / 8) + bx / 8 : bx; }
    unsigned char* ws = args.ws;
    F.ctl = (gu32*)(ws + WS_CTL);
    for (int u = F.tid; u < (LDS_BYTES - LDSCTL_OFF) / 4; u += NTHREADS) ((LAS unsigned*)(F.lds + LDSCTL_OFF))[u] = 0u;
    __syncthreads();
    XcdBarrier bar; bar.bar = (unsigned*)(F.ctl + CW_BAR); bar.x = 0; bar.st = nullptr;
    { bar.bar = (unsigned*)(F.ctl + CW_BAR); bar.x = xb_xcc_id(); bar.st = F.MISC + 8;
      if (F.tid == 0) F.MISC[10] = xb_add(&bar.bar[XB_XCNT(bar.x)], 1u); }
#define GRID_BAR() do { if (MK_ONE_LAUNCH) { xcd_barrier(bar); if (PROBE_DUP == 120) xcd_barrier(bar); } } while (0)
    const int lo = args.ph_lo, hi = args.ph_hi;
#ifdef ONLY_PH
#define IN(k) ((k) == ONLY_PH && lo <= (k) && (k) < hi)
#else
#define IN(k) (lo <= (k) && (k) < hi)
#endif
    bf16* hA = (bf16*)(ws + WS_HA);

    if (IN(0)) { p0_prologue(args, F); GRID_BAR(); if (PROBE_DUP == 100) { p0_prologue(args, F); GRID_BAR(); } if (PROBE_DUP == 131) { p0_prologue<1>(args, F); GRID_BAR(); } if (PROBE_DUP == 132) { p0_prologue<2>(args, F); GRID_BAR(); } if (PROBE_DUP == 133) { p0_prologue<3>(args, F); GRID_BAR(); } if (PROBE_DUP == 134) { p0_prologue<4>(args, F); GRID_BAR(); } }
    {
        if (F.tid == 0) { unsigned below = 0u;
#pragma unroll
            for (unsigned j = 0; j < 16; ++j) { const unsigned c = xb_ld(&bar.bar[XB_XCNT(j)]); below += (j < bar.x && c > 0u) ? 1u : 0u; }
            F.MISC[11] = below; }
        __syncthreads();
        F.xi = __builtin_amdgcn_readfirstlane((int)F.MISC[11]); F.xr = __builtin_amdgcn_readfirstlane((int)F.MISC[10]); F.xn = __builtin_amdgcn_readfirstlane((int)F.MISC[8]); F.nx = __builtin_amdgcn_readfirstlane((int)F.MISC[9]);
        if (F.xn < 1) F.xn = 1; if (F.nx < 1) F.nx = 1;
    }
    if (IN(1)) {
        pg8::Gemm g{(const bf16*)(ws + WS_HQ), (const bf16*)(ws + WS_WIN), T, MIX_IN, D / 2}; pg8::StaticOrder S; S.init(T, MIX_IN, F.G, (int)blockIdx.x);
        pg8::EpiI8<pg8::EpiMixIn> E{pg8::EpiMixIn{(bf16*)(ws + WS_AGLU), (bf16*)(ws + WS_UG), (bf16*)(ws + WS_VG)}, (const float*)(ws + WS_HQS), (const float*)(ws + WS_WSC)};
        pg8::gemm_phase<pg8::EpiI8<pg8::EpiMixIn>, pg8::StaticOrder, true, true, true>(F.lds, g, S, E);
        GRID_BAR();
        if (PROBE_DUP == 101) { pg8::gemm_phase<pg8::EpiI8<pg8::EpiMixIn>, pg8::StaticOrder, true, true, true>(F.lds, g, S, E); GRID_BAR(); }
    }
    if (IN(2)) { p2_mixer(args, F); GRID_BAR(); if (PROBE_DUP == 102) { p2_mixer(args, F); GRID_BAR(); } }
    if (IN(3)) {
        pg8::Gemm g{(const bf16*)(ws + WS_CAT), (const bf16*)(ws + WS_WOUT), T, D, D}; pg8::StaticOrder S; S.init(T, D, F.G, (int)blockIdx.x);
        pg8::EpiResB<false> E{args.in[I_X], nullptr, hA, D};
        pg8::gemm_phase<pg8::EpiResB<false>, pg8::StaticOrder, true, true>(F.lds, g, S, E);
        GRID_BAR();
    }
#define PEER_PHASES(layer, pb) do { \
        if (IN(pb)) { p_rms<true>(args, F, hA, args.in[I_GFFN] + (layer) * D); GRID_BAR(); } \
        if (IN((pb) + 1)) { \
            pg8::Gemm g{(const bf16*)(ws + WS_HQ), (const bf16*)(ws + WS_WQ + (size_t)(layer) * 2048 * D), T, 2048, D / 2}; const pg8::RouteOrder S{(int)F.vcu, (int)F.G, (T / 256) * PH}; \
            pg8::EpiI8Bf16<false> E{(bf16*)(ws + WS_QP), 2048, 0, 0, 1.f, (const float*)(ws + WS_HQS), (const float*)(ws + WS_WSC) + 2048 + (layer) * 2048, nullptr, 0}; \
            pg8::gemm_phase<pg8::EpiI8Bf16<false>, pg8::RouteOrder, true, true, true>(F.lds, g, S, E); \
            __syncthreads();     \
            p6_route<0>(args, F, (layer)); GRID_BAR(); \
            if (PROBE_DUP == 105) { pg8::gemm_phase<pg8::EpiI8Bf16<false>, pg8::RouteOrder, true, true, true>(F.lds, g, S, E); GRID_BAR(); } \
            if (PROBE_DUP == 106) { p6_route<0>(args, F, (layer)); GRID_BAR(); } \
        } \
        if (IN((pb) + 3)) { if (PROBE_DUP == 117) { p7a_part<1>(args, F, (layer)); GRID_BAR(); } p7a_part<0>(args, F, (layer)); GRID_BAR(); if (PROBE_DUP == 107) { p7a_part<0>(args, F, (layer)); GRID_BAR(); } p7c_combine(args, F); GRID_BAR(); if (PROBE_DUP == 108) { p7c_combine(args, F); GRID_BAR(); } } \
        if (IN((pb) + 4)) { if (PROBE_DUP == 118) { p7b_y<false, 1>(args, F, (layer), args.in[I_GFIN], (bf16*)(ws + WS_PART)); GRID_BAR(); } if (PROBE_DUP == 121) { p7b_y<false, 3>(args, F, (layer), args.in[I_GFIN], (bf16*)(ws + WS_PART)); GRID_BAR(); } if (PROBE_DUP == 119) { p7b_y<false, 2>(args, F, (layer), args.in[I_GFIN], (bf16*)(ws + WS_PART)); GRID_BAR(); } p7b_y<false>(args, F, (layer), args.in[I_GFIN], hA); GRID_BAR(); } \
        if (IN((pb) + 5)) { if ((layer) == 0) { p_rms<true, false>(args, F, hA, args.in[I_GMIX] + D); GRID_BAR(); } else p_norm_final(args, F, hA, args.in[I_GFIN]); } \
    } while (0)
    PEER_PHASES(0, 4);
    if (IN(10)) {
        pg8::Gemm g{(const bf16*)(ws + WS_HQ), (const bf16*)(ws + WS_WQKV), T, 3 * D, D / 2}; pg8::StaticOrder S; S.init(T, 3 * D, F.G, (int)blockIdx.x);
        pg8::EpiI8Bf16<true> E{(bf16*)(ws + WS_Q), D, D, (size_t)(WS_K - WS_Q) / 2, attn_body::C2, (const float*)(ws + WS_HQS), (const float*)(ws + WS_WSC) + 6144, (float*)(ws + WS_KMEAN), T / 256};
        pg8::gemm_phase<pg8::EpiI8Bf16<true>, pg8::StaticOrder, true, true, true>(F.lds, g, S, E);
        GRID_BAR();
    }
    if (IN(12)) {
        static_assert(attn_body::ATTN_LDS_BYTES <= RING_BYTES && attn_body::GLUT_OFF == LUT_OFF && attn_body::GLUT_N == LUT_N, "attention body geometry vs frame");
        const attn_body::AttnTensors AT{(const attn_body::bf16*)(ws + WS_Q), (const attn_body::bf16*)(ws + WS_K), (const attn_body::bf16*)(ws + WS_V), (attn_body::bf16*)(ws + WS_Q), (const float*)(ws + WS_KMEAN), (const float*)(ws + WS_LUT)};
        const attn_body::StaticOrder S((int)F.G, (int)blockIdx.x);
        if (PROBE_DUP == 112) { const attn_body::AttnTensors AT2{AT.Q, AT.K, AT.V, (attn_body::bf16*)(ws + WS_IDX), AT.KM, AT.GLUT}; attn_body::attn_phase<attn_body::StaticOrder>((char*)lds, AT2, S); GRID_BAR(); }
        if (PROBE_DUP == 114) { const attn_body::AttnTensors AT2{AT.Q, AT.K, AT.V, (attn_body::bf16*)(ws + WS_IDX), AT.KM, AT.GLUT}; attn_body::attn_phase<attn_body::StaticOrder, 8, 2>((char*)lds, AT2, S); GRID_BAR(); }
        if (PROBE_DUP == 115) { const attn_body::AttnTensors AT2{AT.Q, AT.K, AT.V, (attn_body::bf16*)(ws + WS_IDX), AT.KM, AT.GLUT}; attn_body::attn_phase<attn_body::StaticOrder, 8, 4>((char*)lds, AT2, S); GRID_BAR(); }
        if (PROBE_DUP == 113) { const attn_body::AttnTensors AT2{AT.Q, AT.K, AT.V, (attn_body::bf16*)(ws + WS_IDX), AT.KM, AT.GLUT}; attn_body::attn_phase<attn_body::StaticOrder, 8, true>((char*)lds, AT2, S); GRID_BAR(); }
        attn_body::attn_phase<attn_body::StaticOrder>((char*)lds, AT, S);
        GRID_BAR();
    }
    { int t_ = threadIdx.x; asm volatile("" : "+v"(t_)); F.tid = t_; F.lane = t_ & 63; }
    if (IN(13)) {
        pg8::Gemm g{(const bf16*)(ws + WS_Q), (const bf16*)(ws + WS_WO), T, D, D}; pg8::StaticOrder S; S.init(T, D, F.G, (int)blockIdx.x);
        pg8::EpiResB<true> E{nullptr, hA, hA, D};
        pg8::gemm_phase<pg8::EpiResB<true>, pg8::StaticOrder, true, true>(F.lds, g, S, E);
        GRID_BAR();
    }
    PEER_PHASES(1, 14);
#undef PEER_PHASES
#undef IN
#undef GRID_BAR
}

extern "C" void kernel_launch(void* const* d_in, const int* in_sizes, int n_in, void* d_out, int out_size, void* d_ws, size_t ws_size, hipStream_t stream) {
    static int grid = 0;
    if (grid == 0) {
        if (n_in != 21 || in_sizes[0] != T * D || out_size != T * D || ws_size < WS_END) { fprintf(stderr, "kernel_launch: unexpected shapes (n_in %d, in0 %d, out %d, ws %zu); nothing launched\n", n_in, n_in > 0 ? in_sizes[0] : -1, out_size, ws_size); grid = -1; return; }
        int dev = 0, cus = 0, per_cu = 0;
        if (hipGetDevice(&dev) != hipSuccess || hipDeviceGetAttribute(&cus, hipDeviceAttributeMultiprocessorCount, dev) != hipSuccess) { grid = -1; return; }
        if (hipFuncSetAttribute((const void*)fwd, hipFuncAttributeMaxDynamicSharedMemorySize, LDS_BYTES) != hipSuccess) { fprintf(stderr, "kernel_launch: hipFuncSetAttribute failed\n"); grid = -1; return; }
        if (hipOccupancyMaxActiveBlocksPerMultiprocessor(&per_cu, (const void*)fwd, NTHREADS, LDS_BYTES) != hipSuccess || per_cu < 1) fprintf(stderr, "kernel_launch: occupancy query reports %d workgroups per CU\n", per_cu);
        (void)hipGetLastError();
        grid = cus;
    }
    if (grid < 0) return;
    if (hipMemsetAsync((char*)d_ws + WS_CTL, 0, CTL_ZERO_BYTES, stream) != hipSuccess) { fprintf(stderr, "kernel_launch: hipMemsetAsync failed\n"); return; }
    Args a{};
    for (int i = 0; i < 21; ++i) a.in[i] = (const float*)d_in[i];
    a.out = (float*)d_out; a.ws = (unsigned char*)d_ws;
#if MK_ONE_LAUNCH
    a.ph_lo = 0; a.ph_hi = NPH; a.li = 0;
    hipLaunchKernelGGL(fwd, dim3(grid), dim3(NTHREADS), LDS_BYTES, stream, a);
#else
    for (int p = 0; p < NPH; ++p) { a.ph_lo = p; a.ph_hi = p + 1; a.li = p; hipLaunchKernelGGL(fwd, dim3(grid), dim3(NTHREADS), LDS_BYTES, stream, a); }
#endif
    const hipError_t le = hipPeekAtLastError();
    if (le != hipSuccess) fprintf(stderr, "kernel_launch: launch failed: %s\n", hipGetErrorName(le));
}
```
